# Optimizing an MI355X kernel written in HIP

```python
import jax, jax.numpy as jnp
from jax import lax
import numpy as np

D_MODEL = 1024
BATCH = 2
SEQ = 8192
DEPTH = 2

CHUNK = 64
CONV_WIDTH = D_MODEL
CONV_GROUPS = 16
CONV_K = 3
LRU_WIDTH = D_MODEL
LRU_HEADS = 16
LRU_HEAD_DIM = LRU_WIDTH // LRU_HEADS
LRU_CONV_K = 4
LRU_C = 8.0
D_FF = ((-(-8 * D_MODEL // 3)) + 255) // 256 * 256
RMS_EPS = 1e-6
IN_WIDTHS = (CONV_WIDTH, CONV_WIDTH, CONV_WIDTH, LRU_WIDTH, LRU_WIDTH, D_MODEL, D_MODEL)
IN_TOTAL = sum(IN_WIDTHS)
SPLIT_POINTS = tuple(int(v) for v in np.cumsum(IN_WIDTHS)[:-1])

kernel_name = "hybrid_shortconv_rglru_gated_merge"


def rmsnorm(x, g):
    xf = x.astype(jnp.float32)
    var = jnp.mean(xf * xf, axis=-1, keepdims=True)
    return (xf * lax.rsqrt(var + RMS_EPS) * g.astype(jnp.float32)).astype(x.dtype)


def causal_depthwise_conv(x, w, b=None):
    K = w.shape[0]
    S = x.shape[1]
    xp = jnp.pad(x, ((0, 0), (K - 1, 0), (0, 0)))
    y = xp[:, 0:S] * w[0]
    for k in range(1, K):
        y = y + xp[:, k:k + S] * w[k]
    if b is not None:
        y = y + b
    return y


def rg_lru(x, w_a, b_a, w_x, b_x, lam):
    Bsz, S, W = x.shape
    f32 = jnp.float32
    xf = x.astype(f32)
    xh = xf.reshape(Bsz, S, LRU_HEADS, LRU_HEAD_DIM)
    r = jax.nn.sigmoid(jnp.einsum('bshd,hde->bshe', xh, w_a.astype(f32)).reshape(Bsz, S, W) + b_a.astype(f32))
    i = jax.nn.sigmoid(jnp.einsum('bshd,hde->bshe', xh, w_x.astype(f32)).reshape(Bsz, S, W) + b_x.astype(f32))
    log_a = -LRU_C * r * jax.nn.softplus(-lam.astype(f32))
    a = jnp.exp(log_a)
    b = jnp.sqrt(-jnp.expm1(2.0 * log_a)) * (i * xf)
    n_chunks = S // CHUNK
    a_c = a.reshape(Bsz, n_chunks, CHUNK, W)
    b_c = b.reshape(Bsz, n_chunks, CHUNK, W)

    def combine(left, right):
        a_l, b_l = left
        a_r, b_r = right
        return a_l * a_r, a_r * b_l + b_r

    a_cum, h_loc = lax.associative_scan(combine, (a_c, b_c), axis=2)

    def step(h_prev, inp):
        a_cum_k, h_loc_k = inp
        h = h_loc_k + a_cum_k * h_prev[:, None, :]
        return h[:, -1], h

    h0 = jnp.zeros((Bsz, W), f32)
    _, hs = lax.scan(step, h0, (jnp.moveaxis(a_cum, 1, 0), jnp.moveaxis(h_loc, 1, 0)))
    return jnp.moveaxis(hs, 0, 1).reshape(Bsz, S, W).astype(x.dtype)


def setup_inputs(seed: int = 0) -> dict:
    key = jax.random.key(seed)
    ks = jax.random.split(key, 24)
    f32 = jnp.float32
    nrm = lambda k, shape, fan_in: jax.random.normal(k, shape, f32) * (fan_in ** -0.5)
    x = jax.random.normal(ks[0], (BATCH, SEQ, D_MODEL), f32)
    ln1_g = 1.0 + 0.02 * jax.random.normal(ks[1], (DEPTH, D_MODEL), f32)
    w_in = nrm(ks[2], (DEPTH, D_MODEL, IN_TOTAL), D_MODEL)
    conv_a_w = nrm(ks[3], (DEPTH, CONV_K, CONV_WIDTH), CONV_K)
    conv_b_w = nrm(ks[4], (DEPTH, LRU_CONV_K, LRU_WIDTH), LRU_CONV_K)
    conv_b_b = 0.02 * jax.random.normal(ks[5], (DEPTH, LRU_WIDTH), f32)
    lru_wa = nrm(ks[6], (DEPTH, LRU_HEADS, LRU_HEAD_DIM, LRU_HEAD_DIM), LRU_HEAD_DIM)
    lru_ba = 0.02 * jax.random.normal(ks[7], (DEPTH, LRU_WIDTH), f32)
    lru_wx = nrm(ks[8], (DEPTH, LRU_HEADS, LRU_HEAD_DIM, LRU_HEAD_DIM), LRU_HEAD_DIM)
    lru_bx = 0.02 * jax.random.normal(ks[9], (DEPTH, LRU_WIDTH), f32)
    u = jax.random.uniform(ks[10], (DEPTH, LRU_WIDTH), f32, 0.9, 0.999)
    s = u ** (1.0 / LRU_C)
    lru_lambda = jnp.log(s) - jnp.log1p(-s)
    w_out_a = nrm(ks[11], (DEPTH, CONV_WIDTH, D_MODEL), CONV_WIDTH)
    w_out_b = nrm(ks[12], (DEPTH, LRU_WIDTH, D_MODEL), LRU_WIDTH)
    gate_bias = 0.02 * jax.random.normal(ks[13], (DEPTH, 2, D_MODEL), f32)
    w_o = nrm(ks[14], (DEPTH, D_MODEL, D_MODEL), D_MODEL)
    ln2_g = 1.0 + 0.02 * jax.random.normal(ks[15], (DEPTH, D_MODEL), f32)
    w_ffn_gate = nrm(ks[16], (DEPTH, D_MODEL, D_FF), D_MODEL)
    w_ffn_up = nrm(ks[17], (DEPTH, D_MODEL, D_FF), D_MODEL)
    w_ffn_down = nrm(ks[18], (DEPTH, D_FF, D_MODEL), D_FF)
    final_g = 1.0 + 0.02 * jax.random.normal(ks[19], (D_MODEL,), f32)
    return {"x": x, "ln1_g": ln1_g, "w_in": w_in, "conv_a_w": conv_a_w,
            "conv_b_w": conv_b_w, "conv_b_b": conv_b_b, "lru_wa": lru_wa,
            "lru_ba": lru_ba, "lru_wx": lru_wx, "lru_bx": lru_bx,
            "lru_lambda": lru_lambda, "w_out_a": w_out_a, "w_out_b": w_out_b,
            "gate_bias": gate_bias, "w_o": w_o, "ln2_g": ln2_g,
            "w_ffn_gate": w_ffn_gate, "w_ffn_up": w_ffn_up,
            "w_ffn_down": w_ffn_down, "final_g": final_g}


def reference(x, ln1_g, w_in, conv_a_w, conv_b_w, conv_b_b, lru_wa, lru_ba,
              lru_wx, lru_bx, lru_lambda, w_out_a, w_out_b, gate_bias, w_o,
              ln2_g, w_ffn_gate, w_ffn_up, w_ffn_down, final_g):
    for l in range(DEPTH):
        h = rmsnorm(x, ln1_g[l])
        proj = h @ w_in[l]
        b_a, c_a, x_a, x_b, g_b, gate_a_logit, gate_b_logit = jnp.split(proj, SPLIT_POINTS, axis=-1)
        y_a = b_a * causal_depthwise_conv(c_a * x_a, conv_a_w[l])
        u_b = causal_depthwise_conv(x_b, conv_b_w[l], conv_b_b[l])
        y_b = rg_lru(u_b, lru_wa[l], lru_ba[l], lru_wx[l], lru_bx[l], lru_lambda[l])
        y_b = y_b * jax.nn.gelu(g_b)
        merged = (jax.nn.sigmoid(gate_a_logit + gate_bias[l, 0]) * (y_a @ w_out_a[l])
                  + jax.nn.sigmoid(gate_b_logit + gate_bias[l, 1]) * (y_b @ w_out_b[l]))
        x = x + merged @ w_o[l]
        h = rmsnorm(x, ln2_g[l])
        x = x + (jax.nn.silu(h @ w_ffn_gate[l]) * (h @ w_ffn_up[l])) @ w_ffn_down[l]
    return rmsnorm(x, final_g)
```

```cpp
#include <hip/hip_runtime.h>
#include <cstdio>
#include <cstdint>

#ifndef MK_PER_PHASE
#define MK_PER_PHASE 0
#endif

#define LAS __attribute__((address_space(3)))
#define GAS __attribute__((address_space(1)))
typedef unsigned short bf16_t;
typedef short bf16x8 __attribute__((ext_vector_type(8)));
typedef float f32x4 __attribute__((ext_vector_type(4)));
typedef float f32x2 __attribute__((ext_vector_type(2)));
typedef unsigned u32x4 __attribute__((ext_vector_type(4)));
typedef unsigned u32x2 __attribute__((ext_vector_type(2)));
typedef GAS unsigned gu32;

constexpr int BATCH = 2, SEQ = 8192, DM = 1024, M = BATCH * SEQ, NIN = 7168, DFF = 2816, NGU = 2 * DFF, NHEAD = 16, HD = 64, DEPTH = 2;
constexpr float RMS_EPS = 1e-6f;
constexpr int NWAVES = 8;
constexpr int N1A = 5120;
constexpr int ROW_GG = 5120;

constexpr size_t MiB = 1u << 20;
constexpr size_t WS_CTL = 0, CTL_ZERO_BYTES = 1 * MiB;
constexpr size_t WS_SSQ = 1 * MiB;
constexpr size_t WS_SUM = 2 * MiB;
constexpr size_t WS_LRU = 3 * MiB;
constexpr size_t WS_WIN = 4 * MiB, WS_WOA = 18 * MiB, WS_WOB = 20 * MiB, WS_WO = 22 * MiB, WS_WGU = 24 * MiB, WS_WD = 35 * MiB;
constexpr size_t WS_S0 = 48 * MiB, SLOT = 32 * MiB;
constexpr size_t WS_S1 = WS_S0 + SLOT, WS_S2 = WS_S1 + SLOT, WS_S3 = WS_S2 + SLOT, WS_S4 = WS_S3 + SLOT, WS_S5 = WS_S4 + SLOT, WS_END = WS_S5 + SLOT;
static_assert(WS_WD + (size_t)DM * DFF * 2 <= WS_S0 && WS_END <= 256 * MiB, "d_ws map");
constexpr int CW_BAR = 4096;

constexpr int RING_BYTES = 131072;
constexpr int LDSCTL_OFF = RING_BYTES, MISC_OFF = LDSCTL_OFF + 320;
constexpr int LDS_BYTES = 147456;

#define RLX_AGENT __ATOMIC_RELAXED, __HIP_MEMORY_SCOPE_AGENT
#define LDS_WAIT() asm volatile("s_waitcnt lgkmcnt(0)" ::: "memory")
#define VM_WAIT() asm volatile("s_waitcnt vmcnt(0)" ::: "memory")
__device__ __forceinline__ unsigned f2bf(float f) { unsigned u = __builtin_bit_cast(unsigned, f); return (u + 0x7fffu + ((u >> 16) & 1u)) >> 16; }
__device__ __forceinline__ unsigned pk2(float lo, float hi) { return f2bf(lo) | (f2bf(hi) << 16); }
__device__ __forceinline__ unsigned cvt_pk_bf16(float lo, float hi) { unsigned r; asm volatile("v_cvt_pk_bf16_f32 %0, %1, %2" : "=v"(r) : "v"(lo), "v"(hi)); return r; }
__device__ __forceinline__ float bflo(unsigned w) { return __builtin_bit_cast(float, w << 16); }
__device__ __forceinline__ float bfhi(unsigned w) { return __builtin_bit_cast(float, w & 0xffff0000u); }
__device__ __forceinline__ float fast_exp(float x) { return __builtin_amdgcn_exp2f(x * 1.4426950408889634f); }
__device__ __forceinline__ float fast_sigmoid(float x) { return __builtin_amdgcn_rcpf(1.0f + fast_exp(-x)); }
__device__ __forceinline__ float gelu_tanh(float x) {
    const float z = 1.5957691216057308f * (x + 0.044715f * x * x * x);
    return x * __builtin_amdgcn_rcpf(1.0f + fast_exp(-z));
}
__device__ __forceinline__ float rstd_of(const float* ssq, int row) {
    const f32x4 s = *(const f32x4*)(ssq + (size_t)row * 4);
    return __builtin_amdgcn_rsqf(((s.x + s.y) + (s.z + s.w)) * (1.0f / DM) + RMS_EPS);
}

#define XB_TMO      128
#define XB_XCNT(j)  (256  + 64 * (j))
#define XB_XSUB(j)  (1280 + 64 * (j))
#define XB_XGEN(j)  (2304 + 64 * (j))
#define XB_TOP      3328
#define XB_TOPGEN   3392
#define XCD_BAR_WORDS 3456
#define XB_SPIN_CAP (1u << 22)
__device__ __forceinline__ unsigned xb_ld(unsigned* p)              { return __hip_atomic_load(p, __ATOMIC_RELAXED, __HIP_MEMORY_SCOPE_AGENT); }
__device__ __forceinline__ unsigned xb_add(unsigned* p, unsigned v) { return __hip_atomic_fetch_add(p, v, __ATOMIC_RELAXED, __HIP_MEMORY_SCOPE_AGENT); }
__device__ __forceinline__ unsigned xb_xcc_id() { return (unsigned)__builtin_amdgcn_s_getreg((3 << 11) | 20) & 0xFu; }
#define XB_SPIN(cond, bar) do { unsigned _sp = 0; while (cond) { __builtin_amdgcn_s_sleep(1); \
    if ((++_sp & 255u) == 0u) { if (xb_ld(&(bar)[XB_TMO])) break; if (_sp > XB_SPIN_CAP) { atomicAdd(&(bar)[XB_TMO], 1u); break; } } } } while (0)
struct XcdBarrier { unsigned* bar; unsigned x; volatile LAS unsigned* st; };
__device__ __forceinline__ XcdBarrier xcd_barrier_post(unsigned* bar, volatile LAS unsigned* st) {
    XcdBarrier b; b.bar = bar; b.x = xb_xcc_id(); b.st = st;
    if (threadIdx.x == 0) (void)xb_add(&bar[XB_XCNT(b.x)], 1u);
    return b;
}
__device__ __forceinline__ void xcd_barrier_complete(unsigned* bar, unsigned x, unsigned& nloc, unsigned& nx) {
    const unsigned G = gridDim.x * gridDim.y * gridDim.z;
    unsigned sum, cnt, mine, sp = 0u;
    for (;;) {
        sum = 0u; cnt = 0u; mine = 0u;
#pragma unroll
        for (unsigned j = 0; j < 16; ++j) { const unsigned c = xb_ld(&bar[XB_XCNT(j)]); sum += c; cnt += (c > 0u) ? 1u : 0u; mine = (j == x) ? c : mine; }
        if (sum == G) break;
        __builtin_amdgcn_s_sleep(1);
        if ((++sp & 255u) == 0u) { if (xb_ld(&bar[XB_TMO])) break; if (sp > XB_SPIN_CAP) { atomicAdd(&bar[XB_TMO], 1u); break; } }
    }
    nloc = mine > 0u ? mine : 1u; nx = cnt > 0u ? cnt : 1u;
}
__device__ __forceinline__ void xcd_barrier(const XcdBarrier& b) {
    asm volatile("s_waitcnt vmcnt(0)" ::: "memory");
    __syncthreads();
    if (threadIdx.x == 0) {
        unsigned* bar = b.bar;
        __builtin_amdgcn_s_waitcnt(0);
        unsigned nloc = b.st[0], nx = b.st[1];
        if (nloc == 0u) { xcd_barrier_complete(bar, b.x, nloc, nx); b.st[0] = nloc; b.st[1] = nx; }
        const unsigned old = xb_add(&bar[XB_XSUB(b.x)], 1u);
        const unsigned gen = old / nloc;
        if (old + 1u == (gen + 1u) * nloc) {
            __builtin_amdgcn_fence(__ATOMIC_RELEASE, "agent");
            asm volatile("s_waitcnt vmcnt(0)" ::: "memory");
            const unsigned og = xb_add(&bar[XB_TOP], 1u);
            const unsigned tg = og / nx;
            if (og + 1u == (tg + 1u) * nx) xb_add(&bar[XB_TOPGEN], 1u);
            else XB_SPIN(xb_ld(&bar[XB_TOPGEN]) == tg, bar);
            __builtin_amdgcn_fence(__ATOMIC_ACQUIRE, "agent");
            xb_add(&bar[XB_XGEN(b.x)], 1u);
            asm volatile("s_waitcnt vmcnt(0)" ::: "memory");
        } else {
            XB_SPIN(xb_ld(&bar[XB_XGEN(b.x)]) == gen, bar);
            __builtin_amdgcn_fence(__ATOMIC_ACQUIRE, "agent");
            asm volatile("s_waitcnt vmcnt(0)" ::: "memory");
        }
    }
    __syncthreads();
}

namespace pg8 {
constexpr int BM = 256, BK = 64, HALF = 128, HTB = HALF * BK * 2, NXCD = 8, WGM = 8;
__host__ __device__ __forceinline__ int lds_byte(int r, int c) { const int st = (r >> 4) * 2 + (c >> 5), rr = r & 15, cc = c & 31, ob = rr * 64 + cc * 2; return st * 1024 + (ob ^ (((ob >> 9) & 1) << 5)); }
__host__ __device__ __forceinline__ void stage_rc(int b, int& R, int& C) { const int st = b / 1024, sb = b % 1024, swz = sb ^ (((sb >> 9) & 1) << 5); R = (st >> 1) * 16 + swz / 64; C = (st & 1) * 32 + (swz % 64) / 2; }
__host__ __device__ __forceinline__ int perm32(int rho) { const int n = rho >> 4, i = rho & 15; return 8 * (i >> 2) + 4 * n + (i & 3); }

struct Unit { int pm, pn, kind; };

struct StaticOrder {
    int nM, nN, nwg, G, c;
    __device__ __forceinline__ void init(int M_, int N_, int G_, int c_) { nM = M_ / BM; nN = N_ / BM; nwg = nM * nN; G = G_; c = c_; }
    __device__ __forceinline__ bool next(int i, int& pm, int& pn) const {
        const long L = (long)i * G + c; if (L >= nwg) return false;
        int wgid = (int)L; { const int q = nwg / NXCD, r = nwg % NXCD, xcd = wgid % NXCD, off = wgid / NXCD; wgid = (xcd < r ? xcd * (q + 1) : r * (q + 1) + (xcd - r) * q) + off; }
        const int nig = WGM * nN, gid = wgid / nig, fm = gid * WGM, gsz = (nM - fm) < WGM ? (nM - fm) : WGM;
        pm = fm + ((wgid % nig) % gsz); pn = (wgid % nig) / gsz; return true;
    }
};
struct SchedPlain {
    StaticOrder so; const char* A0; const char* B0; size_t tstep;
    __device__ __forceinline__ bool next(int i, Unit& u) const { int pm_ = 0, pn_ = 0; const bool ok_ = so.next(i, pm_, pn_); u.pm = pm_; u.pn = pn_; u.kind = 0; return ok_; }
    __device__ __forceinline__ const char* a_ptr(const Unit& u) const { return A0 + (size_t)u.pm * tstep; }
    __device__ __forceinline__ const char* b_ptr(const Unit& u) const { return B0 + (size_t)u.pn * tstep; }
};
struct SchedP4 {
    int pm, pn; bool valid; const char* ws;
    static constexpr size_t TS = (size_t)256 * DM * 2;
    __device__ __forceinline__ bool next(int i, Unit& u) const { if (!valid || i >= 4) return false; u.pm = pm; u.kind = i < 2 ? 0 : i - 1; u.pn = i < 2 ? 2 * pn + i : pn; return true; }
    __device__ __forceinline__ const char* a_ptr(const Unit& u) const { const size_t off = WS_S0 + (size_t)(u.kind == 1) * (WS_S1 - WS_S0) + (size_t)(u.kind == 2) * (WS_S4 - WS_S0); return ws + off + (size_t)u.pm * TS; }
    __device__ __forceinline__ const char* b_ptr(const Unit& u) const { const size_t off = (WS_WIN + (size_t)ROW_GG * DM * 2) + (size_t)(u.kind == 1) * (WS_WOA - (WS_WIN + (size_t)ROW_GG * DM * 2)) + (size_t)(u.kind == 2) * (WS_WOB - (WS_WIN + (size_t)ROW_GG * DM * 2)); return ws + off + (size_t)u.pn * TS; }
};

template <class Epi, class Sched, bool ALIGN_EPI, bool SP2>
__device__ __forceinline__ void gemm_phase(LAS unsigned char* lds, const int tid, const int K, const Sched& S, const Epi& E) {
    const int wid = __builtin_amdgcn_readfirstlane(tid >> 6), lane = tid & 63, wr = wid >> 2, wc = wid & 3, fr = lane & 15, fq = lane >> 4;
    const int nt = K / BK;
    unsigned voffA[2], voffB[2];
#pragma unroll
    for (int i = 0; i < 2; ++i) { int R, C; stage_rc(tid * 16 + i * 8192, R, C); const int Rb = Epi::PERM ? ((R & ~31) + perm32(R & 31)) : R;
        voffA[i] = (unsigned)(R * K + C) * 2u; voffB[i] = (unsigned)(Rb * K + C) * 2u; }
    const size_t kstep = (size_t)(BK * 2);
    const size_t hstep = (size_t)HALF * K * 2;
    const unsigned ldsw = (unsigned)wid * 1024u;
    const int aoff = lds_byte(wr * 64 + fr, fq * 8), boff = lds_byte(wc * 32 + fr, fq * 8);
#define PG8_SA(b, h) (((b) * 2 + (h)) * HTB)
#define PG8_SB(b, h) ((4 + (b) * 2 + (h)) * HTB)
#define PG8_STAGE(bufoff, gbase, voff) do { _Pragma("unroll") for (int _i = 0; _i < 2; ++_i) \
        __builtin_amdgcn_global_load_lds((const unsigned*)((const char*)(gbase) + (voff)[_i]), (LAS unsigned*)(lds + (bufoff) + ldsw + _i * 8192), 16, 0, 0); } while (0)
#define PG8_LDA(dst, b, h) do { _Pragma("unroll") for (int m = 0; m < 4; ++m) _Pragma("unroll") for (int k = 0; k < 2; ++k) dst[m][k] = *(const LAS bf16x8*)(lds + PG8_SA(b, h) + aoff + m * 2048 + k * 1024); } while (0)
#define PG8_LDB(dst, b, h) do { _Pragma("unroll") for (int n = 0; n < 2; ++n) _Pragma("unroll") for (int k = 0; k < 2; ++k) dst[n][k] = *(const LAS bf16x8*)(lds + PG8_SB(b, h) + boff + n * 2048 + k * 1024); } while (0)
#define PG8_MMA(ai, bj, At, Bt) do { __builtin_amdgcn_s_setprio(1); _Pragma("unroll") for (int m = 0; m < 4; ++m) _Pragma("unroll") for (int n = 0; n < 2; ++n) _Pragma("unroll") for (int k = 0; k < 2; ++k) \
        acc[ai][bj][m][n] = __builtin_amdgcn_mfma_f32_16x16x32_bf16(Bt[n][k], At[m][k], acc[ai][bj][m][n], 0, 0, 0); __builtin_amdgcn_s_setprio(0); } while (0)
#define PG8_WAIT_V(n) asm volatile("s_waitcnt vmcnt(" #n ")" ::: "memory")
#define PG8_WAIT_L(n) asm volatile("s_waitcnt lgkmcnt(" #n ")" ::: "memory")
#define PG8_BAR __builtin_amdgcn_s_barrier()
#define PG8_SCHED __builtin_amdgcn_sched_barrier(0)
    Unit cur, nxt; int ui = 0;
    if (!S.next(0, cur)) return;
    f32x4 acc[2][2][4][2];
#pragma unroll
    for (int a = 0; a < 2; ++a)
#pragma unroll
        for (int b = 0; b < 2; ++b)
#pragma unroll
            for (int m = 0; m < 4; ++m)
#pragma unroll
                for (int n = 0; n < 2; ++n) acc[a][b][m][n] = (f32x4){0.f, 0.f, 0.f, 0.f};
    bf16x8 At[4][2], B0[2][2], B1[2][2];
    const char* cA = S.a_ptr(cur); const char* cB = S.b_ptr(cur);
    if constexpr (SP2) {
        PG8_STAGE(PG8_SB(0, 0), cB, voffB); PG8_STAGE(PG8_SB(0, 1), cB + hstep, voffB); PG8_STAGE(PG8_SA(0, 0), cA, voffA); PG8_STAGE(PG8_SA(0, 1), cA + hstep, voffA);
        if (wr == 1) PG8_BAR;
        PG8_WAIT_V(2); PG8_BAR;
        PG8_STAGE(PG8_SB(1, 0), cB + kstep, voffB); PG8_STAGE(PG8_SA(1, 0), cA + kstep, voffA); PG8_STAGE(PG8_SB(1, 1), cB + hstep + kstep, voffB);
        PG8_WAIT_V(6); PG8_BAR;
    } else {
        PG8_STAGE(PG8_SB(0, 0), cB, voffB); PG8_STAGE(PG8_SA(0, 0), cA, voffA); PG8_STAGE(PG8_SB(0, 1), cB + hstep, voffB); PG8_STAGE(PG8_SA(0, 1), cA + hstep, voffA);
        if (wr == 1) PG8_BAR;
        PG8_WAIT_V(4); PG8_BAR;
        PG8_STAGE(PG8_SB(1, 0), cB + kstep, voffB); PG8_STAGE(PG8_SA(1, 0), cA + kstep, voffA); PG8_STAGE(PG8_SB(1, 1), cB + hstep + kstep, voffB);
        PG8_WAIT_V(6); PG8_BAR;
    }
    for (;;) {
        const bool has_next = S.next(ui + 1, nxt);
        const char* nA = has_next ? S.a_ptr(nxt) : cA; const char* nB = has_next ? S.b_ptr(nxt) : cB;
        for (int t = 0; t < nt; t += 2) {
            const bool last = (t == nt - 2);
            const char* a1 = cA + (size_t)(t + 1) * kstep;
            const char* a2 = last ? nA : cA + (size_t)(t + 2) * kstep; const char* b2 = last ? nB : cB + (size_t)(t + 2) * kstep;
            const char* a3 = a2 + kstep; const char* b3 = b2 + kstep;
            if constexpr (SP2) {
            PG8_LDB(B0, 0, 0); PG8_LDB(B1, 0, 1); PG8_SCHED; PG8_LDA(At, 0, 0); PG8_STAGE(PG8_SA(1, 1), a1 + hstep, voffA);
            PG8_WAIT_V(8); PG8_WAIT_L(0); PG8_BAR; PG8_MMA(0, 0, At, B0); PG8_MMA(0, 1, At, B1); PG8_BAR; PG8_SCHED;
            PG8_LDA(At, 0, 1); PG8_STAGE(PG8_SB(0, 0), b2, voffB); PG8_STAGE(PG8_SB(0, 1), b2 + hstep, voffB); PG8_STAGE(PG8_SA(0, 0), a2, voffA);
            PG8_WAIT_V(8); PG8_WAIT_L(0); PG8_BAR; PG8_MMA(1, 0, At, B0); PG8_MMA(1, 1, At, B1); PG8_BAR; PG8_SCHED;
            PG8_LDB(B0, 1, 0); PG8_LDB(B1, 1, 1); PG8_SCHED; PG8_LDA(At, 1, 0); PG8_STAGE(PG8_SA(0, 1), a2 + hstep, voffA);
            PG8_WAIT_V(8); PG8_WAIT_L(0); PG8_BAR; PG8_MMA(0, 0, At, B0); PG8_MMA(0, 1, At, B1); PG8_BAR; PG8_SCHED;
            PG8_LDA(At, 1, 1); PG8_STAGE(PG8_SB(1, 0), b3, voffB); PG8_STAGE(PG8_SB(1, 1), b3 + hstep, voffB); PG8_STAGE(PG8_SA(1, 0), a3, voffA);
            PG8_WAIT_V(8); PG8_WAIT_L(0); PG8_BAR; PG8_MMA(1, 0, At, B0); PG8_MMA(1, 1, At, B1); PG8_BAR; PG8_SCHED;
            } else {
            PG8_LDB(B0, 0, 0); PG8_SCHED; PG8_LDA(At, 0, 0); PG8_STAGE(PG8_SA(1, 1), a1 + hstep, voffA);
            PG8_WAIT_L(8); PG8_BAR; PG8_WAIT_L(0); PG8_MMA(0, 0, At, B0); PG8_BAR; PG8_SCHED;
            PG8_LDB(B1, 0, 1); PG8_STAGE(PG8_SB(0, 0), b2, voffB);
            PG8_BAR; PG8_WAIT_L(0); PG8_MMA(0, 1, At, B1); PG8_BAR;
            PG8_LDA(At, 0, 1); PG8_STAGE(PG8_SA(0, 0), a2, voffA);
            PG8_BAR; PG8_WAIT_L(0); PG8_MMA(1, 0, At, B0); PG8_BAR; PG8_SCHED;
            PG8_STAGE(PG8_SB(0, 1), b2 + hstep, voffB);
            PG8_WAIT_V(6); PG8_BAR; PG8_MMA(1, 1, At, B1); PG8_BAR;
            PG8_LDB(B0, 1, 0); PG8_SCHED; PG8_LDA(At, 1, 0); PG8_STAGE(PG8_SA(0, 1), a2 + hstep, voffA);
            PG8_WAIT_L(8); PG8_BAR; PG8_WAIT_L(0); PG8_MMA(0, 0, At, B0); PG8_BAR; PG8_SCHED;
            PG8_LDB(B1, 1, 1); PG8_STAGE(PG8_SB(1, 0), b3, voffB);
            PG8_BAR; PG8_WAIT_L(0); PG8_MMA(0, 1, At, B1); PG8_BAR;
            PG8_LDA(At, 1, 1); PG8_STAGE(PG8_SA(1, 0), a3, voffA);
            PG8_BAR; PG8_WAIT_L(0); PG8_MMA(1, 0, At, B0); PG8_BAR; PG8_SCHED;
            PG8_STAGE(PG8_SB(1, 1), b3 + hstep, voffB);
            PG8_WAIT_V(6); PG8_BAR; PG8_MMA(1, 1, At, B1); PG8_BAR;
            }
        }
        if constexpr (ALIGN_EPI) { if (wr == 0) PG8_BAR; }
        if constexpr (!Epi::AFTER_DRAIN) { E(acc, cur, wr, wc, fr, fq); }
        if (!has_next) break;
        if constexpr (Epi::KEEPS) {
            E.rescale(acc, cur, wr, wc, fr, fq);
        } else {
#pragma unroll
            for (int a = 0; a < 2; ++a)
#pragma unroll
                for (int b = 0; b < 2; ++b)
#pragma unroll
                    for (int m = 0; m < 4; ++m)
#pragma unroll
                        for (int n = 0; n < 2; ++n) acc[a][b][m][n] = (f32x4){0.f, 0.f, 0.f, 0.f};
        }
        cur = nxt; cA = nA; cB = nB; ++ui;
        if constexpr (ALIGN_EPI) { if (wr == 1) PG8_BAR; }
    }
    PG8_WAIT_V(0);
    if constexpr (!ALIGN_EPI) { if (wr == 0) PG8_BAR; }
    PG8_BAR;
    if constexpr (Epi::AFTER_DRAIN) { E.fused(acc, cur, wr, wc, fr, fq, lds, wid, lane); }
#undef PG8_SA
#undef PG8_SB
#undef PG8_STAGE
#undef PG8_LDA
#undef PG8_LDB
#undef PG8_MMA
#undef PG8_WAIT_V
#undef PG8_WAIT_L
#undef PG8_BAR
#undef PG8_SCHED
}

__device__ __forceinline__ u32x4 pack8(const f32x4 a, const f32x4 b) { u32x4 w; w.x = cvt_pk_bf16(a[0], a[1]); w.y = cvt_pk_bf16(a[2], a[3]); w.z = cvt_pk_bf16(b[0], b[1]); w.w = cvt_pk_bf16(b[2], b[3]); return w; }

struct EpiP1a {
    static constexpr bool PERM = true, AFTER_DRAIN = false, KEEPS = false;
    const float* ssq; bf16_t *BA, *V, *XBp, *GG;
    __device__ __forceinline__ bool keep(const Unit&) const { return false; }
    __device__ __forceinline__ void operator()(f32x4 (&acc)[2][2][4][2], const Unit& u, int wr, int wc, int fr, int fq) const {
        const int row0 = u.pm * BM + wr * 64 + fr;
        const int pn = u.pn;
        if (pn >= 4 && pn < 12) {
            const int col = (pn - 4) * 128 + wc * 32 + 8 * fq;
#pragma unroll
            for (int ai = 0; ai < 2; ++ai)
#pragma unroll
                for (int m = 0; m < 4; ++m) { const int row = row0 + ai * HALF + m * 16; const float r = rstd_of(ssq, row), r2 = r * r;
                    const f32x4 v0 = acc[ai][0][m][0] * acc[ai][1][m][0] * r2, v1 = acc[ai][0][m][1] * acc[ai][1][m][1] * r2;
                    *(u32x4*)(V + (size_t)row * DM + col) = pack8(v0, v1); }
        } else {
            bf16_t* O; int colt; bool act = false;
            if (pn < 4) { O = BA; colt = pn * 256; } else if (pn < 16) { O = XBp; colt = (pn - 12) * 256; } else { O = GG; colt = (pn - 16) * 256; act = true; }
            const int col = colt + wc * 32 + 8 * fq;
#pragma unroll
            for (int ai = 0; ai < 2; ++ai)
#pragma unroll
                for (int m = 0; m < 4; ++m) { const int row = row0 + ai * HALF + m * 16; const float r = rstd_of(ssq, row);
#pragma unroll
                    for (int bj = 0; bj < 2; ++bj) { f32x4 v0 = acc[ai][bj][m][0] * r, v1 = acc[ai][bj][m][1] * r;
                        if (act) {
#pragma unroll
                            for (int i = 0; i < 4; ++i) { v0[i] = gelu_tanh(v0[i]); v1[i] = gelu_tanh(v1[i]); } }
                        *(u32x4*)(O + (size_t)row * DM + col + bj * HALF) = pack8(v0, v1); } }
        }
    }
};
struct EpiP4 {
    static constexpr bool PERM = true, AFTER_DRAIN = false, KEEPS = true;
    const float* ssq; const float* gbias;
    bf16_t *RA, *SB, *MG;
    __device__ __forceinline__ bool keep(const Unit& u) const { return u.kind == 1; }
    __device__ __forceinline__ void operator()(f32x4 (&acc)[2][2][4][2], const Unit& u, int wr, int wc, int fr, int fq) const {
        const int row0 = u.pm * BM + wr * 64 + fr;
        if (u.kind == 0) {
            const int col = u.pn * 128 + wc * 32 + 8 * fq;
#pragma unroll
            for (int ai = 0; ai < 2; ++ai)
#pragma unroll
                for (int m = 0; m < 4; ++m) { const int row = row0 + ai * HALF + m * 16; const float r = rstd_of(ssq, row);
                    unsigned wra[4], wsb[4];
#pragma unroll
                    for (int n = 0; n < 2; ++n) {
                        const f32x4 ba = *(const f32x4*)(gbias + col + 4 * n), bb = *(const f32x4*)(gbias + DM + col + 4 * n);
                        float ra[4], sb[4];
#pragma unroll
                        for (int i = 0; i < 4; ++i) {
                            float p = acc[ai][0][m][n][i] * r + ba[i], q = acc[ai][1][m][n][i] * r + bb[i];
                            p = fminf(fmaxf(p, -30.f), 30.f); q = fminf(fmaxf(q, -30.f), 30.f);
                            const float ep = 1.0f + fast_exp(-p), eq = 1.0f + fast_exp(-q);
                            ra[i] = eq * __builtin_amdgcn_rcpf(ep); sb[i] = __builtin_amdgcn_rcpf(eq); }
                        wra[2 * n] = cvt_pk_bf16(ra[0], ra[1]); wra[2 * n + 1] = cvt_pk_bf16(ra[2], ra[3]);
                        wsb[2 * n] = cvt_pk_bf16(sb[0], sb[1]); wsb[2 * n + 1] = cvt_pk_bf16(sb[2], sb[3]); }
                    *(u32x4*)(RA + (size_t)row * DM + col) = (u32x4){wra[0], wra[1], wra[2], wra[3]};
                    *(u32x4*)(SB + (size_t)row * DM + col) = (u32x4){wsb[0], wsb[1], wsb[2], wsb[3]};
                    asm volatile("" ::: "memory"); }
        } else if (u.kind == 2) {
            const int col = u.pn * 256 + wc * 32 + 8 * fq;
#pragma unroll
            for (int ai = 0; ai < 2; ++ai)
#pragma unroll
                for (int m = 0; m < 4; ++m) { const int row = row0 + ai * HALF + m * 16;
#pragma unroll
                    for (int bj = 0; bj < 2; ++bj) { const u32x4 g = *(const u32x4*)(SB + (size_t)row * DM + col + bj * HALF);
                        const f32x4 g0 = {bflo(g.x), bfhi(g.x), bflo(g.y), bfhi(g.y)}, g1 = {bflo(g.z), bfhi(g.z), bflo(g.w), bfhi(g.w)};
                        *(u32x4*)(MG + (size_t)row * DM + col + bj * HALF) = pack8(acc[ai][bj][m][0] * g0, acc[ai][bj][m][1] * g1); }
                    asm volatile("" ::: "memory"); }
        }
    }
    __device__ __forceinline__ void rescale(f32x4 (&acc)[2][2][4][2], const Unit& u, int wr, int wc, int fr, int fq) const {
        const int row0 = u.pm * BM + wr * 64 + fr, col = (u.pn & 3) * 256 + wc * 32 + 8 * fq;
        const bool k1 = (u.kind == 1);
#pragma unroll
        for (int ai = 0; ai < 2; ++ai)
#pragma unroll
            for (int m = 0; m < 4; ++m) { const int row = row0 + ai * HALF + m * 16;
#pragma unroll
                for (int bj = 0; bj < 2; ++bj) { const u32x4 g = *(const u32x4*)(RA + (size_t)row * DM + col + bj * HALF);
                    f32x4 g0 = {bflo(g.x), bfhi(g.x), bflo(g.y), bfhi(g.y)}, g1 = {bflo(g.z), bfhi(g.z), bflo(g.w), bfhi(g.w)};
#pragma unroll
                    for (int i = 0; i < 4; ++i) { g0[i] = k1 ? g0[i] : 0.f; g1[i] = k1 ? g1[i] : 0.f; }
                    acc[ai][bj][m][0] = acc[ai][bj][m][0] * g0; acc[ai][bj][m][1] = acc[ai][bj][m][1] * g1; }
                asm volatile("" ::: "memory"); }
    }
};
struct EpiP6 {
    static constexpr bool PERM = true, AFTER_DRAIN = false, KEEPS = false;
    const float* ssq; bf16_t* H;
    __device__ __forceinline__ bool keep(const Unit&) const { return false; }
    __device__ __forceinline__ void operator()(f32x4 (&acc)[2][2][4][2], const Unit& u, int wr, int wc, int fr, int fq) const {
        const int row0 = u.pm * BM + wr * 64 + fr, col = u.pn * 128 + wc * 32 + 8 * fq;
#pragma unroll
        for (int ai = 0; ai < 2; ++ai)
#pragma unroll
            for (int m = 0; m < 4; ++m) { const int row = row0 + ai * HALF + m * 16; const float r = rstd_of(ssq, row);
                f32x4 h[2];
#pragma unroll
                for (int n = 0; n < 2; ++n)
#pragma unroll
                    for (int i = 0; i < 4; ++i) { const float g = acc[ai][0][m][n][i] * r, uu = acc[ai][1][m][n][i] * r;
                        h[n][i] = g * uu * __builtin_amdgcn_rcpf(1.0f + fast_exp(-g)); }
                *(u32x4*)(H + (size_t)row * DFF + col) = pack8(h[0], h[1]); }
    }
};
struct EpiRes {
    static constexpr bool PERM = false, AFTER_DRAIN = true, KEEPS = false;
    const float* base; float* X; bf16_t* XBo; float* ssq;
    __device__ __forceinline__ bool keep(const Unit&) const { return false; }
    __device__ __forceinline__ void fused(f32x4 (&acc)[2][2][4][2], const Unit& u, int wr, int wc, int fr, int fq, LAS unsigned char* lds, int wid, int lane) const {
        LAS float* P = (LAS float*)lds;
        const int col0 = u.pn * BM + wc * 32 + 4 * fq;
#pragma unroll
        for (int ai = 0; ai < 2; ++ai)
#pragma unroll
            for (int m = 0; m < 4; ++m) { const int rl = ai * HALF + wr * 64 + m * 16 + fr; const size_t off = (size_t)(u.pm * BM + rl) * DM + col0;
                f32x4 bs[2][2];
#pragma unroll
                for (int bj = 0; bj < 2; ++bj)
#pragma unroll
                    for (int n = 0; n < 2; ++n) bs[bj][n] = *(const f32x4*)(base + off + bj * HALF + n * 16);
                float ss = 0.f;
#pragma unroll
                for (int bj = 0; bj < 2; ++bj)
#pragma unroll
                    for (int n = 0; n < 2; ++n) { const f32x4 xn = bs[bj][n] + acc[ai][bj][m][n];
                        *(f32x4*)(X + off + bj * HALF + n * 16) = xn;
                        u32x2 w; w.x = cvt_pk_bf16(xn[0], xn[1]); w.y = cvt_pk_bf16(xn[2], xn[3]);
                        *(u32x2*)(XBo + off + bj * HALF + n * 16) = w;
                        ss += (xn[0] * xn[0] + xn[1] * xn[1]) + (xn[2] * xn[2] + xn[3] * xn[3]); }
                ss += __shfl_xor(ss, 16); ss += __shfl_xor(ss, 32);
                if (fq == 0) P[rl * 4 + wc] = ss;
                asm volatile("" ::: "memory"); }
        asm volatile("s_waitcnt lgkmcnt(0)" ::: "memory"); __builtin_amdgcn_s_barrier(); asm volatile("" ::: "memory");
        const int t = wid * 64 + lane;
        if (t < 256) { const f32x4 p = *(const LAS f32x4*)(P + t * 4); ssq[(size_t)(u.pm * BM + t) * 4 + u.pn] = (p.x + p.y) + (p.z + p.w); }
        asm volatile("s_waitcnt lgkmcnt(0)" ::: "memory"); __builtin_amdgcn_s_barrier(); asm volatile("" ::: "memory");
    }
};
}

struct Frame {
    LAS unsigned char* lds;
    volatile LAS unsigned* MISC;
    int tid, lane, wave, vcu, G, bx;
};
__device__ __forceinline__ Frame make_frame(LAS unsigned char* lds) {
    Frame F; int tid = threadIdx.x, bx = blockIdx.x, G = gridDim.x;
    asm volatile("" : "+v"(tid), "+s"(bx), "+s"(G));
    F.lds = lds; F.MISC = (volatile LAS unsigned*)(lds + MISC_OFF);
    F.tid = tid; F.lane = tid & 63; F.wave = __builtin_amdgcn_readfirstlane(tid >> 6);
    F.G = G; F.bx = bx; F.vcu = (G % 8 == 0) ? (bx % 8) * (G / 8) + bx / 8 : bx;
    return F;
}
struct Args { const float* in[20]; float* out; unsigned char* ws; int ph_lo, ph_hi; };
#define CAS __attribute__((address_space(4)))
typedef const CAS Args* KArgs;
__device__ __forceinline__ KArgs kargs() { KArgs p = (KArgs)__builtin_amdgcn_kernarg_segment_ptr(); asm volatile("" : "+s"(p)); return p; }
enum { I_X = 0, I_LN1 = 1, I_WIN = 2, I_CAW = 3, I_CBW = 4, I_CBB = 5, I_LWA = 6, I_LBA = 7, I_LWX = 8, I_LBX = 9, I_LAM = 10, I_WOA = 11, I_WOB = 12, I_GB = 13, I_WO = 14, I_LN2 = 15, I_WG = 16, I_WU = 17, I_WD = 18, I_FG = 19 };

__device__ __forceinline__ float wave_sum(float v) {
#pragma unroll
    for (int o = 1; o < 64; o <<= 1) v += __shfl_xor(v, o);
    return v;
}

__device__ __forceinline__ void tr_item(const float* W, int K, int N, bf16_t* WT, int drow, const float* gk, LAS float* scr, int k0, int n0, int lane) {
#pragma unroll 8
    for (int i = 0; i < 32; ++i) { const int kk = 2 * i + (lane >> 5); float v = W[(size_t)(k0 + kk) * N + n0 + (lane & 31)]; if (gk) v *= gk[k0 + kk]; scr[kk * 33 + (lane & 31)] = v; }
    LDS_WAIT(); asm volatile("" ::: "memory");
    const int c = lane & 7;
#pragma unroll
    for (int j = 0; j < 4; ++j) { const int n = (lane >> 3) + 8 * j; const LAS float* s = scr + (8 * c) * 33 + n;
        u32x4 o; o.x = pk2(s[0 * 33], s[1 * 33]); o.y = pk2(s[2 * 33], s[3 * 33]); o.z = pk2(s[4 * 33], s[5 * 33]); o.w = pk2(s[6 * 33], s[7 * 33]);
        *(GAS u32x4*)(WT + (size_t)(drow + n) * K + k0 + 8 * c) = o; }
    LDS_WAIT(); asm volatile("" ::: "memory");
}
__device__ __forceinline__ int win_row(int n0) {
    const int seg = n0 >> 10, o = n0 & 1023, j = o >> 7, i = o & 127;
    switch (seg) {
        case 0: return o;
        case 1: return 1024 + 256 * j + i;
        case 2: return 1024 + 256 * j + 128 + i;
        case 3: return 3072 + o;
        case 4: return 4096 + o;
        case 5: return ROW_GG + 256 * j + i;
        default: return ROW_GG + 256 * j + 128 + i;
    }
}
__device__ __forceinline__ void p0_weights(Frame& F, int l) {
    KArgs a = kargs();
    unsigned char* ws = a->ws;
    LAS float* scr = (LAS float*)(F.lds + F.wave * 16384);
    const int gw = F.vcu * NWAVES + F.wave, NGW = F.G * NWAVES;
    constexpr int I_IN = (DM / 64) * (NIN / 32), I_SQ = (DM / 64) * (DM / 32), I_FF = (DM / 64) * (DFF / 32), I_DN = (DFF / 64) * (DM / 32), I_LR = 16 * 2;
    constexpr int NITEMS = I_IN + 3 * I_SQ + 2 * I_FF + I_DN + 2 * I_LR;
    const float* ln1 = a->in[I_LN1] + (size_t)l * DM; const float* ln2 = a->in[I_LN2] + (size_t)l * DM;
    for (int it = gw; it < NITEMS; it += NGW) {
        int r = it;
        if (r < I_IN) { const int nblk = NIN / 32, kb = r / nblk, nb = r % nblk; tr_item(a->in[I_WIN] + (size_t)l * DM * NIN, DM, NIN, (bf16_t*)(ws + WS_WIN), win_row(nb * 32), ln1, scr, kb * 64, nb * 32, F.lane); continue; } r -= I_IN;
        if (r < I_SQ) { const int nblk = DM / 32, kb = r / nblk, nb = r % nblk; tr_item(a->in[I_WOA] + (size_t)l * DM * DM, DM, DM, (bf16_t*)(ws + WS_WOA), nb * 32, nullptr, scr, kb * 64, nb * 32, F.lane); continue; } r -= I_SQ;
        if (r < I_SQ) { const int nblk = DM / 32, kb = r / nblk, nb = r % nblk; tr_item(a->in[I_WOB] + (size_t)l * DM * DM, DM, DM, (bf16_t*)(ws + WS_WOB), nb * 32, nullptr, scr, kb * 64, nb * 32, F.lane); continue; } r -= I_SQ;
        if (r < I_SQ) { const int nblk = DM / 32, kb = r / nblk, nb = r % nblk; tr_item(a->in[I_WO] + (size_t)l * DM * DM, DM, DM, (bf16_t*)(ws + WS_WO), nb * 32, nullptr, scr, kb * 64, nb * 32, F.lane); continue; } r -= I_SQ;
        if (r < I_FF) { const int nblk = DFF / 32, kb = r / nblk, nb = r % nblk, n0 = nb * 32; tr_item(a->in[I_WG] + (size_t)l * DM * DFF, DM, DFF, (bf16_t*)(ws + WS_WGU), 256 * (n0 >> 7) + (n0 & 127), ln2, scr, kb * 64, n0, F.lane); continue; } r -= I_FF;
        if (r < I_FF) { const int nblk = DFF / 32, kb = r / nblk, nb = r % nblk, n0 = nb * 32; tr_item(a->in[I_WU] + (size_t)l * DM * DFF, DM, DFF, (bf16_t*)(ws + WS_WGU), 256 * (n0 >> 7) + 128 + (n0 & 127), ln2, scr, kb * 64, n0, F.lane); continue; } r -= I_FF;
        if (r < I_DN) { const int nblk = DM / 32, kb = r / nblk, nb = r % nblk; tr_item(a->in[I_WD] + (size_t)l * DFF * DM, DFF, DM, (bf16_t*)(ws + WS_WD), nb * 32, nullptr, scr, kb * 64, nb * 32, F.lane); continue; } r -= I_DN;
        if (r < I_LR) { const int h = r >> 1, nb = r & 1; tr_item(a->in[I_LWA] + ((size_t)l * NHEAD + h) * HD * HD, HD, HD, (bf16_t*)(ws + WS_LRU) + (size_t)h * HD * HD, nb * 32, nullptr, scr, 0, nb * 32, F.lane); continue; } r -= I_LR;
        { const int h = r >> 1, nb = r & 1; tr_item(a->in[I_LWX] + ((size_t)l * NHEAD + h) * HD * HD, HD, HD, (bf16_t*)(ws + WS_LRU) + (size_t)(NHEAD + h) * HD * HD, nb * 32, nullptr, scr, 0, nb * 32, F.lane); }
    }
}
__device__ __forceinline__ void p0_x(Frame& F) {
    KArgs a = kargs();
    const int gw = F.vcu * NWAVES + F.wave, NGW = F.G * NWAVES;
    const float* x = a->in[I_X]; bf16_t* XB = (bf16_t*)(a->ws + WS_S0); float* ssq = (float*)(a->ws + WS_SSQ);
    for (int m = gw; m < M; m += NGW) {
        const GAS f32x4* xr = (const GAS f32x4*)(x + (size_t)m * DM) + F.lane;
        f32x4 v[4]; float s = 0.f;
#pragma unroll
        for (int j = 0; j < 4; ++j) { v[j] = xr[64 * j]; s += (v[j].x * v[j].x + v[j].y * v[j].y) + (v[j].z * v[j].z + v[j].w * v[j].w); }
        s = wave_sum(s);
        GAS u32x2* o8 = (GAS u32x2*)(XB + (size_t)m * DM) + F.lane;
#pragma unroll
        for (int j = 0; j < 4; ++j) { u32x2 w; w.x = pk2(v[j].x, v[j].y); w.y = pk2(v[j].z, v[j].w); o8[64 * j] = w; }
        if (F.lane == 0) *(f32x4*)(ssq + (size_t)m * 4) = (f32x4){s, 0.f, 0.f, 0.f};
    }
}
__device__ __forceinline__ void p8_final(Frame& F) {
    KArgs a = kargs();
    const int gw = F.vcu * NWAVES + F.wave, NGW = F.G * NWAVES;
    float* X = a->out; const float* ssq = (const float*)(a->ws + WS_SSQ); const float* g = a->in[I_FG];
    f32x4 gv[4];
#pragma unroll
    for (int j = 0; j < 4; ++j) gv[j] = *((const f32x4*)g + F.lane + 64 * j);
    for (int m = gw; m < M; m += NGW) {
        const float r = rstd_of(ssq, m);
        GAS f32x4* xr = (GAS f32x4*)(X + (size_t)m * DM) + F.lane;
#pragma unroll
        for (int j = 0; j < 4; ++j) { const f32x4 v = xr[64 * j]; xr[64 * j] = v * r * gv[j]; }
    }
}

__device__ __forceinline__ void unpack8(const u32x4 w, float (&f)[8]) { f[0] = bflo(w.x); f[1] = bfhi(w.x); f[2] = bflo(w.y); f[3] = bfhi(w.y); f[4] = bflo(w.z); f[5] = bfhi(w.z); f[6] = bflo(w.w); f[7] = bfhi(w.w); }
__device__ __forceinline__ void p2_mixer_a(Frame& F, int l) {
    KArgs a = kargs();
    bf16_t* BA = (bf16_t*)(a->ws + WS_S1); const bf16_t* V = (const bf16_t*)(a->ws + WS_S2);
    const float* cw = a->in[I_CAW] + (size_t)l * 3 * DM;
    constexpr int RB = 16, NTASK = (M / RB) * (DM / 8);
    for (int task = F.vcu * (NWAVES * 64) + F.tid; task < NTASK; task += F.G * NWAVES * 64) {
        const int cg = task & 127, rb = task >> 7, c0 = cg * 8, t0 = rb * RB;
        float w0[8], w1[8], w2[8];
#pragma unroll
        for (int h = 0; h < 2; ++h) { const f32x4 q0 = *(const f32x4*)(cw + c0 + 4 * h), q1 = *(const f32x4*)(cw + DM + c0 + 4 * h), q2 = *(const f32x4*)(cw + 2 * DM + c0 + 4 * h);
#pragma unroll
            for (int i = 0; i < 4; ++i) { w0[4 * h + i] = q0[i]; w1[4 * h + i] = q1[i]; w2[4 * h + i] = q2[i]; } }
        float vm2[8], vm1[8];
        const bool first = (t0 % SEQ) == 0;
        if (first) {
#pragma unroll
            for (int i = 0; i < 8; ++i) { vm2[i] = 0.f; vm1[i] = 0.f; }
        } else { unpack8(*(const u32x4*)(V + (size_t)(t0 - 2) * DM + c0), vm2); unpack8(*(const u32x4*)(V + (size_t)(t0 - 1) * DM + c0), vm1); }
#pragma unroll 4
        for (int r = 0; r < RB; ++r) {
            float v[8], b[8];
            unpack8(*(const u32x4*)(V + (size_t)(t0 + r) * DM + c0), v);
            unpack8(*(const u32x4*)(BA + (size_t)(t0 + r) * DM + c0), b);
            float o[8];
#pragma unroll
            for (int i = 0; i < 8; ++i) { o[i] = b[i] * (w0[i] * vm2[i] + w1[i] * vm1[i] + w2[i] * v[i]); vm2[i] = vm1[i]; vm1[i] = v[i]; }
            u32x4 w; w.x = pk2(o[0], o[1]); w.y = pk2(o[2], o[3]); w.z = pk2(o[4], o[5]); w.w = pk2(o[6], o[7]);
            *(u32x4*)(BA + (size_t)(t0 + r) * DM + c0) = w;
        }
    }
}

constexpr int MX_WAVE_BYTES = 12288, MX_UB = 0, MX_SA = 2048, MX_SB = 6144, MX_GT = 10240, MX_WS = 8 * MX_WAVE_BYTES;
template <bool APPLY>
__device__ __forceinline__ void mixer_b(Frame& F, int l) {
    KArgs a = kargs();
    const int lane = F.lane, w = F.wave;
    const bf16_t* XBp = (const bf16_t*)(a->ws + WS_S3); bf16_t* GG = (bf16_t*)(a->ws + WS_S4);
    f32x2* SUM = (f32x2*)(a->ws + WS_SUM);
    const bf16_t* WaT = (const bf16_t*)(a->ws + WS_LRU); const bf16_t* WxT = WaT + (size_t)NHEAD * HD * HD;
    LAS unsigned char* wl = F.lds + w * MX_WAVE_BYTES;
    LAS float* SA = (LAS float*)(wl + MX_SA); LAS float* SBm = (LAS float*)(wl + MX_SB);
    const int c = F.bx, head = c & 15;
    for (int i = 0;; ++i) {
        const int U = c + F.G * i; if (U >= BATCH * 64 * NHEAD) break;
        const int hd = U & 15, ck = (U >> 4) & 63, b = U >> 10;
        const int par = i & 1;
        LAS f32x2* WSA = (LAS f32x2*)(F.lds + MX_WS + par * 8192);
        LAS f32x2* WSB = (LAS f32x2*)(F.lds + MX_WS + par * 8192 + 4096);
        const int tb = b * SEQ + ck * 128 + w * 16;
        const int chb = hd * HD;
        u32x4 gt[2]; f32x2 ps[8];
        if (APPLY) {
#pragma unroll
            for (int e = 0; e < 2; ++e) gt[e] = *(const u32x4*)(GG + (size_t)(tb + (lane >> 3) + 8 * e) * DM + chb + 8 * (lane & 7));
#pragma unroll
            for (int j = 0; j < 8; ++j) { const int cj = w * 8 + j; ps[j] = (cj < ck) ? SUM[((size_t)(b * 64 + cj)) * DM + chb + lane] : (f32x2){1.f, 0.f}; }
        }
        {
            const int g = lane & 7, tr = lane >> 3, ch0 = chb + 8 * g;
            const float* cbw = a->in[I_CBW] + (size_t)l * 4 * DM + ch0; const float* cbb = a->in[I_CBB] + (size_t)l * DM + ch0;
            float xr[5][8];
#pragma unroll
            for (int k = 0; k < 5; ++k) { const int row = tb + 2 * tr - 3 + k;
                if (row >= b * SEQ) unpack8(*(const u32x4*)(XBp + (size_t)row * DM + ch0), xr[k]);
                else {
#pragma unroll
                    for (int i2 = 0; i2 < 8; ++i2) xr[k][i2] = 0.f; } }
            float u0[8], u1[8];
#pragma unroll
            for (int h2 = 0; h2 < 2; ++h2) { const f32x4 bb = *(const f32x4*)(cbb + 4 * h2);
#pragma unroll
                for (int i2 = 0; i2 < 4; ++i2) { u0[4 * h2 + i2] = bb[i2]; u1[4 * h2 + i2] = bb[i2]; } }
#pragma unroll
            for (int k = 0; k < 4; ++k)
#pragma unroll
                for (int h2 = 0; h2 < 2; ++h2) { const f32x4 wk = *(const f32x4*)(cbw + (size_t)k * DM + 4 * h2);
#pragma unroll
                    for (int i2 = 0; i2 < 4; ++i2) { u0[4 * h2 + i2] += wk[i2] * xr[k][4 * h2 + i2]; u1[4 * h2 + i2] += wk[i2] * xr[k + 1][4 * h2 + i2]; } }
            const int tk0 = 2 * tr, tk1 = 2 * tr + 1;
            u32x4 p0, p1; p0.x = pk2(u0[0], u0[1]); p0.y = pk2(u0[2], u0[3]); p0.z = pk2(u0[4], u0[5]); p0.w = pk2(u0[6], u0[7]);
            p1.x = pk2(u1[0], u1[1]); p1.y = pk2(u1[2], u1[3]); p1.z = pk2(u1[4], u1[5]); p1.w = pk2(u1[6], u1[7]);
            *(LAS u32x4*)(wl + MX_UB + tk0 * 128 + ((g ^ (tk0 & 7)) * 16)) = p0;
            *(LAS u32x4*)(wl + MX_UB + tk1 * 128 + ((g ^ (tk1 & 7)) * 16)) = p1;
            if (APPLY) {
#pragma unroll
                for (int e = 0; e < 2; ++e) *(LAS u32x4*)(wl + MX_GT + ((lane >> 3) + 8 * e) * 128 + (lane & 7) * 16) = gt[e];
            }
        }
        LDS_WAIT(); asm volatile("" ::: "memory");
        {
            const int tokA = lane & 15, kq = lane >> 4, cc = lane & 15;
            bf16x8 Af[2];
#pragma unroll
            for (int s = 0; s < 2; ++s) Af[s] = *(const LAS bf16x8*)(wl + MX_UB + tokA * 128 + (((4 * s + kq) ^ (tokA & 7)) * 16));
            const float* lba = a->in[I_LBA] + (size_t)l * DM + chb; const float* lbx = a->in[I_LBX] + (size_t)l * DM + chb; const float* lam = a->in[I_LAM] + (size_t)l * DM + chb;
#pragma unroll
            for (int n = 0; n < 4; ++n) {
                const int e = 16 * n + cc;
                f32x4 aR = {0.f, 0.f, 0.f, 0.f}, aI = {0.f, 0.f, 0.f, 0.f}, aU = {0.f, 0.f, 0.f, 0.f};
#pragma unroll
                for (int s = 0; s < 2; ++s) {
                    const bf16x8 bR = *(const bf16x8*)(WaT + ((size_t)hd * HD + e) * HD + 32 * s + 8 * kq);
                    const bf16x8 bI = *(const bf16x8*)(WxT + ((size_t)hd * HD + e) * HD + 32 * s + 8 * kq);
                    aR = __builtin_amdgcn_mfma_f32_16x16x32_bf16(Af[s], bR, aR, 0, 0, 0);
                    aI = __builtin_amdgcn_mfma_f32_16x16x32_bf16(Af[s], bI, aI, 0, 0, 0);
                }
                { bf16x8 id; const int kk0 = 8 * kq - 16 * (n & 1);
#pragma unroll
                  for (int j = 0; j < 8; ++j) id[j] = (kk0 + j == cc) ? (short)0x3f80 : (short)0;
                  aU = __builtin_amdgcn_mfma_f32_16x16x32_bf16(Af[n >> 1], id, aU, 0, 0, 0); }
                const float ba_ = lba[e], bx_ = lbx[e];
                const float kk = -8.0f * log1pf(__expf(-lam[e])) * 1.4426950408889634f;
#pragma unroll
                for (int r = 0; r < 4; ++r) {
                    const float rg = fast_sigmoid(aR[r] + ba_), ig = fast_sigmoid(aI[r] + bx_);
                    const float av = __builtin_amdgcn_exp2f(rg * kk);
                    const float bv = __builtin_amdgcn_sqrtf(fmaxf(1.0f - av * av, 0.f)) * (ig * aU[r]);
                    const int tok = 4 * kq + r;
                    SA[tok * 64 + e] = av; SBm[tok * 64 + e] = bv;
                }
            }
        }
        LDS_WAIT(); asm volatile("" ::: "memory");
        float Pw = 1.f, Hw = 0.f;
#pragma unroll
        for (int t = 0; t < 16; ++t) { const float av = SA[t * 64 + lane], bv = SBm[t * 64 + lane]; Hw = av * Hw + bv; Pw *= av; }
        WSA[w * 64 + lane] = (f32x2){Pw, Hw};
        if (APPLY) {
            float Pp = 1.f, Hp = 0.f;
#pragma unroll
            for (int j = 0; j < 8; ++j) { Hp = ps[j].x * Hp + ps[j].y; Pp *= ps[j].x; }
            WSB[w * 64 + lane] = (f32x2){Pp, Hp};
        }
        LDS_WAIT(); __syncthreads();
        if (!APPLY) {
            if (w == 0) { float Pu = 1.f, Hu = 0.f;
#pragma unroll
                for (int j = 0; j < 8; ++j) { const f32x2 s = WSA[j * 64 + lane]; Hu = s.x * Hu + s.y; Pu *= s.x; }
                SUM[((size_t)(b * 64 + ck)) * DM + chb + lane] = (f32x2){Pu, Hu}; }
        } else {
            float h = 0.f;
#pragma unroll
            for (int j = 0; j < 8; ++j) { const f32x2 s = WSB[j * 64 + lane]; h = s.x * h + s.y; }
            for (int j = 0; j < w; ++j) { const f32x2 s = WSA[j * 64 + lane]; h = s.x * h + s.y; }
            LAS unsigned short* GT = (LAS unsigned short*)(wl + MX_GT);
#pragma unroll
            for (int t = 0; t < 16; ++t) { const float av = SA[t * 64 + lane], bv = SBm[t * 64 + lane]; h = av * h + bv;
                const float gv = __builtin_bit_cast(float, (unsigned)GT[t * 64 + lane] << 16);
                GT[t * 64 + lane] = (unsigned short)f2bf(h * gv); }
            LDS_WAIT(); asm volatile("" ::: "memory");
#pragma unroll
            for (int e = 0; e < 2; ++e) { const u32x4 o = *(const LAS u32x4*)(wl + MX_GT + ((lane >> 3) + 8 * e) * 128 + (lane & 7) * 16);
                *(u32x4*)(GG + (size_t)(tb + (lane >> 3) + 8 * e) * DM + chb + 8 * (lane & 7)) = o; }
            LDS_WAIT(); asm volatile("" ::: "memory");
        }
    }
    (void)head;
}

constexpr int N_PHASES = 8 * DEPTH + 1;
__global__ void __launch_bounds__(NWAVES * 64, 2) fwd_kernel(Args args_unused) {
    extern __shared__ __attribute__((aligned(16))) unsigned char lds[];
    LAS unsigned char* const ldsb = (LAS unsigned char*)lds;
    for (int u = threadIdx.x; u < (LDS_BYTES - LDSCTL_OFF) / 4; u += NWAVES * 64) ((LAS unsigned*)(ldsb + LDSCTL_OFF))[u] = 0u;
    __syncthreads();
    int lo, hi;
    { KArgs a = kargs(); lo = a->ph_lo; hi = a->ph_hi;
      if (hi - lo > 1) (void)xcd_barrier_post((unsigned*)(a->ws + WS_CTL) + CW_BAR, (volatile LAS unsigned*)(ldsb + MISC_OFF) + 8); }
#define IN(k) (lo <= (k) && (k) < hi)
#define SEAM(k) do { if (IN(k) && IN((k) + 1)) { XcdBarrier b_; b_.bar = (unsigned*)(kargs()->ws + WS_CTL) + CW_BAR; b_.x = xb_xcc_id(); b_.st = (volatile LAS unsigned*)(ldsb + MISC_OFF) + 8; xcd_barrier(b_); } } while (0)
    constexpr size_t TS1 = (size_t)256 * DM * 2, TSF = (size_t)256 * DFF * 2;

#pragma unroll 1
    for (int l = 0; l < DEPTH; ++l) {
        const int pb = 8 * l;
        if (IN(pb + 0)) { Frame F = make_frame(ldsb); p0_weights(F, l); if (l == 0) p0_x(F); }
        SEAM(pb + 0);
        if (IN(pb + 1)) {
            Frame F = make_frame(ldsb); KArgs a = kargs(); unsigned char* ws = a->ws;
            pg8::SchedPlain S; S.so.init(M, N1A, F.G, F.bx); S.A0 = (const char*)(ws + WS_S0); S.B0 = (const char*)(ws + WS_WIN); S.tstep = TS1;
            pg8::EpiP1a E{(const float*)(ws + WS_SSQ), (bf16_t*)(ws + WS_S1), (bf16_t*)(ws + WS_S2), (bf16_t*)(ws + WS_S3), (bf16_t*)(ws + WS_S4)};
            pg8::gemm_phase<pg8::EpiP1a, pg8::SchedPlain, true, true>(F.lds, F.tid, DM, S, E);
        }
        SEAM(pb + 1);
        if (IN(pb + 2)) { { Frame F = make_frame(ldsb); p2_mixer_a(F, l); } { Frame F = make_frame(ldsb); mixer_b<false>(F, l); } }
        SEAM(pb + 2);
        if (IN(pb + 3)) { Frame F = make_frame(ldsb); mixer_b<true>(F, l); }
        SEAM(pb + 3);
        if (IN(pb + 4)) {
            Frame F = make_frame(ldsb); KArgs a = kargs(); unsigned char* ws = a->ws;
            pg8::StaticOrder so; so.init(M, DM, F.G, F.bx);
            int pm_ = 0, pn_ = 0; const bool ok_ = so.next(0, pm_, pn_);
            pg8::SchedP4 S; S.valid = ok_; S.pm = pm_; S.pn = pn_; S.ws = (const char*)ws;
            pg8::EpiP4 E{(const float*)(ws + WS_SSQ), a->in[I_GB] + (size_t)l * 2 * DM, (bf16_t*)(ws + WS_S2), (bf16_t*)(ws + WS_S3), (bf16_t*)(ws + WS_S5)};
            pg8::gemm_phase<pg8::EpiP4, pg8::SchedP4, false, true>(F.lds, F.tid, DM, S, E);
        }
        SEAM(pb + 4);
        if (IN(pb + 5)) {
            Frame F = make_frame(ldsb); KArgs a = kargs(); unsigned char* ws = a->ws;
            pg8::SchedPlain S; S.so.init(M, DM, F.G, F.bx); S.A0 = (const char*)(ws + WS_S5); S.B0 = (const char*)(ws + WS_WO); S.tstep = TS1;
            pg8::EpiRes E{l == 0 ? a->in[I_X] : a->out, a->out, (bf16_t*)(ws + WS_S0), (float*)(ws + WS_SSQ)};
            pg8::gemm_phase<pg8::EpiRes, pg8::SchedPlain, false, true>(F.lds, F.tid, DM, S, E);
        }
        SEAM(pb + 5);
        if (IN(pb + 6)) {
            Frame F = make_frame(ldsb); KArgs a = kargs(); unsigned char* ws = a->ws;
            pg8::SchedPlain S; S.so.init(M, NGU, F.G, F.bx); S.A0 = (const char*)(ws + WS_S0); S.B0 = (const char*)(ws + WS_WGU); S.tstep = TS1;
            pg8::EpiP6 E{(const float*)(ws + WS_SSQ), (bf16_t*)(ws + WS_S1)};
            pg8::gemm_phase<pg8::EpiP6, pg8::SchedPlain, true, true>(F.lds, F.tid, DM, S, E);
        }
        SEAM(pb + 6);
        if (IN(pb + 7)) {
            Frame F = make_frame(ldsb); KArgs a = kargs(); unsigned char* ws = a->ws;
            pg8::SchedPlain S; S.so.init(M, DM, F.G, F.bx); S.A0 = (const char*)(ws + WS_S1); S.B0 = (const char*)(ws + WS_WD); S.tstep = TSF;
            pg8::EpiRes E{a->out, a->out, (bf16_t*)(ws + WS_S0), (float*)(ws + WS_SSQ)};
            pg8::gemm_phase<pg8::EpiRes, pg8::SchedPlain, false, true>(F.lds, F.tid, DFF, S, E);
        }
        SEAM(pb + 7);
    }
    if (IN(8 * DEPTH)) { Frame F = make_frame(ldsb); p8_final(F); }
#undef IN
#undef SEAM
}

extern "C" void kernel_launch(void* const* d_in, const int* in_sizes, int n_in, void* d_out, int out_size, void* d_ws, size_t ws_size, hipStream_t stream) {
    static int grid = 0;
    if (grid == 0) {
        if (n_in != 20 || in_sizes[0] != M * DM || out_size != M * DM || ws_size < WS_END) {
            fprintf(stderr, "kernel_launch: unexpected shapes: n_in %d in0 %d out %d ws %zu (need %zu)\n", n_in, n_in > 0 ? in_sizes[0] : -1, out_size, ws_size, (size_t)WS_END); grid = -1; return; }
        int dev = 0, cus = 0, per_cu = 0;
        if (hipGetDevice(&dev) != hipSuccess || hipDeviceGetAttribute(&cus, hipDeviceAttributeMultiprocessorCount, dev) != hipSuccess) { grid = -1; return; }
        if (hipFuncSetAttribute((const void*)fwd_kernel, hipFuncAttributeMaxDynamicSharedMemorySize, LDS_BYTES) != hipSuccess) { fprintf(stderr, "kernel_launch: hipFuncSetAttribute failed\n"); grid = -1; return; }
        if (hipOccupancyMaxActiveBlocksPerMultiprocessor(&per_cu, (const void*)fwd_kernel, NWAVES * 64, LDS_BYTES) != hipSuccess || per_cu < 1)
            fprintf(stderr, "kernel_launch: occupancy query reports %d workgroups per CU\n", per_cu);
        (void)hipGetLastError();
        grid = cus;
        if (grid != 256) fprintf(stderr, "kernel_launch: %d CUs (built for 256)\n", grid);
    }
    if (grid < 0) return;
    (void)hipMemsetAsync((char*)d_ws + WS_CTL, 0, CTL_ZERO_BYTES, stream);
    Args a{};
    for (int i = 0; i < 20; ++i) a.in[i] = (const float*)d_in[i];
    a.out = (float*)d_out; a.ws = (unsigned char*)d_ws;
#if MK_PER_PHASE
    for (int p = 0; p < N_PHASES; ++p) { a.ph_lo = p; a.ph_hi = p + 1; hipLaunchKernelGGL(fwd_kernel, dim3(grid), dim3(NWAVES * 64), LDS_BYTES, stream, a); }
#else
    a.ph_lo = 0; a.ph_hi = N_PHASES;
    hipLaunchKernelGGL(fwd_kernel, dim3(grid), dim3(NWAVES * 64), LDS_BYTES, stream, a);
#endif
}
```

```cpp
#include <hip/hip_runtime.h>
#include <cstdio>
#include <cstdint>

#ifndef PROBE_REPEAT
#define PROBE_REPEAT -1
#endif
#ifndef MK_PER_PHASE
#define MK_PER_PHASE 0
#endif

#define LAS __attribute__((address_space(3)))
#define GAS __attribute__((address_space(1)))
typedef unsigned short bf16_t;
typedef short bf16x8 __attribute__((ext_vector_type(8)));
typedef float f32x4 __attribute__((ext_vector_type(4)));
typedef float f32x2 __attribute__((ext_vector_type(2)));
typedef unsigned u32x4 __attribute__((ext_vector_type(4)));
typedef unsigned u32x2 __attribute__((ext_vector_type(2)));
typedef GAS unsigned gu32;

constexpr int BATCH = 2, SEQ = 8192, DM = 1024, M = BATCH * SEQ, NIN = 7168, DFF = 2816, NGU = 2 * DFF, NHEAD = 16, HD = 64, DEPTH = 2;
constexpr float RMS_EPS = 1e-6f;
constexpr int NWAVES = 8;
constexpr int N1A = 5120;
constexpr int ROW_GG = 5120;

constexpr size_t MiB = 1u << 20;
constexpr size_t WS_CTL = 0, CTL_ZERO_BYTES = 1 * MiB;
constexpr size_t WS_SSQ = 1 * MiB;
constexpr size_t WS_SUM = 2 * MiB;
constexpr size_t WS_LRU = 3 * MiB;
constexpr size_t WS_SUMG = 3 * MiB + 512 * 1024;
constexpr size_t WS_WIN = 4 * MiB, WS_WOA = 18 * MiB, WS_WOB = 20 * MiB, WS_WO = 22 * MiB, WS_WGU = 24 * MiB, WS_WD = 35 * MiB;
constexpr size_t WS_S0 = 48 * MiB, SLOT = 32 * MiB;
constexpr size_t WS_S1 = WS_S0 + SLOT, WS_S2 = WS_S1 + SLOT, WS_S3 = WS_S2 + SLOT, WS_S4 = WS_S3 + SLOT, WS_S5 = WS_S4 + SLOT, WS_END = WS_S5 + SLOT;
static_assert(WS_WD + (size_t)DM * DFF * 2 <= WS_S0 && WS_END <= 256 * MiB, "d_ws map");
constexpr int CW_BAR = 4096;

constexpr int RING_BYTES = 131072;
constexpr int LDSCTL_OFF = RING_BYTES, MISC_OFF = LDSCTL_OFF + 320;
constexpr int LDS_BYTES = 147456;

#define RLX_AGENT __ATOMIC_RELAXED, __HIP_MEMORY_SCOPE_AGENT
#define LDS_WAIT() asm volatile("s_waitcnt lgkmcnt(0)" ::: "memory")
#define VM_WAIT() asm volatile("s_waitcnt vmcnt(0)" ::: "memory")
__device__ __forceinline__ unsigned f2bf(float f) { unsigned u = __builtin_bit_cast(unsigned, f); return (u + 0x7fffu + ((u >> 16) & 1u)) >> 16; }
__device__ __forceinline__ unsigned pk2(float lo, float hi) { return f2bf(lo) | (f2bf(hi) << 16); }
__device__ __forceinline__ unsigned cvt_pk_bf16(float lo, float hi) { unsigned r; asm volatile("v_cvt_pk_bf16_f32 %0, %1, %2" : "=v"(r) : "v"(lo), "v"(hi)); return r; }
__device__ __forceinline__ float bflo(unsigned w) { return __builtin_bit_cast(float, w << 16); }
__device__ __forceinline__ float bfhi(unsigned w) { return __builtin_bit_cast(float, w & 0xffff0000u); }
__device__ __forceinline__ float fast_exp(float x) { return __builtin_amdgcn_exp2f(x * 1.4426950408889634f); }
__device__ __forceinline__ float fast_sigmoid(float x) { return __builtin_amdgcn_rcpf(1.0f + fast_exp(-x)); }
__device__ __forceinline__ float gelu_tanh(float x) {
    const float z = 1.5957691216057308f * (x + 0.044715f * x * x * x);
    return x * __builtin_amdgcn_rcpf(1.0f + fast_exp(-z));
}
__device__ __forceinline__ float rstd_of(const float* ssq, int row) {
    const f32x4 s = *(const f32x4*)(ssq + (size_t)row * 4);
    return __builtin_amdgcn_rsqf(((s.x + s.y) + (s.z + s.w)) * (1.0f / DM) + RMS_EPS);
}

#define XB_TMO      128
#define XB_XCNT(j)  (256  + 64 * (j))
#define XB_XSUB(j)  (1280 + 64 * (j))
#define XB_XGEN(j)  (2304 + 64 * (j))
#define XB_TOP      3328
#define XB_TOPGEN   3392
#define XCD_BAR_WORDS 3456
#define XB_SPIN_CAP (1u << 22)
__device__ __forceinline__ unsigned xb_ld(unsigned* p)              { return __hip_atomic_load(p, __ATOMIC_RELAXED, __HIP_MEMORY_SCOPE_AGENT); }
__device__ __forceinline__ unsigned xb_add(unsigned* p, unsigned v) { return __hip_atomic_fetch_add(p, v, __ATOMIC_RELAXED, __HIP_MEMORY_SCOPE_AGENT); }
__device__ __forceinline__ unsigned xb_xcc_id() { return (unsigned)__builtin_amdgcn_s_getreg((3 << 11) | 20) & 0xFu; }
#define XB_SPIN(cond, bar) do { unsigned _sp = 0; while (cond) { __builtin_amdgcn_s_sleep(1); \
    if ((++_sp & 255u) == 0u) { if (xb_ld(&(bar)[XB_TMO])) break; if (_sp > XB_SPIN_CAP) { atomicAdd(&(bar)[XB_TMO], 1u); break; } } } } while (0)
struct XcdBarrier { unsigned* bar; unsigned x; volatile LAS unsigned* st; };
__device__ __forceinline__ XcdBarrier xcd_barrier_post(unsigned* bar, volatile LAS unsigned* st) {
    XcdBarrier b; b.bar = bar; b.x = xb_xcc_id(); b.st = st;
    if (threadIdx.x == 0) (void)xb_add(&bar[XB_XCNT(b.x)], 1u);
    return b;
}
__device__ __forceinline__ void xcd_barrier_complete(unsigned* bar, unsigned x, unsigned& nloc, unsigned& nx) {
    const unsigned G = gridDim.x * gridDim.y * gridDim.z;
    unsigned sum, cnt, mine, sp = 0u;
    for (;;) {
        sum = 0u; cnt = 0u; mine = 0u;
#pragma unroll
        for (unsigned j = 0; j < 16; ++j) { const unsigned c = xb_ld(&bar[XB_XCNT(j)]); sum += c; cnt += (c > 0u) ? 1u : 0u; mine = (j == x) ? c : mine; }
        if (sum == G) break;
        __builtin_amdgcn_s_sleep(1);
        if ((++sp & 255u) == 0u) { if (xb_ld(&bar[XB_TMO])) break; if (sp > XB_SPIN_CAP) { atomicAdd(&bar[XB_TMO], 1u); break; } }
    }
    nloc = mine > 0u ? mine : 1u; nx = cnt > 0u ? cnt : 1u;
}
__device__ __forceinline__ void xcd_barrier(const XcdBarrier& b) {
    asm volatile("s_waitcnt vmcnt(0)" ::: "memory");
    __syncthreads();
    if (threadIdx.x == 0) {
        unsigned* bar = b.bar;
        __builtin_amdgcn_s_waitcnt(0);
        unsigned nloc = b.st[0], nx = b.st[1];
        if (nloc == 0u) { xcd_barrier_complete(bar, b.x, nloc, nx); b.st[0] = nloc; b.st[1] = nx; }
        const unsigned old = xb_add(&bar[XB_XSUB(b.x)], 1u);
        const unsigned gen = old / nloc;
        if (old + 1u == (gen + 1u) * nloc) {
            __builtin_amdgcn_fence(__ATOMIC_RELEASE, "agent");
            asm volatile("s_waitcnt vmcnt(0)" ::: "memory");
            const unsigned og = xb_add(&bar[XB_TOP], 1u);
            const unsigned tg = og / nx;
            if (og + 1u == (tg + 1u) * nx) xb_add(&bar[XB_TOPGEN], 1u);
            else XB_SPIN(xb_ld(&bar[XB_TOPGEN]) == tg, bar);
            __builtin_amdgcn_fence(__ATOMIC_ACQUIRE, "agent");
            xb_add(&bar[XB_XGEN(b.x)], 1u);
            asm volatile("s_waitcnt vmcnt(0)" ::: "memory");
        } else {
            XB_SPIN(xb_ld(&bar[XB_XGEN(b.x)]) == gen, bar);
            __builtin_amdgcn_fence(__ATOMIC_ACQUIRE, "agent");
            asm volatile("s_waitcnt vmcnt(0)" ::: "memory");
        }
    }
    __syncthreads();
}

namespace pg8 {
constexpr int BM = 256, BK = 64, HALF = 128, HTB = HALF * BK * 2, NXCD = 8, WGM = 8;
__host__ __device__ __forceinline__ int lds_byte(int r, int c) { const int st = (r >> 4) * 2 + (c >> 5), rr = r & 15, cc = c & 31, ob = rr * 64 + cc * 2; return st * 1024 + (ob ^ (((ob >> 9) & 1) << 5)); }
__host__ __device__ __forceinline__ void stage_rc(int b, int& R, int& C) { const int st = b / 1024, sb = b % 1024, swz = sb ^ (((sb >> 9) & 1) << 5); R = (st >> 1) * 16 + swz / 64; C = (st & 1) * 32 + (swz % 64) / 2; }
__host__ __device__ __forceinline__ int perm32(int rho) { const int n = rho >> 4, i = rho & 15; return 8 * (i >> 2) + 4 * n + (i & 3); }

struct Unit { int pm, pn, kind; };

struct StaticOrder {
    int nM, nN, nwg, G, c;
    __device__ __forceinline__ void init(int M_, int N_, int G_, int c_) { nM = M_ / BM; nN = N_ / BM; nwg = nM * nN; G = G_; c = c_; }
    __device__ __forceinline__ bool next(int i, int& pm, int& pn) const {
        const long L = (long)i * G + c; if (L >= nwg) return false;
        int wgid = (int)L; { const int q = nwg / NXCD, r = nwg % NXCD, xcd = wgid % NXCD, off = wgid / NXCD; wgid = (xcd < r ? xcd * (q + 1) : r * (q + 1) + (xcd - r) * q) + off; }
        const int nig = WGM * nN, gid = wgid / nig, fm = gid * WGM, gsz = (nM - fm) < WGM ? (nM - fm) : WGM;
        pm = fm + ((wgid % nig) % gsz); pn = (wgid % nig) / gsz; return true;
    }
};
struct SchedPlain {
    StaticOrder so; const char* A0; const char* B0; size_t tstep;
    __device__ __forceinline__ bool next(int i, Unit& u) const { int pm_ = 0, pn_ = 0; const bool ok_ = so.next(i, pm_, pn_); u.pm = pm_; u.pn = pn_; u.kind = 0; return ok_; }
    __device__ __forceinline__ const char* a_ptr(const Unit& u) const { return A0 + (size_t)u.pm * tstep; }
    __device__ __forceinline__ const char* b_ptr(const Unit& u) const { return B0 + (size_t)u.pn * tstep; }
};
struct SchedP4 {
    int pm, pn; bool valid; const char* ws;
    static constexpr size_t TS = (size_t)256 * DM * 2;
    __device__ __forceinline__ bool next(int i, Unit& u) const { if (!valid || i >= 4) return false; u.pm = pm; u.kind = i < 2 ? 0 : i - 1; u.pn = i < 2 ? 2 * pn + i : pn; return true; }
    __device__ __forceinline__ const char* a_ptr(const Unit& u) const { const size_t off = WS_S0 + (size_t)(u.kind == 1) * (WS_S1 - WS_S0) + (size_t)(u.kind == 2) * (WS_S4 - WS_S0); return ws + off + (size_t)u.pm * TS; }
    __device__ __forceinline__ const char* b_ptr(const Unit& u) const { const size_t off = (WS_WIN + (size_t)ROW_GG * DM * 2) + (size_t)(u.kind == 1) * (WS_WOA - (WS_WIN + (size_t)ROW_GG * DM * 2)) + (size_t)(u.kind == 2) * (WS_WOB - (WS_WIN + (size_t)ROW_GG * DM * 2)); return ws + off + (size_t)u.pn * TS; }
};

template <class Epi, class Sched, bool ALIGN_EPI, bool SP2>
__device__ __forceinline__ void gemm_phase(LAS unsigned char* lds, const int tid, const int K, const Sched& S, const Epi& E) {
    const int wid = __builtin_amdgcn_readfirstlane(tid >> 6), lane = tid & 63, wr = wid >> 2, wc = wid & 3, fr = lane & 15, fq = lane >> 4;
    const int nt = K / BK;
    unsigned voffA[2], voffB[2];
#pragma unroll
    for (int i = 0; i < 2; ++i) { int R, C; stage_rc(tid * 16 + i * 8192, R, C); const int Rb = Epi::PERM ? ((R & ~31) + perm32(R & 31)) : R;
        voffA[i] = (unsigned)(R * K + C) * 2u; voffB[i] = (unsigned)(Rb * K + C) * 2u; }
    const size_t kstep = (size_t)(BK * 2);
    const size_t hstep = (size_t)HALF * K * 2;
    const unsigned ldsw = (unsigned)wid * 1024u;
    const int aoff = lds_byte(wr * 64 + fr, fq * 8), boff = lds_byte(wc * 32 + fr, fq * 8);
#define PG8_SA(b, h) (((b) * 2 + (h)) * HTB)
#define PG8_SB(b, h) ((4 + (b) * 2 + (h)) * HTB)
#define PG8_STAGE(bufoff, gbase, voff) do { _Pragma("unroll") for (int _i = 0; _i < 2; ++_i) \
        __builtin_amdgcn_global_load_lds((const unsigned*)((const char*)(gbase) + (voff)[_i]), (LAS unsigned*)(lds + (bufoff) + ldsw + _i * 8192), 16, 0, 0); } while (0)
#define PG8_LDA(dst, b, h) do { _Pragma("unroll") for (int m = 0; m < 4; ++m) _Pragma("unroll") for (int k = 0; k < 2; ++k) dst[m][k] = *(const LAS bf16x8*)(lds + PG8_SA(b, h) + aoff + m * 2048 + k * 1024); } while (0)
#define PG8_LDB(dst, b, h) do { _Pragma("unroll") for (int n = 0; n < 2; ++n) _Pragma("unroll") for (int k = 0; k < 2; ++k) dst[n][k] = *(const LAS bf16x8*)(lds + PG8_SB(b, h) + boff + n * 2048 + k * 1024); } while (0)
#define PG8_MMA(ai, bj, At, Bt) do { __builtin_amdgcn_s_setprio(1); _Pragma("unroll") for (int m = 0; m < 4; ++m) _Pragma("unroll") for (int n = 0; n < 2; ++n) _Pragma("unroll") for (int k = 0; k < 2; ++k) \
        acc[ai][bj][m][n] = __builtin_amdgcn_mfma_f32_16x16x32_bf16(Bt[n][k], At[m][k], acc[ai][bj][m][n], 0, 0, 0); __builtin_amdgcn_s_setprio(0); } while (0)
#define PG8_WAIT_V(n) asm volatile("s_waitcnt vmcnt(" #n ")" ::: "memory")
#define PG8_WAIT_L(n) asm volatile("s_waitcnt lgkmcnt(" #n ")" ::: "memory")
#define PG8_BAR __builtin_amdgcn_s_barrier()
#define PG8_SCHED __builtin_amdgcn_sched_barrier(0)
    Unit cur, nxt; int ui = 0;
    if (!S.next(0, cur)) return;
    f32x4 acc[2][2][4][2];
#pragma unroll
    for (int a = 0; a < 2; ++a)
#pragma unroll
        for (int b = 0; b < 2; ++b)
#pragma unroll
            for (int m = 0; m < 4; ++m)
#pragma unroll
                for (int n = 0; n < 2; ++n) acc[a][b][m][n] = (f32x4){0.f, 0.f, 0.f, 0.f};
    bf16x8 At[4][2], B0[2][2], B1[2][2];
    const char* cA = S.a_ptr(cur); const char* cB = S.b_ptr(cur);
    if constexpr (SP2) {
        PG8_STAGE(PG8_SB(0, 0), cB, voffB); PG8_STAGE(PG8_SB(0, 1), cB + hstep, voffB); PG8_STAGE(PG8_SA(0, 0), cA, voffA); PG8_STAGE(PG8_SA(0, 1), cA + hstep, voffA);
        if (wr == 1) PG8_BAR;
        PG8_WAIT_V(2); PG8_BAR;
        PG8_STAGE(PG8_SB(1, 0), cB + kstep, voffB); PG8_STAGE(PG8_SA(1, 0), cA + kstep, voffA); PG8_STAGE(PG8_SB(1, 1), cB + hstep + kstep, voffB);
        PG8_WAIT_V(6); PG8_BAR;
    } else {
        PG8_STAGE(PG8_SB(0, 0), cB, voffB); PG8_STAGE(PG8_SA(0, 0), cA, voffA); PG8_STAGE(PG8_SB(0, 1), cB + hstep, voffB); PG8_STAGE(PG8_SA(0, 1), cA + hstep, voffA);
        if (wr == 1) PG8_BAR;
        PG8_WAIT_V(4); PG8_BAR;
        PG8_STAGE(PG8_SB(1, 0), cB + kstep, voffB); PG8_STAGE(PG8_SA(1, 0), cA + kstep, voffA); PG8_STAGE(PG8_SB(1, 1), cB + hstep + kstep, voffB);
        PG8_WAIT_V(6); PG8_BAR;
    }
    for (;;) {
        const bool has_next = S.next(ui + 1, nxt);
        const char* nA = has_next ? S.a_ptr(nxt) : cA; const char* nB = has_next ? S.b_ptr(nxt) : cB;
        for (int t = 0; t < nt; t += 2) {
            const bool last = (t == nt - 2);
            const char* a1 = cA + (size_t)(t + 1) * kstep;
            const char* a2 = last ? nA : cA + (size_t)(t + 2) * kstep; const char* b2 = last ? nB : cB + (size_t)(t + 2) * kstep;
            const char* a3 = a2 + kstep; const char* b3 = b2 + kstep;
            if constexpr (SP2) {
            PG8_LDB(B0, 0, 0); PG8_LDB(B1, 0, 1); PG8_SCHED; PG8_LDA(At, 0, 0); PG8_STAGE(PG8_SA(1, 1), a1 + hstep, voffA);
            PG8_WAIT_V(8); PG8_WAIT_L(0); PG8_BAR; PG8_MMA(0, 0, At, B0); PG8_MMA(0, 1, At, B1); PG8_BAR; PG8_SCHED;
            PG8_LDA(At, 0, 1); PG8_STAGE(PG8_SB(0, 0), b2, voffB); PG8_STAGE(PG8_SB(0, 1), b2 + hstep, voffB); PG8_STAGE(PG8_SA(0, 0), a2, voffA);
            PG8_WAIT_V(8); PG8_WAIT_L(0); PG8_BAR; PG8_MMA(1, 0, At, B0); PG8_MMA(1, 1, At, B1); PG8_BAR; PG8_SCHED;
            PG8_LDB(B0, 1, 0); PG8_LDB(B1, 1, 1); PG8_SCHED; PG8_LDA(At, 1, 0); PG8_STAGE(PG8_SA(0, 1), a2 + hstep, voffA);
            PG8_WAIT_V(8); PG8_WAIT_L(0); PG8_BAR; PG8_MMA(0, 0, At, B0); PG8_MMA(0, 1, At, B1); PG8_BAR; PG8_SCHED;
            PG8_LDA(At, 1, 1); PG8_STAGE(PG8_SB(1, 0), b3, voffB); PG8_STAGE(PG8_SB(1, 1), b3 + hstep, voffB); PG8_STAGE(PG8_SA(1, 0), a3, voffA);
            PG8_WAIT_V(8); PG8_WAIT_L(0); PG8_BAR; PG8_MMA(1, 0, At, B0); PG8_MMA(1, 1, At, B1); PG8_BAR; PG8_SCHED;
            } else {
            PG8_LDB(B0, 0, 0); PG8_SCHED; PG8_LDA(At, 0, 0); PG8_STAGE(PG8_SA(1, 1), a1 + hstep, voffA);
            PG8_WAIT_L(8); PG8_BAR; PG8_WAIT_L(0); PG8_MMA(0, 0, At, B0); PG8_BAR; PG8_SCHED;
            PG8_LDB(B1, 0, 1); PG8_STAGE(PG8_SB(0, 0), b2, voffB);
            PG8_BAR; PG8_WAIT_L(0); PG8_MMA(0, 1, At, B1); PG8_BAR;
            PG8_LDA(At, 0, 1); PG8_STAGE(PG8_SA(0, 0), a2, voffA);
            PG8_BAR; PG8_WAIT_L(0); PG8_MMA(1, 0, At, B0); PG8_BAR; PG8_SCHED;
            PG8_STAGE(PG8_SB(0, 1), b2 + hstep, voffB);
            PG8_WAIT_V(6); PG8_BAR; PG8_MMA(1, 1, At, B1); PG8_BAR;
            PG8_LDB(B0, 1, 0); PG8_SCHED; PG8_LDA(At, 1, 0); PG8_STAGE(PG8_SA(0, 1), a2 + hstep, voffA);
            PG8_WAIT_L(8); PG8_BAR; PG8_WAIT_L(0); PG8_MMA(0, 0, At, B0); PG8_BAR; PG8_SCHED;
            PG8_LDB(B1, 1, 1); PG8_STAGE(PG8_SB(1, 0), b3, voffB);
            PG8_BAR; PG8_WAIT_L(0); PG8_MMA(0, 1, At, B1); PG8_BAR;
            PG8_LDA(At, 1, 1); PG8_STAGE(PG8_SA(1, 0), a3, voffA);
            PG8_BAR; PG8_WAIT_L(0); PG8_MMA(1, 0, At, B0); PG8_BAR; PG8_SCHED;
            PG8_STAGE(PG8_SB(1, 1), b3 + hstep, voffB);
            PG8_WAIT_V(6); PG8_BAR; PG8_MMA(1, 1, At, B1); PG8_BAR;
            }
        }
        if constexpr (ALIGN_EPI) { if (wr == 0) PG8_BAR; }
        if constexpr (!Epi::AFTER_DRAIN) { E(acc, cur, wr, wc, fr, fq); }
        if (!has_next) break;
        if constexpr (Epi::KEEPS) {
            E.rescale(acc, cur, wr, wc, fr, fq);
        } else {
#pragma unroll
            for (int a = 0; a < 2; ++a)
#pragma unroll
                for (int b = 0; b < 2; ++b)
#pragma unroll
                    for (int m = 0; m < 4; ++m)
#pragma unroll
                        for (int n = 0; n < 2; ++n) acc[a][b][m][n] = (f32x4){0.f, 0.f, 0.f, 0.f};
        }
        cur = nxt; cA = nA; cB = nB; ++ui;
        if constexpr (ALIGN_EPI) { if (wr == 1) PG8_BAR; }
    }
    PG8_WAIT_V(0);
    if constexpr (!ALIGN_EPI) { if (wr == 0) PG8_BAR; }
    PG8_BAR;
    if constexpr (Epi::AFTER_DRAIN) { E.fused(acc, cur, wr, wc, fr, fq, lds, wid, lane); }
#undef PG8_SA
#undef PG8_SB
#undef PG8_STAGE
#undef PG8_LDA
#undef PG8_LDB
#undef PG8_MMA
#undef PG8_WAIT_V
#undef PG8_WAIT_L
#undef PG8_BAR
#undef PG8_SCHED
}

__device__ __forceinline__ u32x4 pack8(const f32x4 a, const f32x4 b) { u32x4 w; w.x = cvt_pk_bf16(a[0], a[1]); w.y = cvt_pk_bf16(a[2], a[3]); w.z = cvt_pk_bf16(b[0], b[1]); w.w = cvt_pk_bf16(b[2], b[3]); return w; }

struct EpiP1a {
    static constexpr bool PERM = true, AFTER_DRAIN = false, KEEPS = false;
    const float* ssq; bf16_t *BA, *V, *XBp, *GG;
    __device__ __forceinline__ bool keep(const Unit&) const { return false; }
    __device__ __forceinline__ void operator()(f32x4 (&acc)[2][2][4][2], const Unit& u, int wr, int wc, int fr, int fq) const {
        const int row0 = u.pm * BM + wr * 64 + fr;
        const int pn = u.pn;
        if (pn >= 4 && pn < 12) {
            const int col = (pn - 4) * 128 + wc * 32 + 8 * fq;
#pragma unroll
            for (int ai = 0; ai < 2; ++ai)
#pragma unroll
                for (int m = 0; m < 4; ++m) { const int row = row0 + ai * HALF + m * 16; const float r = rstd_of(ssq, row), r2 = r * r;
                    const f32x4 v0 = acc[ai][0][m][0] * acc[ai][1][m][0] * r2, v1 = acc[ai][0][m][1] * acc[ai][1][m][1] * r2;
                    *(u32x4*)(V + (size_t)row * DM + col) = pack8(v0, v1); }
        } else {
            bf16_t* O; int colt; bool act = false;
            if (pn < 4) { O = BA; colt = pn * 256; } else if (pn < 16) { O = XBp; colt = (pn - 12) * 256; } else { O = GG; colt = (pn - 16) * 256; act = true; }
            const int col = colt + wc * 32 + 8 * fq;
#pragma unroll
            for (int ai = 0; ai < 2; ++ai)
#pragma unroll
                for (int m = 0; m < 4; ++m) { const int row = row0 + ai * HALF + m * 16; const float r = rstd_of(ssq, row);
#pragma unroll
                    for (int bj = 0; bj < 2; ++bj) { f32x4 v0 = acc[ai][bj][m][0] * r, v1 = acc[ai][bj][m][1] * r;
                        if (act) {
#pragma unroll
                            for (int i = 0; i < 4; ++i) { v0[i] = gelu_tanh(v0[i]); v1[i] = gelu_tanh(v1[i]); } }
                        *(u32x4*)(O + (size_t)row * DM + col + bj * HALF) = pack8(v0, v1); } }
        }
    }
};
struct EpiP4 {
    static constexpr bool PERM = true, AFTER_DRAIN = false, KEEPS = true;
    const float* ssq; const float* gbias;
    bf16_t *RA, *SB, *MG;
    __device__ __forceinline__ bool keep(const Unit& u) const { return u.kind == 1; }
    __device__ __forceinline__ void operator()(f32x4 (&acc)[2][2][4][2], const Unit& u, int wr, int wc, int fr, int fq) const {
        const int row0 = u.pm * BM + wr * 64 + fr;
        if (u.kind == 0) {
            const int col = u.pn * 128 + wc * 32 + 8 * fq;
#pragma unroll
            for (int ai = 0; ai < 2; ++ai)
#pragma unroll
                for (int m = 0; m < 4; ++m) { const int row = row0 + ai * HALF + m * 16; const float r = rstd_of(ssq, row);
                    unsigned wra[4], wsb[4];
#pragma unroll
                    for (int n = 0; n < 2; ++n) {
                        const f32x4 ba = *(const f32x4*)(gbias + col + 4 * n), bb = *(const f32x4*)(gbias + DM + col + 4 * n);
                        float ra[4], sb[4];
#pragma unroll
                        for (int i = 0; i < 4; ++i) {
                            float p = acc[ai][0][m][n][i] * r + ba[i], q = acc[ai][1][m][n][i] * r + bb[i];
                            p = fminf(fmaxf(p, -30.f), 30.f); q = fminf(fmaxf(q, -30.f), 30.f);
                            const float ep = 1.0f + fast_exp(-p), eq = 1.0f + fast_exp(-q);
                            ra[i] = eq * __builtin_amdgcn_rcpf(ep); sb[i] = __builtin_amdgcn_rcpf(eq); }
                        wra[2 * n] = cvt_pk_bf16(ra[0], ra[1]); wra[2 * n + 1] = cvt_pk_bf16(ra[2], ra[3]);
                        wsb[2 * n] = cvt_pk_bf16(sb[0], sb[1]); wsb[2 * n + 1] = cvt_pk_bf16(sb[2], sb[3]); }
                    *(u32x4*)(RA + (size_t)row * DM + col) = (u32x4){wra[0], wra[1], wra[2], wra[3]};
                    *(u32x4*)(SB + (size_t)row * DM + col) = (u32x4){wsb[0], wsb[1], wsb[2], wsb[3]};
                    asm volatile("" ::: "memory"); }
        } else if (u.kind == 2) {
            const int col = u.pn * 256 + wc * 32 + 8 * fq;
#pragma unroll
            for (int ai = 0; ai < 2; ++ai)
#pragma unroll
                for (int m = 0; m < 4; ++m) { const int row = row0 + ai * HALF + m * 16;
#pragma unroll
                    for (int bj = 0; bj < 2; ++bj) { const u32x4 g = *(const u32x4*)(SB + (size_t)row * DM + col + bj * HALF);
                        const f32x4 g0 = {bflo(g.x), bfhi(g.x), bflo(g.y), bfhi(g.y)}, g1 = {bflo(g.z), bfhi(g.z), bflo(g.w), bfhi(g.w)};
                        *(u32x4*)(MG + (size_t)row * DM + col + bj * HALF) = pack8(acc[ai][bj][m][0] * g0, acc[ai][bj][m][1] * g1); }
                    asm volatile("" ::: "memory"); }
        }
    }
    __device__ __forceinline__ void rescale(f32x4 (&acc)[2][2][4][2], const Unit& u, int wr, int wc, int fr, int fq) const {
        const int row0 = u.pm * BM + wr * 64 + fr, col = (u.pn & 3) * 256 + wc * 32 + 8 * fq;
        const bool k1 = (u.kind == 1);
#pragma unroll
        for (int ai = 0; ai < 2; ++ai)
#pragma unroll
            for (int m = 0; m < 4; ++m) { const int row = row0 + ai * HALF + m * 16;
#pragma unroll
                for (int bj = 0; bj < 2; ++bj) { const u32x4 g = *(const u32x4*)(RA + (size_t)row * DM + col + bj * HALF);
                    f32x4 g0 = {bflo(g.x), bfhi(g.x), bflo(g.y), bfhi(g.y)}, g1 = {bflo(g.z), bfhi(g.z), bflo(g.w), bfhi(g.w)};
#pragma unroll
                    for (int i = 0; i < 4; ++i) { g0[i] = k1 ? g0[i] : 0.f; g1[i] = k1 ? g1[i] : 0.f; }
                    acc[ai][bj][m][0] = acc[ai][bj][m][0] * g0; acc[ai][bj][m][1] = acc[ai][bj][m][1] * g1; }
                asm volatile("" ::: "memory"); }
    }
};
struct EpiP6 {
    static constexpr bool PERM = true, AFTER_DRAIN = false, KEEPS = false;
    const float* ssq; bf16_t* H;
    __device__ __forceinline__ bool keep(const Unit&) const { return false; }
    __device__ __forceinline__ void operator()(f32x4 (&acc)[2][2][4][2], const Unit& u, int wr, int wc, int fr, int fq) const {
        const int row0 = u.pm * BM + wr * 64 + fr, col = u.pn * 128 + wc * 32 + 8 * fq;
#pragma unroll
        for (int ai = 0; ai < 2; ++ai)
#pragma unroll
            for (int m = 0; m < 4; ++m) { const int row = row0 + ai * HALF + m * 16; const float r = rstd_of(ssq, row);
                f32x4 h[2];
#pragma unroll
                for (int n = 0; n < 2; ++n)
#pragma unroll
                    for (int i = 0; i < 4; ++i) { const float g = acc[ai][0][m][n][i] * r, uu = acc[ai][1][m][n][i] * r;
                        h[n][i] = g * uu * __builtin_amdgcn_rcpf(1.0f + fast_exp(-g)); }
                *(u32x4*)(H + (size_t)row * DFF + col) = pack8(h[0], h[1]); }
    }
};
struct EpiRes {
    static constexpr bool PERM = false, AFTER_DRAIN = true, KEEPS = false;
    const float* base; float* X; bf16_t* XBo; float* ssq;
    __device__ __forceinline__ bool keep(const Unit&) const { return false; }
    __device__ __forceinline__ void fused(f32x4 (&acc)[2][2][4][2], const Unit& u, int wr, int wc, int fr, int fq, LAS unsigned char* lds, int wid, int lane) const {
        LAS float* P = (LAS float*)lds;
        const int col0 = u.pn * BM + wc * 32 + 4 * fq;
#pragma unroll
        for (int ai = 0; ai < 2; ++ai)
#pragma unroll
            for (int m = 0; m < 4; ++m) { const int rl = ai * HALF + wr * 64 + m * 16 + fr; const size_t off = (size_t)(u.pm * BM + rl) * DM + col0;
                f32x4 bs[2][2];
#pragma unroll
                for (int bj = 0; bj < 2; ++bj)
#pragma unroll
                    for (int n = 0; n < 2; ++n) bs[bj][n] = *(const f32x4*)(base + off + bj * HALF + n * 16);
                float ss = 0.f;
#pragma unroll
                for (int bj = 0; bj < 2; ++bj)
#pragma unroll
                    for (int n = 0; n < 2; ++n) { const f32x4 xn = bs[bj][n] + acc[ai][bj][m][n];
                        *(f32x4*)(X + off + bj * HALF + n * 16) = xn;
                        u32x2 w; w.x = cvt_pk_bf16(xn[0], xn[1]); w.y = cvt_pk_bf16(xn[2], xn[3]);
                        *(u32x2*)(XBo + off + bj * HALF + n * 16) = w;
                        ss += (xn[0] * xn[0] + xn[1] * xn[1]) + (xn[2] * xn[2] + xn[3] * xn[3]); }
                ss += __shfl_xor(ss, 16); ss += __shfl_xor(ss, 32);
                if (fq == 0) P[rl * 4 + wc] = ss;
                asm volatile("" ::: "memory"); }
        asm volatile("s_waitcnt lgkmcnt(0)" ::: "memory"); __builtin_amdgcn_s_barrier(); asm volatile("" ::: "memory");
        const int t = wid * 64 + lane;
        if (t < 256) { const f32x4 p = *(const LAS f32x4*)(P + t * 4); ssq[(size_t)(u.pm * BM + t) * 4 + u.pn] = (p.x + p.y) + (p.z + p.w); }
        asm volatile("s_waitcnt lgkmcnt(0)" ::: "memory"); __builtin_amdgcn_s_barrier(); asm volatile("" ::: "memory");
    }
};
}

struct Frame {
    LAS unsigned char* lds;
    volatile LAS unsigned* MISC;
    int tid, lane, wave, vcu, G, bx;
};
__device__ __forceinline__ Frame make_frame(LAS unsigned char* lds) {
    Frame F; int tid = threadIdx.x, bx = blockIdx.x, G = gridDim.x;
    asm volatile("" : "+v"(tid), "+s"(bx), "+s"(G));
    F.lds = lds; F.MISC = (volatile LAS unsigned*)(lds + MISC_OFF);
    F.tid = tid; F.lane = tid & 63; F.wave = __builtin_amdgcn_readfirstlane(tid >> 6);
    F.G = G; F.bx = bx; F.vcu = (G % 8 == 0) ? (bx % 8) * (G / 8) + bx / 8 : bx;
    return F;
}
struct Args { const float* in[20]; float* out; unsigned char* ws; int ph_lo, ph_hi; };
#define CAS __attribute__((address_space(4)))
typedef const CAS Args* KArgs;
__device__ __forceinline__ KArgs kargs() { KArgs p = (KArgs)__builtin_amdgcn_kernarg_segment_ptr(); asm volatile("" : "+s"(p)); return p; }
enum { I_X = 0, I_LN1 = 1, I_WIN = 2, I_CAW = 3, I_CBW = 4, I_CBB = 5, I_LWA = 6, I_LBA = 7, I_LWX = 8, I_LBX = 9, I_LAM = 10, I_WOA = 11, I_WOB = 12, I_GB = 13, I_WO = 14, I_LN2 = 15, I_WG = 16, I_WU = 17, I_WD = 18, I_FG = 19 };

__device__ __forceinline__ float wave_sum(float v) {
#pragma unroll
    for (int o = 1; o < 64; o <<= 1) v += __shfl_xor(v, o);
    return v;
}

__device__ __forceinline__ void tr_item(const float* W, int K, int N, bf16_t* WT, int drow, const float* gk, LAS float* scr, int k0, int n0, int lane) {
    const int ks = lane >> 3, nq = lane & 7;
    f32x4 v[8];
#pragma unroll
    for (int i = 0; i < 8; ++i) v[i] = *(const f32x4*)(W + (size_t)(k0 + 8 * i + ks) * N + n0 + 4 * nq);
#pragma unroll
    for (int i = 0; i < 8; ++i) { const int kk = 8 * i + ks; const float sc = gk ? gk[k0 + kk] : 1.0f; LAS float* d = scr + kk * 33 + 4 * nq;
        d[0] = v[i].x * sc; d[1] = v[i].y * sc; d[2] = v[i].z * sc; d[3] = v[i].w * sc; }
    LDS_WAIT(); asm volatile("" ::: "memory");
    const int c = lane & 7;
#pragma unroll
    for (int j = 0; j < 4; ++j) { const int n = (lane >> 3) + 8 * j; const LAS float* s = scr + (8 * c) * 33 + n;
        u32x4 o; o.x = pk2(s[0 * 33], s[1 * 33]); o.y = pk2(s[2 * 33], s[3 * 33]); o.z = pk2(s[4 * 33], s[5 * 33]); o.w = pk2(s[6 * 33], s[7 * 33]);
        *(GAS u32x4*)(WT + (size_t)(drow + n) * K + k0 + 8 * c) = o; }
    LDS_WAIT(); asm volatile("" ::: "memory");
}
__device__ __forceinline__ int win_row(int n0) {
    const int seg = n0 >> 10, o = n0 & 1023, j = o >> 7, i = o & 127;
    switch (seg) {
        case 0: return o;
        case 1: return 1024 + 256 * j + i;
        case 2: return 1024 + 256 * j + 128 + i;
        case 3: return 3072 + o;
        case 4: return 4096 + o;
        case 5: return ROW_GG + 256 * j + i;
        default: return ROW_GG + 256 * j + 128 + i;
    }
}
__device__ __forceinline__ void p0_weights(Frame& F, int l) {
    KArgs a = kargs();
    unsigned char* ws = a->ws;
    LAS float* scr = (LAS float*)(F.lds + F.wave * 16384);
    const int gw = F.vcu * NWAVES + F.wave, NGW = F.G * NWAVES;
    constexpr int I_IN = (DM / 64) * (NIN / 32), I_SQ = (DM / 64) * (DM / 32), I_FF = (DM / 64) * (DFF / 32), I_DN = (DFF / 64) * (DM / 32), I_LR = 16 * 2;
    constexpr int NITEMS = I_IN + 3 * I_SQ + 2 * I_FF + I_DN + 2 * I_LR;
    const float* ln1 = a->in[I_LN1] + (size_t)l * DM; const float* ln2 = a->in[I_LN2] + (size_t)l * DM;
    for (int it = gw; it < NITEMS; it += NGW) {
        int r = it;
        if (r < I_IN) { const int nblk = NIN / 32, kb = r / nblk, nb = r % nblk; tr_item(a->in[I_WIN] + (size_t)l * DM * NIN, DM, NIN, (bf16_t*)(ws + WS_WIN), win_row(nb * 32), ln1, scr, kb * 64, nb * 32, F.lane); continue; } r -= I_IN;
        if (r < I_SQ) { const int nblk = DM / 32, kb = r / nblk, nb = r % nblk; tr_item(a->in[I_WOA] + (size_t)l * DM * DM, DM, DM, (bf16_t*)(ws + WS_WOA), nb * 32, nullptr, scr, kb * 64, nb * 32, F.lane); continue; } r -= I_SQ;
        if (r < I_SQ) { const int nblk = DM / 32, kb = r / nblk, nb = r % nblk; tr_item(a->in[I_WOB] + (size_t)l * DM * DM, DM, DM, (bf16_t*)(ws + WS_WOB), nb * 32, nullptr, scr, kb * 64, nb * 32, F.lane); continue; } r -= I_SQ;
        if (r < I_SQ) { const int nblk = DM / 32, kb = r / nblk, nb = r % nblk; tr_item(a->in[I_WO] + (size_t)l * DM * DM, DM, DM, (bf16_t*)(ws + WS_WO), nb * 32, nullptr, scr, kb * 64, nb * 32, F.lane); continue; } r -= I_SQ;
        if (r < I_FF) { const int nblk = DFF / 32, kb = r / nblk, nb = r % nblk, n0 = nb * 32; tr_item(a->in[I_WG] + (size_t)l * DM * DFF, DM, DFF, (bf16_t*)(ws + WS_WGU), 256 * (n0 >> 7) + (n0 & 127), ln2, scr, kb * 64, n0, F.lane); continue; } r -= I_FF;
        if (r < I_FF) { const int nblk = DFF / 32, kb = r / nblk, nb = r % nblk, n0 = nb * 32; tr_item(a->in[I_WU] + (size_t)l * DM * DFF, DM, DFF, (bf16_t*)(ws + WS_WGU), 256 * (n0 >> 7) + 128 + (n0 & 127), ln2, scr, kb * 64, n0, F.lane); continue; } r -= I_FF;
        if (r < I_DN) { const int nblk = DM / 32, kb = r / nblk, nb = r % nblk; tr_item(a->in[I_WD] + (size_t)l * DFF * DM, DFF, DM, (bf16_t*)(ws + WS_WD), nb * 32, nullptr, scr, kb * 64, nb * 32, F.lane); continue; } r -= I_DN;
        if (r < I_LR) { const int h = r >> 1, nb = r & 1; tr_item(a->in[I_LWA] + ((size_t)l * NHEAD + h) * HD * HD, HD, HD, (bf16_t*)(ws + WS_LRU) + (size_t)h * HD * HD, nb * 32, nullptr, scr, 0, nb * 32, F.lane); continue; } r -= I_LR;
        { const int h = r >> 1, nb = r & 1; tr_item(a->in[I_LWX] + ((size_t)l * NHEAD + h) * HD * HD, HD, HD, (bf16_t*)(ws + WS_LRU) + (size_t)(NHEAD + h) * HD * HD, nb * 32, nullptr, scr, 0, nb * 32, F.lane); }
    }
}
__device__ __forceinline__ void p0_x(Frame& F) {
    KArgs a = kargs();
    const int gw = F.vcu * NWAVES + F.wave, NGW = F.G * NWAVES;
    const float* x = a->in[I_X]; bf16_t* XB = (bf16_t*)(a->ws + WS_S0); float* ssq = (float*)(a->ws + WS_SSQ);
    for (int m = gw; m < M; m += NGW) {
        const GAS f32x4* xr = (const GAS f32x4*)(x + (size_t)m * DM) + F.lane;
        f32x4 v[4]; float s = 0.f;
#pragma unroll
        for (int j = 0; j < 4; ++j) { v[j] = xr[64 * j]; s += (v[j].x * v[j].x + v[j].y * v[j].y) + (v[j].z * v[j].z + v[j].w * v[j].w); }
        s = wave_sum(s);
        GAS u32x2* o8 = (GAS u32x2*)(XB + (size_t)m * DM) + F.lane;
#pragma unroll
        for (int j = 0; j < 4; ++j) { u32x2 w; w.x = pk2(v[j].x, v[j].y); w.y = pk2(v[j].z, v[j].w); o8[64 * j] = w; }
        if (F.lane == 0) *(f32x4*)(ssq + (size_t)m * 4) = (f32x4){s, 0.f, 0.f, 0.f};
    }
}
__device__ __forceinline__ void p8_final(Frame& F) {
    KArgs a = kargs();
    const int gw = F.vcu * NWAVES + F.wave, NGW = F.G * NWAVES;
    float* X = a->out; const float* ssq = (const float*)(a->ws + WS_SSQ); const float* g = a->in[I_FG];
    f32x4 gv[4];
#pragma unroll
    for (int j = 0; j < 4; ++j) gv[j] = *((const f32x4*)g + F.lane + 64 * j);
    for (int m = gw; m < M; m += NGW) {
        const float r = rstd_of(ssq, m);
        GAS f32x4* xr = (GAS f32x4*)(X + (size_t)m * DM) + F.lane;
#pragma unroll
        for (int j = 0; j < 4; ++j) { const f32x4 v = xr[64 * j]; xr[64 * j] = v * r * gv[j]; }
    }
}

__device__ __forceinline__ void unpack8(const u32x4 w, float (&f)[8]) { f[0] = bflo(w.x); f[1] = bfhi(w.x); f[2] = bflo(w.y); f[3] = bfhi(w.y); f[4] = bflo(w.z); f[5] = bfhi(w.z); f[6] = bflo(w.w); f[7] = bfhi(w.w); }
__device__ __forceinline__ void p2_mixer_a(Frame& F, int l) {
    KArgs a = kargs();
    bf16_t* BA = (bf16_t*)(a->ws + WS_S1); const bf16_t* V = (const bf16_t*)(a->ws + WS_S2);
    const float* cw = a->in[I_CAW] + (size_t)l * 3 * DM;
    constexpr int RB = 8, NTASK = (M / RB) * (DM / 8);
    for (int task = F.vcu * (NWAVES * 64) + F.tid; task < NTASK; task += F.G * NWAVES * 64) {
        const int cg = task & 127, rb = task >> 7, c0 = cg * 8, t0 = rb * RB;
        const bool first = (t0 % SEQ) == 0;
        u32x4 vr[RB + 2], br[RB];
        vr[0] = first ? (u32x4){0u, 0u, 0u, 0u} : *(const u32x4*)(V + (size_t)(t0 - 2) * DM + c0);
        vr[1] = first ? (u32x4){0u, 0u, 0u, 0u} : *(const u32x4*)(V + (size_t)(t0 - 1) * DM + c0);
#pragma unroll
        for (int r = 0; r < RB; ++r) { vr[r + 2] = *(const u32x4*)(V + (size_t)(t0 + r) * DM + c0); br[r] = *(const u32x4*)(BA + (size_t)(t0 + r) * DM + c0); }
        float w0[8], w1[8], w2[8];
#pragma unroll
        for (int h = 0; h < 2; ++h) { const f32x4 q0 = *(const f32x4*)(cw + c0 + 4 * h), q1 = *(const f32x4*)(cw + DM + c0 + 4 * h), q2 = *(const f32x4*)(cw + 2 * DM + c0 + 4 * h);
#pragma unroll
            for (int i = 0; i < 4; ++i) { w0[4 * h + i] = q0[i]; w1[4 * h + i] = q1[i]; w2[4 * h + i] = q2[i]; } }
        float vm2[8], vm1[8];
        unpack8(vr[0], vm2); unpack8(vr[1], vm1);
#pragma unroll
        for (int r = 0; r < RB; ++r) {
            float v[8], b[8], o[8];
            unpack8(vr[r + 2], v); unpack8(br[r], b);
#pragma unroll
            for (int i = 0; i < 8; ++i) { o[i] = b[i] * (w0[i] * vm2[i] + w1[i] * vm1[i] + w2[i] * v[i]); vm2[i] = vm1[i]; vm1[i] = v[i]; }
            u32x4 w; w.x = pk2(o[0], o[1]); w.y = pk2(o[2], o[3]); w.z = pk2(o[4], o[5]); w.w = pk2(o[6], o[7]);
            *(u32x4*)(BA + (size_t)(t0 + r) * DM + c0) = w;
        }
    }
}

constexpr int MX_WAVE_BYTES = 12288, MX_UB = 0, MX_SA = 2048, MX_SB = 6144, MX_GT = 10240, MX_WS = 8 * MX_WAVE_BYTES;
template <bool APPLY>
__device__ __forceinline__ void mixer_b(Frame& F, int l) {
    KArgs a = kargs();
    const int lane = F.lane, w = F.wave;
    const bf16_t* XBp = (const bf16_t*)(a->ws + WS_S3); bf16_t* GG = (bf16_t*)(a->ws + WS_S4);
    f32x2* SUM = (f32x2*)(a->ws + WS_SUM); f32x2* SUMG = (f32x2*)(a->ws + WS_SUMG);
    const bf16_t* WaT = (const bf16_t*)(a->ws + WS_LRU); const bf16_t* WxT = WaT + (size_t)NHEAD * HD * HD;
    LAS unsigned char* wl = F.lds + w * MX_WAVE_BYTES;
    LAS float* SA = (LAS float*)(wl + MX_SA); LAS float* SBm = (LAS float*)(wl + MX_SB);
    LAS unsigned short* GT = (LAS unsigned short*)(wl + MX_GT);
    LAS f32x2* WSX = (LAS f32x2*)(F.lds + MX_WS);
    for (int item = F.bx; item < BATCH * NHEAD * 8; item += F.G) {
        const int b = item >> 7, hd = (item >> 3) & 15, g8 = item & 7, span = g8 * 8 + w, chb = hd * HD;
        const int t0 = b * SEQ + span * 128;
        f32x2 pg[7], ps[7];
        if (APPLY) {
#pragma unroll
            for (int j = 0; j < 7; ++j) { pg[j] = (j < g8) ? SUMG[((size_t)(b * 8 + j)) * DM + chb + lane] : (f32x2){1.f, 0.f};
                                          ps[j] = (j < w) ? SUM[((size_t)(b * 64 + g8 * 8 + j)) * DM + chb + lane] : (f32x2){1.f, 0.f}; }
        }
        const int g = lane & 7, tr = lane >> 3, ch0 = chb + 8 * g;
        u32x4 xr[5], gt[2];
#pragma unroll
        for (int k = 0; k < 5; ++k) { const int row = t0 + 2 * tr - 3 + k; xr[k] = (row >= b * SEQ) ? *(const u32x4*)(XBp + (size_t)row * DM + ch0) : (u32x4){0u, 0u, 0u, 0u}; }
        if (APPLY) {
#pragma unroll
            for (int e = 0; e < 2; ++e) gt[e] = *(const u32x4*)(GG + (size_t)(t0 + tr + 8 * e) * DM + ch0);
        }
        float cw[4][8], cb[8];
        { const float* cbw = a->in[I_CBW] + (size_t)l * 4 * DM + ch0; const float* cbb = a->in[I_CBB] + (size_t)l * DM + ch0;
#pragma unroll
          for (int h2 = 0; h2 < 2; ++h2) { const f32x4 bb = *(const f32x4*)(cbb + 4 * h2);
#pragma unroll
              for (int i2 = 0; i2 < 4; ++i2) cb[4 * h2 + i2] = bb[i2];
#pragma unroll
              for (int k = 0; k < 4; ++k) { const f32x4 wk = *(const f32x4*)(cbw + (size_t)k * DM + 4 * h2);
#pragma unroll
                  for (int i2 = 0; i2 < 4; ++i2) cw[k][4 * h2 + i2] = wk[i2]; } } }
        const int cc = lane & 15, kq = lane >> 4;
        bf16x8 bR[4][2], bI[4][2], idf[2];
        float gba[4], gbx[4], gkk[4];
#pragma unroll
        for (int n = 0; n < 4; ++n) { const int e = 16 * n + cc;
#pragma unroll
            for (int s2 = 0; s2 < 2; ++s2) { bR[n][s2] = *(const bf16x8*)(WaT + ((size_t)hd * HD + e) * HD + 32 * s2 + 8 * kq); bI[n][s2] = *(const bf16x8*)(WxT + ((size_t)hd * HD + e) * HD + 32 * s2 + 8 * kq); }
            gba[n] = a->in[I_LBA][(size_t)l * DM + chb + e]; gbx[n] = a->in[I_LBX][(size_t)l * DM + chb + e];
            gkk[n] = -8.0f * log1pf(__expf(-a->in[I_LAM][(size_t)l * DM + chb + e])) * 1.4426950408889634f; }
#pragma unroll
        for (int p2 = 0; p2 < 2; ++p2)
#pragma unroll
            for (int j = 0; j < 8; ++j) idf[p2][j] = (8 * kq + j == 16 * p2 + cc) ? (short)0x3f80 : (short)0;
        float Pw = 1.f, Hw = 0.f;
        if (APPLY) {
#pragma unroll
            for (int j = 0; j < 7; ++j) Hw = pg[j].x * Hw + pg[j].y;
#pragma unroll
            for (int j = 0; j < 7; ++j) Hw = ps[j].x * Hw + ps[j].y;
        }
#pragma unroll 1
        for (int s = 0; s < 8; ++s) {
            const int tb = t0 + 16 * s;
            {
                float u0[8], u1[8];
#pragma unroll
                for (int i2 = 0; i2 < 8; ++i2) { u0[i2] = cb[i2]; u1[i2] = cb[i2]; }
#pragma unroll
                for (int k = 0; k < 5; ++k) { float x[8]; unpack8(xr[k], x);
#pragma unroll
                    for (int i2 = 0; i2 < 8; ++i2) { if (k < 4) u0[i2] += cw[k][i2] * x[i2]; if (k >= 1) u1[i2] += cw[k - 1][i2] * x[i2]; } }
                const int tk0 = 2 * tr, tk1 = 2 * tr + 1;
                u32x4 p0, p1; p0.x = pk2(u0[0], u0[1]); p0.y = pk2(u0[2], u0[3]); p0.z = pk2(u0[4], u0[5]); p0.w = pk2(u0[6], u0[7]);
                p1.x = pk2(u1[0], u1[1]); p1.y = pk2(u1[2], u1[3]); p1.z = pk2(u1[4], u1[5]); p1.w = pk2(u1[6], u1[7]);
                *(LAS u32x4*)(wl + MX_UB + tk0 * 128 + ((g ^ (tk0 & 7)) * 16)) = p0;
                *(LAS u32x4*)(wl + MX_UB + tk1 * 128 + ((g ^ (tk1 & 7)) * 16)) = p1;
                if (APPLY) {
#pragma unroll
                    for (int e = 0; e < 2; ++e) *(LAS u32x4*)(wl + MX_GT + (tr + 8 * e) * 128 + g * 16) = gt[e];
                }
            }
            if (s < 7) {
#pragma unroll
                for (int k = 0; k < 5; ++k) xr[k] = *(const u32x4*)(XBp + (size_t)(tb + 16 + 2 * tr - 3 + k) * DM + ch0);
                if (APPLY) {
#pragma unroll
                    for (int e = 0; e < 2; ++e) gt[e] = *(const u32x4*)(GG + (size_t)(tb + 16 + tr + 8 * e) * DM + ch0);
                }
            }
            LDS_WAIT(); asm volatile("" ::: "memory");
            {
                bf16x8 Af[2];
#pragma unroll
                for (int s2 = 0; s2 < 2; ++s2) Af[s2] = *(const LAS bf16x8*)(wl + MX_UB + cc * 128 + (((4 * s2 + kq) ^ (cc & 7)) * 16));
#pragma unroll
                for (int n = 0; n < 4; ++n) {
                    f32x4 aR = {0.f, 0.f, 0.f, 0.f}, aI = {0.f, 0.f, 0.f, 0.f}, aU = {0.f, 0.f, 0.f, 0.f};
#pragma unroll
                    for (int s2 = 0; s2 < 2; ++s2) { aR = __builtin_amdgcn_mfma_f32_16x16x32_bf16(Af[s2], bR[n][s2], aR, 0, 0, 0); aI = __builtin_amdgcn_mfma_f32_16x16x32_bf16(Af[s2], bI[n][s2], aI, 0, 0, 0); }
                    aU = __builtin_amdgcn_mfma_f32_16x16x32_bf16(Af[n >> 1], idf[n & 1], aU, 0, 0, 0);
#pragma unroll
                    for (int r = 0; r < 4; ++r) {
                        const float rg = fast_sigmoid(aR[r] + gba[n]), ig = fast_sigmoid(aI[r] + gbx[n]);
                        const float av = __builtin_amdgcn_exp2f(rg * gkk[n]);
                        const float bv = __builtin_amdgcn_sqrtf(fmaxf(1.0f - av * av, 0.f)) * (ig * aU[r]);
                        const int tok = 4 * kq + r;
                        SA[tok * 64 + 16 * n + cc] = av; SBm[tok * 64 + 16 * n + cc] = bv;
                    }
                }
            }
            LDS_WAIT(); asm volatile("" ::: "memory");
            if (!APPLY) {
#pragma unroll
                for (int t = 0; t < 16; ++t) { const float av = SA[t * 64 + lane], bv = SBm[t * 64 + lane]; Hw = av * Hw + bv; Pw *= av; }
            } else {
#pragma unroll
                for (int t = 0; t < 16; ++t) { const float av = SA[t * 64 + lane], bv = SBm[t * 64 + lane]; Hw = av * Hw + bv;
                    const float gv = __builtin_bit_cast(float, (unsigned)GT[t * 64 + lane] << 16);
                    GT[t * 64 + lane] = (unsigned short)f2bf(Hw * gv); }
                LDS_WAIT(); asm volatile("" ::: "memory");
#pragma unroll
                for (int e = 0; e < 2; ++e) { const u32x4 o = *(const LAS u32x4*)(wl + MX_GT + (tr + 8 * e) * 128 + g * 16);
                    *(u32x4*)(GG + (size_t)(tb + tr + 8 * e) * DM + ch0) = o; }
            }
        }
        if (!APPLY) {
            SUM[((size_t)(b * 64 + span)) * DM + chb + lane] = (f32x2){Pw, Hw};
            WSX[w * 64 + lane] = (f32x2){Pw, Hw};
            LDS_WAIT(); __syncthreads();
            if (w == 0) { float Pu = 1.f, Hu = 0.f;
#pragma unroll
                for (int j = 0; j < 8; ++j) { const f32x2 sj = WSX[j * 64 + lane]; Hu = sj.x * Hu + sj.y; Pu *= sj.x; }
                SUMG[((size_t)(b * 8 + g8)) * DM + chb + lane] = (f32x2){Pu, Hu}; }
            LDS_WAIT(); __syncthreads();
        }
    }
}

constexpr int N_PHASES = 8 * DEPTH + 1;
__global__ void __launch_bounds__(NWAVES * 64, 2) fwd_kernel(Args args_unused) {
    extern __shared__ __attribute__((aligned(16))) unsigned char lds[];
    LAS unsigned char* const ldsb = (LAS unsigned char*)lds;
    for (int u = threadIdx.x; u < (LDS_BYTES - LDSCTL_OFF) / 4; u += NWAVES * 64) ((LAS unsigned*)(ldsb + LDSCTL_OFF))[u] = 0u;
    __syncthreads();
    int lo, hi;
    { KArgs a = kargs(); lo = a->ph_lo; hi = a->ph_hi;
      if (hi - lo > 1) (void)xcd_barrier_post((unsigned*)(a->ws + WS_CTL) + CW_BAR, (volatile LAS unsigned*)(ldsb + MISC_OFF) + 8); }
#define IN(k) (lo <= (k) && (k) < hi)
#define SEAM(k) do { if (IN(k) && IN((k) + 1)) { XcdBarrier b_; b_.bar = (unsigned*)(kargs()->ws + WS_CTL) + CW_BAR; b_.x = xb_xcc_id(); b_.st = (volatile LAS unsigned*)(ldsb + MISC_OFF) + 8; xcd_barrier(b_); } } while (0)
    constexpr size_t TS1 = (size_t)256 * DM * 2, TSF = (size_t)256 * DFF * 2;

#pragma unroll 1
    for (int l = 0; l < DEPTH; ++l) {
        const int pb = 8 * l;
        if (IN(pb + 0)) { Frame F = make_frame(ldsb); p0_weights(F, l); if (l == 0) p0_x(F); }
        if (PROBE_REPEAT == 0 && IN(pb + 0)) { Frame F = make_frame(ldsb); p0_weights(F, l); if (l == 0) p0_x(F); }
        SEAM(pb + 0);
        if (IN(pb + 1)) {
            Frame F = make_frame(ldsb); KArgs a = kargs(); unsigned char* ws = a->ws;
            pg8::SchedPlain S; S.so.init(M, N1A, F.G, F.bx); S.A0 = (const char*)(ws + WS_S0); S.B0 = (const char*)(ws + WS_WIN); S.tstep = TS1;
            pg8::EpiP1a E{(const float*)(ws + WS_SSQ), (bf16_t*)(ws + WS_S1), (bf16_t*)(ws + WS_S2), (bf16_t*)(ws + WS_S3), (bf16_t*)(ws + WS_S4)};
            pg8::gemm_phase<pg8::EpiP1a, pg8::SchedPlain, true, true>(F.lds, F.tid, DM, S, E);
        }
        SEAM(pb + 1);
        if (IN(pb + 2)) { { Frame F = make_frame(ldsb); p2_mixer_a(F, l); } { Frame F = make_frame(ldsb); mixer_b<false>(F, l); } }
        if (PROBE_REPEAT == 2 && IN(pb + 2)) { __syncthreads(); Frame F = make_frame(ldsb); mixer_b<false>(F, l); }
        SEAM(pb + 2);
        if (IN(pb + 3)) { Frame F = make_frame(ldsb); mixer_b<true>(F, l); }
        SEAM(pb + 3);
        if (IN(pb + 4)) {
            Frame F = make_frame(ldsb); KArgs a = kargs(); unsigned char* ws = a->ws;
            pg8::StaticOrder so; so.init(M, DM, F.G, F.bx);
            int pm_ = 0, pn_ = 0; const bool ok_ = so.next(0, pm_, pn_);
            pg8::SchedP4 S; S.valid = ok_; S.pm = pm_; S.pn = pn_; S.ws = (const char*)ws;
            pg8::EpiP4 E{(const float*)(ws + WS_SSQ), a->in[I_GB] + (size_t)l * 2 * DM, (bf16_t*)(ws + WS_S2), (bf16_t*)(ws + WS_S3), (bf16_t*)(ws + WS_S5)};
            pg8::gemm_phase<pg8::EpiP4, pg8::SchedP4, false, true>(F.lds, F.tid, DM, S, E);
        }
        SEAM(pb + 4);
        if (IN(pb + 5)) {
            Frame F = make_frame(ldsb); KArgs a = kargs(); unsigned char* ws = a->ws;
            pg8::SchedPlain S; S.so.init(M, DM, F.G, F.bx); S.A0 = (const char*)(ws + WS_S5); S.B0 = (const char*)(ws + WS_WO); S.tstep = TS1;
            pg8::EpiRes E{l == 0 ? a->in[I_X] : a->out, a->out, (bf16_t*)(ws + WS_S0), (float*)(ws + WS_SSQ)};
            pg8::gemm_phase<pg8::EpiRes, pg8::SchedPlain, false, true>(F.lds, F.tid, DM, S, E);
        }
        SEAM(pb + 5);
        if (IN(pb + 6)) {
            Frame F = make_frame(ldsb); KArgs a = kargs(); unsigned char* ws = a->ws;
            pg8::SchedPlain S; S.so.init(M, NGU, F.G, F.bx); S.A0 = (const char*)(ws + WS_S0); S.B0 = (const char*)(ws + WS_WGU); S.tstep = TS1;
            pg8::EpiP6 E{(const float*)(ws + WS_SSQ), (bf16_t*)(ws + WS_S1)};
            pg8::gemm_phase<pg8::EpiP6, pg8::SchedPlain, true, true>(F.lds, F.tid, DM, S, E);
        }
        SEAM(pb + 6);
        if (IN(pb + 7)) {
            Frame F = make_frame(ldsb); KArgs a = kargs(); unsigned char* ws = a->ws;
            pg8::SchedPlain S; S.so.init(M, DM, F.G, F.bx); S.A0 = (const char*)(ws + WS_S1); S.B0 = (const char*)(ws + WS_WD); S.tstep = TSF;
            pg8::EpiRes E{a->out, a->out, (bf16_t*)(ws + WS_S0), (float*)(ws + WS_SSQ)};
            pg8::gemm_phase<pg8::EpiRes, pg8::SchedPlain, false, true>(F.lds, F.tid, DFF, S, E);
        }
        SEAM(pb + 7);
    }
    if (IN(8 * DEPTH)) { Frame F = make_frame(ldsb); p8_final(F); }
#undef IN
#undef SEAM
}

extern "C" void kernel_launch(void* const* d_in, const int* in_sizes, int n_in, void* d_out, int out_size, void* d_ws, size_t ws_size, hipStream_t stream) {
    static int grid = 0;
    if (grid == 0) {
        if (n_in != 20 || in_sizes[0] != M * DM || out_size != M * DM || ws_size < WS_END) {
            fprintf(stderr, "kernel_launch: unexpected shapes: n_in %d in0 %d out %d ws %zu (need %zu)\n", n_in, n_in > 0 ? in_sizes[0] : -1, out_size, ws_size, (size_t)WS_END); grid = -1; return; }
        int dev = 0, cus = 0, per_cu = 0;
        if (hipGetDevice(&dev) != hipSuccess || hipDeviceGetAttribute(&cus, hipDeviceAttributeMultiprocessorCount, dev) != hipSuccess) { grid = -1; return; }
        if (hipFuncSetAttribute((const void*)fwd_kernel, hipFuncAttributeMaxDynamicSharedMemorySize, LDS_BYTES) != hipSuccess) { fprintf(stderr, "kernel_launch: hipFuncSetAttribute failed\n"); grid = -1; return; }
        if (hipOccupancyMaxActiveBlocksPerMultiprocessor(&per_cu, (const void*)fwd_kernel, NWAVES * 64, LDS_BYTES) != hipSuccess || per_cu < 1)
            fprintf(stderr, "kernel_launch: occupancy query reports %d workgroups per CU\n", per_cu);
        (void)hipGetLastError();
        grid = cus;
        if (grid != 256) fprintf(stderr, "kernel_launch: %d CUs (built for 256)\n", grid);
    }
    if (grid < 0) return;
    (void)hipMemsetAsync((char*)d_ws + WS_CTL, 0, CTL_ZERO_BYTES, stream);
    Args a{};
    for (int i = 0; i < 20; ++i) a.in[i] = (const float*)d_in[i];
    a.out = (float*)d_out; a.ws = (unsigned char*)d_ws;
#if MK_PER_PHASE
    for (int p = 0; p < N_PHASES; ++p) { a.ph_lo = p; a.ph_hi = p + 1; hipLaunchKernelGGL(fwd_kernel, dim3(grid), dim3(NWAVES * 64), LDS_BYTES, stream, a); }
#else
    a.ph_lo = 0; a.ph_hi = N_PHASES;
    hipLaunchKernelGGL(fwd_kernel, dim3(grid), dim3(NWAVES * 64), LDS_BYTES, stream, a);
#endif
}
```

```cpp
#include <hip/hip_runtime.h>
#include <cstdio>
#include <cstdint>

#ifndef PROBE_REPEAT
#define PROBE_REPEAT -1
#endif
#ifndef MK_PER_PHASE
#define MK_PER_PHASE 0
#endif

#define LAS __attribute__((address_space(3)))
#define GAS __attribute__((address_space(1)))
typedef unsigned short bf16_t;
typedef short bf16x8 __attribute__((ext_vector_type(8)));
typedef float f32x4 __attribute__((ext_vector_type(4)));
typedef float f32x2 __attribute__((ext_vector_type(2)));
typedef unsigned u32x4 __attribute__((ext_vector_type(4)));
typedef unsigned u32x2 __attribute__((ext_vector_type(2)));
typedef GAS unsigned gu32;

constexpr int BATCH = 2, SEQ = 8192, DM = 1024, M = BATCH * SEQ, NIN = 7168, DFF = 2816, NGU = 2 * DFF, NHEAD = 16, HD = 64, DEPTH = 2;
constexpr float RMS_EPS = 1e-6f;
constexpr int NWAVES = 8;
constexpr int N1A = 5120;
constexpr int ROW_GG = 5120;

constexpr size_t MiB = 1u << 20;
constexpr size_t WS_CTL = 0, CTL_ZERO_BYTES = 1 * MiB;
constexpr size_t WS_SSQ = 1 * MiB;
constexpr size_t WS_SUM = 2 * MiB;
constexpr size_t WS_LRU = 3 * MiB;
constexpr size_t WS_SUMG = 3 * MiB + 512 * 1024;
constexpr size_t WS_WIN = 4 * MiB, WS_WOA = 18 * MiB, WS_WOB = 20 * MiB, WS_WO = 22 * MiB, WS_WGU = 24 * MiB, WS_WD = 35 * MiB;
constexpr size_t WS_S0 = 48 * MiB, SLOT = 32 * MiB;
constexpr size_t WS_S1 = WS_S0 + SLOT, WS_S2 = WS_S1 + SLOT, WS_S3 = WS_S2 + SLOT, WS_S4 = WS_S3 + SLOT, WS_S5 = WS_S4 + SLOT, WS_END = WS_S5 + SLOT;
static_assert(WS_WD + (size_t)DM * DFF * 2 <= WS_S0 && WS_END <= 256 * MiB, "d_ws map");
constexpr int CW_BAR = 4096;

constexpr int RING_BYTES = 131072;
constexpr int LDSCTL_OFF = RING_BYTES, MISC_OFF = LDSCTL_OFF + 320;
constexpr int LDS_BYTES = 147456;

#define RLX_AGENT __ATOMIC_RELAXED, __HIP_MEMORY_SCOPE_AGENT
#define LDS_WAIT() asm volatile("s_waitcnt lgkmcnt(0)" ::: "memory")
#define VM_WAIT() asm volatile("s_waitcnt vmcnt(0)" ::: "memory")
__device__ __forceinline__ unsigned f2bf(float f) { unsigned u = __builtin_bit_cast(unsigned, f); return (u + 0x7fffu + ((u >> 16) & 1u)) >> 16; }
__device__ __forceinline__ unsigned pk2(float lo, float hi) { return f2bf(lo) | (f2bf(hi) << 16); }
__device__ __forceinline__ unsigned cvt_pk_bf16(float lo, float hi) { unsigned r; asm volatile("v_cvt_pk_bf16_f32 %0, %1, %2" : "=v"(r) : "v"(lo), "v"(hi)); return r; }
__device__ __forceinline__ float bflo(unsigned w) { return __builtin_bit_cast(float, w << 16); }
__device__ __forceinline__ float bfhi(unsigned w) { return __builtin_bit_cast(float, w & 0xffff0000u); }
__device__ __forceinline__ float fast_exp(float x) { return __builtin_amdgcn_exp2f(x * 1.4426950408889634f); }
__device__ __forceinline__ float fast_sigmoid(float x) { return __builtin_amdgcn_rcpf(1.0f + fast_exp(-x)); }
__device__ __forceinline__ float gelu_tanh(float x) {
    const float z = 1.5957691216057308f * (x + 0.044715f * x * x * x);
    return x * __builtin_amdgcn_rcpf(1.0f + fast_exp(-z));
}
__device__ __forceinline__ float rstd_of(const float* ssq, int row) {
    const f32x4 s = *(const f32x4*)(ssq + (size_t)row * 4);
    return __builtin_amdgcn_rsqf(((s.x + s.y) + (s.z + s.w)) * (1.0f / DM) + RMS_EPS);
}

#define XB_TMO      128
#define XB_XCNT(j)  (256  + 64 * (j))
#define XB_XSUB(j)  (1280 + 64 * (j))
#define XB_XGEN(j)  (2304 + 64 * (j))
#define XB_TOP      3328
#define XB_TOPGEN   3392
#define XCD_BAR_WORDS 3456
#define XB_SPIN_CAP (1u << 22)
__device__ __forceinline__ unsigned xb_ld(unsigned* p)              { return __hip_atomic_load(p, __ATOMIC_RELAXED, __HIP_MEMORY_SCOPE_AGENT); }
__device__ __forceinline__ unsigned xb_add(unsigned* p, unsigned v) { return __hip_atomic_fetch_add(p, v, __ATOMIC_RELAXED, __HIP_MEMORY_SCOPE_AGENT); }
__device__ __forceinline__ unsigned xb_xcc_id() { return (unsigned)__builtin_amdgcn_s_getreg((3 << 11) | 20) & 0xFu; }
#define XB_SPIN(cond, bar) do { unsigned _sp = 0; while (cond) { __builtin_amdgcn_s_sleep(1); \
    if ((++_sp & 255u) == 0u) { if (xb_ld(&(bar)[XB_TMO])) break; if (_sp > XB_SPIN_CAP) { atomicAdd(&(bar)[XB_TMO], 1u); break; } } } } while (0)
struct XcdBarrier { unsigned* bar; unsigned x; volatile LAS unsigned* st; };
__device__ __forceinline__ XcdBarrier xcd_barrier_post(unsigned* bar, volatile LAS unsigned* st) {
    XcdBarrier b; b.bar = bar; b.x = xb_xcc_id(); b.st = st;
    if (threadIdx.x == 0) (void)xb_add(&bar[XB_XCNT(b.x)], 1u);
    return b;
}
__device__ __forceinline__ void xcd_barrier_complete(unsigned* bar, unsigned x, unsigned& nloc, unsigned& nx) {
    const unsigned G = gridDim.x * gridDim.y * gridDim.z;
    unsigned sum, cnt, mine, sp = 0u;
    for (;;) {
        sum = 0u; cnt = 0u; mine = 0u;
#pragma unroll
        for (unsigned j = 0; j < 16; ++j) { const unsigned c = xb_ld(&bar[XB_XCNT(j)]); sum += c; cnt += (c > 0u) ? 1u : 0u; mine = (j == x) ? c : mine; }
        if (sum == G) break;
        __builtin_amdgcn_s_sleep(1);
        if ((++sp & 255u) == 0u) { if (xb_ld(&bar[XB_TMO])) break; if (sp > XB_SPIN_CAP) { atomicAdd(&bar[XB_TMO], 1u); break; } }
    }
    nloc = mine > 0u ? mine : 1u; nx = cnt > 0u ? cnt : 1u;
}
__device__ __forceinline__ void xcd_barrier(const XcdBarrier& b) {
    asm volatile("s_waitcnt vmcnt(0)" ::: "memory");
    __syncthreads();
    if (threadIdx.x == 0) {
        unsigned* bar = b.bar;
        __builtin_amdgcn_s_waitcnt(0);
        unsigned nloc = b.st[0], nx = b.st[1];
        if (nloc == 0u) { xcd_barrier_complete(bar, b.x, nloc, nx); b.st[0] = nloc; b.st[1] = nx; }
        const unsigned old = xb_add(&bar[XB_XSUB(b.x)], 1u);
        const unsigned gen = old / nloc;
        if (old + 1u == (gen + 1u) * nloc) {
            __builtin_amdgcn_fence(__ATOMIC_RELEASE, "agent");
            asm volatile("s_waitcnt vmcnt(0)" ::: "memory");
            const unsigned og = xb_add(&bar[XB_TOP], 1u);
            const unsigned tg = og / nx;
            if (og + 1u == (tg + 1u) * nx) xb_add(&bar[XB_TOPGEN], 1u);
            else XB_SPIN(xb_ld(&bar[XB_TOPGEN]) == tg, bar);
            __builtin_amdgcn_fence(__ATOMIC_ACQUIRE, "agent");
            xb_add(&bar[XB_XGEN(b.x)], 1u);
            asm volatile("s_waitcnt vmcnt(0)" ::: "memory");
        } else {
            XB_SPIN(xb_ld(&bar[XB_XGEN(b.x)]) == gen, bar);
            __builtin_amdgcn_fence(__ATOMIC_ACQUIRE, "agent");
            asm volatile("s_waitcnt vmcnt(0)" ::: "memory");
        }
    }
    __syncthreads();
}

namespace pg8 {
constexpr int BM = 256, BK = 64, HALF = 128, HTB = HALF * BK * 2, NXCD = 8, WGM = 8;
__host__ __device__ __forceinline__ int lds_byte(int r, int c) { const int st = (r >> 4) * 2 + (c >> 5), rr = r & 15, cc = c & 31, ob = rr * 64 + cc * 2; return st * 1024 + (ob ^ (((ob >> 9) & 1) << 5)); }
__host__ __device__ __forceinline__ void stage_rc(int b, int& R, int& C) { const int st = b / 1024, sb = b % 1024, swz = sb ^ (((sb >> 9) & 1) << 5); R = (st >> 1) * 16 + swz / 64; C = (st & 1) * 32 + (swz % 64) / 2; }
__host__ __device__ __forceinline__ int perm32(int rho) { const int n = rho >> 4, i = rho & 15; return 8 * (i >> 2) + 4 * n + (i & 3); }

struct Unit { int pm, pn, kind; };

struct StaticOrder {
    int nM, nN, nwg, G, c;
    __device__ __forceinline__ void init(int M_, int N_, int G_, int c_) { nM = M_ / BM; nN = N_ / BM; nwg = nM * nN; G = G_; c = c_; }
    __device__ __forceinline__ bool next(int i, int& pm, int& pn) const {
        const long L = (long)i * G + c; if (L >= nwg) return false;
        int wgid = (int)L; { const int q = nwg / NXCD, r = nwg % NXCD, xcd = wgid % NXCD, off = wgid / NXCD; wgid = (xcd < r ? xcd * (q + 1) : r * (q + 1) + (xcd - r) * q) + off; }
        const int nig = WGM * nN, gid = wgid / nig, fm = gid * WGM, gsz = (nM - fm) < WGM ? (nM - fm) : WGM;
        pm = fm + ((wgid % nig) % gsz); pn = (wgid % nig) / gsz; return true;
    }
};
struct SchedPlain {
    StaticOrder so; const char* A0; const char* B0; size_t tstep;
    __device__ __forceinline__ bool next(int i, Unit& u) const { int pm_ = 0, pn_ = 0; const bool ok_ = so.next(i, pm_, pn_); u.pm = pm_; u.pn = pn_; u.kind = 0; return ok_; }
    __device__ __forceinline__ const char* a_ptr(const Unit& u) const { return A0 + (size_t)u.pm * tstep; }
    __device__ __forceinline__ const char* b_ptr(const Unit& u) const { return B0 + (size_t)u.pn * tstep; }
};
struct SchedGG {
    int pm, pn; bool valid; const char* ws;
    static constexpr size_t TS = (size_t)256 * DM * 2;
    __device__ __forceinline__ bool next(int i, Unit& u) const { if (!valid || i >= 2) return false; u.pm = pm; u.kind = 0; u.pn = 2 * pn + i; return true; }
    __device__ __forceinline__ const char* a_ptr(const Unit& u) const { return ws + WS_S0 + (size_t)u.pm * TS; }
    __device__ __forceinline__ const char* b_ptr(const Unit& u) const { return ws + WS_WIN + (size_t)ROW_GG * DM * 2 + (size_t)u.pn * TS; }
};
struct SchedOut {
    int pm, pn; bool valid; const char* ws;
    static constexpr size_t TS = (size_t)256 * DM * 2;
    __device__ __forceinline__ bool next(int i, Unit& u) const { if (!valid || i >= 2) return false; u.pm = pm; u.kind = i + 1; u.pn = pn; return true; }
    __device__ __forceinline__ const char* a_ptr(const Unit& u) const { return ws + WS_S1 + (size_t)(u.kind == 2) * (WS_S4 - WS_S1) + (size_t)u.pm * TS; }
    __device__ __forceinline__ const char* b_ptr(const Unit& u) const { return ws + WS_WOA + (size_t)(u.kind == 2) * (WS_WOB - WS_WOA) + (size_t)u.pn * TS; }
};

template <class Epi, class Sched, bool ALIGN_EPI, bool SP2>
__device__ __forceinline__ void gemm_phase(LAS unsigned char* lds, const int tid, const int K, const Sched& S, const Epi& E) {
    const int wid = __builtin_amdgcn_readfirstlane(tid >> 6), lane = tid & 63, wr = wid >> 2, wc = wid & 3, fr = lane & 15, fq = lane >> 4;
    const int nt = K / BK;
    unsigned voffA[2], voffB[2];
#pragma unroll
    for (int i = 0; i < 2; ++i) { int R, C; stage_rc(tid * 16 + i * 8192, R, C); const int Rb = Epi::PERM ? ((R & ~31) + perm32(R & 31)) : R;
        voffA[i] = (unsigned)(R * K + C) * 2u; voffB[i] = (unsigned)(Rb * K + C) * 2u; }
    const size_t kstep = (size_t)(BK * 2);
    const size_t hstep = (size_t)HALF * K * 2;
    const unsigned ldsw = (unsigned)wid * 1024u;
    const int aoff = lds_byte(wr * 64 + fr, fq * 8), boff = lds_byte(wc * 32 + fr, fq * 8);
#define PG8_SA(b, h) (((b) * 2 + (h)) * HTB)
#define PG8_SB(b, h) ((4 + (b) * 2 + (h)) * HTB)
#define PG8_STAGE(bufoff, gbase, voff) do { _Pragma("unroll") for (int _i = 0; _i < 2; ++_i) \
        __builtin_amdgcn_global_load_lds((const unsigned*)((const char*)(gbase) + (voff)[_i]), (LAS unsigned*)(lds + (bufoff) + ldsw + _i * 8192), 16, 0, 0); } while (0)
#define PG8_LDA(dst, b, h) do { _Pragma("unroll") for (int m = 0; m < 4; ++m) _Pragma("unroll") for (int k = 0; k < 2; ++k) dst[m][k] = *(const LAS bf16x8*)(lds + PG8_SA(b, h) + aoff + m * 2048 + k * 1024); } while (0)
#define PG8_LDB(dst, b, h) do { _Pragma("unroll") for (int n = 0; n < 2; ++n) _Pragma("unroll") for (int k = 0; k < 2; ++k) dst[n][k] = *(const LAS bf16x8*)(lds + PG8_SB(b, h) + boff + n * 2048 + k * 1024); } while (0)
#define PG8_MMA(ai, bj, At, Bt) do { __builtin_amdgcn_s_setprio(1); _Pragma("unroll") for (int m = 0; m < 4; ++m) _Pragma("unroll") for (int n = 0; n < 2; ++n) _Pragma("unroll") for (int k = 0; k < 2; ++k) \
        acc[ai][bj][m][n] = __builtin_amdgcn_mfma_f32_16x16x32_bf16(Bt[n][k], At[m][k], acc[ai][bj][m][n], 0, 0, 0); __builtin_amdgcn_s_setprio(0); } while (0)
#define PG8_WAIT_V(n) asm volatile("s_waitcnt vmcnt(" #n ")" ::: "memory")
#define PG8_WAIT_L(n) asm volatile("s_waitcnt lgkmcnt(" #n ")" ::: "memory")
#define PG8_BAR __builtin_amdgcn_s_barrier()
#define PG8_SCHED __builtin_amdgcn_sched_barrier(0)
    Unit cur, nxt; int ui = 0;
    if (!S.next(0, cur)) return;
    f32x4 acc[2][2][4][2];
#pragma unroll
    for (int a = 0; a < 2; ++a)
#pragma unroll
        for (int b = 0; b < 2; ++b)
#pragma unroll
            for (int m = 0; m < 4; ++m)
#pragma unroll
                for (int n = 0; n < 2; ++n) acc[a][b][m][n] = (f32x4){0.f, 0.f, 0.f, 0.f};
    bf16x8 At[4][2], B0[2][2], B1[2][2];
    const char* cA = S.a_ptr(cur); const char* cB = S.b_ptr(cur);
    if constexpr (SP2) {
        PG8_STAGE(PG8_SB(0, 0), cB, voffB); PG8_STAGE(PG8_SB(0, 1), cB + hstep, voffB); PG8_STAGE(PG8_SA(0, 0), cA, voffA); PG8_STAGE(PG8_SA(0, 1), cA + hstep, voffA);
        if (wr == 1) PG8_BAR;
        PG8_WAIT_V(2); PG8_BAR;
        PG8_STAGE(PG8_SB(1, 0), cB + kstep, voffB); PG8_STAGE(PG8_SA(1, 0), cA + kstep, voffA); PG8_STAGE(PG8_SB(1, 1), cB + hstep + kstep, voffB);
        PG8_WAIT_V(6); PG8_BAR;
    } else {
        PG8_STAGE(PG8_SB(0, 0), cB, voffB); PG8_STAGE(PG8_SA(0, 0), cA, voffA); PG8_STAGE(PG8_SB(0, 1), cB + hstep, voffB); PG8_STAGE(PG8_SA(0, 1), cA + hstep, voffA);
        if (wr == 1) PG8_BAR;
        PG8_WAIT_V(4); PG8_BAR;
        PG8_STAGE(PG8_SB(1, 0), cB + kstep, voffB); PG8_STAGE(PG8_SA(1, 0), cA + kstep, voffA); PG8_STAGE(PG8_SB(1, 1), cB + hstep + kstep, voffB);
        PG8_WAIT_V(6); PG8_BAR;
    }
    for (;;) {
        const bool has_next = S.next(ui + 1, nxt);
        const char* nA = has_next ? S.a_ptr(nxt) : cA; const char* nB = has_next ? S.b_ptr(nxt) : cB;
        for (int t = 0; t < nt; t += 2) {
            const bool last = (t == nt - 2);
            const char* a1 = cA + (size_t)(t + 1) * kstep;
            const char* a2 = last ? nA : cA + (size_t)(t + 2) * kstep; const char* b2 = last ? nB : cB + (size_t)(t + 2) * kstep;
            const char* a3 = a2 + kstep; const char* b3 = b2 + kstep;
            if constexpr (SP2) {
            PG8_LDB(B0, 0, 0); PG8_LDB(B1, 0, 1); PG8_SCHED; PG8_LDA(At, 0, 0); PG8_STAGE(PG8_SA(1, 1), a1 + hstep, voffA);
            PG8_WAIT_V(8); PG8_WAIT_L(0); PG8_BAR; PG8_MMA(0, 0, At, B0); PG8_MMA(0, 1, At, B1); PG8_BAR; PG8_SCHED;
            PG8_LDA(At, 0, 1); PG8_STAGE(PG8_SB(0, 0), b2, voffB); PG8_STAGE(PG8_SB(0, 1), b2 + hstep, voffB); PG8_STAGE(PG8_SA(0, 0), a2, voffA);
            PG8_WAIT_V(8); PG8_WAIT_L(0); PG8_BAR; PG8_MMA(1, 0, At, B0); PG8_MMA(1, 1, At, B1); PG8_BAR; PG8_SCHED;
            PG8_LDB(B0, 1, 0); PG8_LDB(B1, 1, 1); PG8_SCHED; PG8_LDA(At, 1, 0); PG8_STAGE(PG8_SA(0, 1), a2 + hstep, voffA);
            PG8_WAIT_V(8); PG8_WAIT_L(0); PG8_BAR; PG8_MMA(0, 0, At, B0); PG8_MMA(0, 1, At, B1); PG8_BAR; PG8_SCHED;
            PG8_LDA(At, 1, 1); PG8_STAGE(PG8_SB(1, 0), b3, voffB); PG8_STAGE(PG8_SB(1, 1), b3 + hstep, voffB); PG8_STAGE(PG8_SA(1, 0), a3, voffA);
            PG8_WAIT_V(8); PG8_WAIT_L(0); PG8_BAR; PG8_MMA(1, 0, At, B0); PG8_MMA(1, 1, At, B1); PG8_BAR; PG8_SCHED;
            } else {
            PG8_LDB(B0, 0, 0); PG8_SCHED; PG8_LDA(At, 0, 0); PG8_STAGE(PG8_SA(1, 1), a1 + hstep, voffA);
            PG8_WAIT_L(8); PG8_BAR; PG8_WAIT_L(0); PG8_MMA(0, 0, At, B0); PG8_BAR; PG8_SCHED;
            PG8_LDB(B1, 0, 1); PG8_STAGE(PG8_SB(0, 0), b2, voffB);
            PG8_BAR; PG8_WAIT_L(0); PG8_MMA(0, 1, At, B1); PG8_BAR;
            PG8_LDA(At, 0, 1); PG8_STAGE(PG8_SA(0, 0), a2, voffA);
            PG8_BAR; PG8_WAIT_L(0); PG8_MMA(1, 0, At, B0); PG8_BAR; PG8_SCHED;
            PG8_STAGE(PG8_SB(0, 1), b2 + hstep, voffB);
            PG8_WAIT_V(6); PG8_BAR; PG8_MMA(1, 1, At, B1); PG8_BAR;
            PG8_LDB(B0, 1, 0); PG8_SCHED; PG8_LDA(At, 1, 0); PG8_STAGE(PG8_SA(0, 1), a2 + hstep, voffA);
            PG8_WAIT_L(8); PG8_BAR; PG8_WAIT_L(0); PG8_MMA(0, 0, At, B0); PG8_BAR; PG8_SCHED;
            PG8_LDB(B1, 1, 1); PG8_STAGE(PG8_SB(1, 0), b3, voffB);
            PG8_BAR; PG8_WAIT_L(0); PG8_MMA(0, 1, At, B1); PG8_BAR;
            PG8_LDA(At, 1, 1); PG8_STAGE(PG8_SA(1, 0), a3, voffA);
            PG8_BAR; PG8_WAIT_L(0); PG8_MMA(1, 0, At, B0); PG8_BAR; PG8_SCHED;
            PG8_STAGE(PG8_SB(1, 1), b3 + hstep, voffB);
            PG8_WAIT_V(6); PG8_BAR; PG8_MMA(1, 1, At, B1); PG8_BAR;
            }
        }
        if constexpr (ALIGN_EPI) { if (wr == 0) PG8_BAR; }
        if constexpr (!Epi::AFTER_DRAIN) { E(acc, cur, wr, wc, fr, fq); }
        if (!has_next) break;
        if constexpr (Epi::KEEPS) {
            E.rescale(acc, cur, wr, wc, fr, fq);
        } else {
#pragma unroll
            for (int a = 0; a < 2; ++a)
#pragma unroll
                for (int b = 0; b < 2; ++b)
#pragma unroll
                    for (int m = 0; m < 4; ++m)
#pragma unroll
                        for (int n = 0; n < 2; ++n) acc[a][b][m][n] = (f32x4){0.f, 0.f, 0.f, 0.f};
        }
        cur = nxt; cA = nA; cB = nB; ++ui;
        if constexpr (ALIGN_EPI) { if (wr == 1) PG8_BAR; }
    }
    PG8_WAIT_V(0);
    if constexpr (!ALIGN_EPI) { if (wr == 0) PG8_BAR; }
    PG8_BAR;
    if constexpr (Epi::AFTER_DRAIN) { E.fused(acc, cur, wr, wc, fr, fq, lds, wid, lane); }
#undef PG8_SA
#undef PG8_SB
#undef PG8_STAGE
#undef PG8_LDA
#undef PG8_LDB
#undef PG8_MMA
#undef PG8_WAIT_V
#undef PG8_WAIT_L
#undef PG8_BAR
#undef PG8_SCHED
}

__device__ __forceinline__ void rstd8(const float* ssq, int row0, float (&rs)[2][4]) {
    f32x4 q[2][4];
#pragma unroll
    for (int ai = 0; ai < 2; ++ai)
#pragma unroll
        for (int m = 0; m < 4; ++m) q[ai][m] = *(const f32x4*)(ssq + (size_t)(row0 + ai * HALF + m * 16) * 4);
#pragma unroll
    for (int ai = 0; ai < 2; ++ai)
#pragma unroll
        for (int m = 0; m < 4; ++m) rs[ai][m] = __builtin_amdgcn_rsqf(((q[ai][m].x + q[ai][m].y) + (q[ai][m].z + q[ai][m].w)) * (1.0f / DM) + RMS_EPS);
}
__device__ __forceinline__ u32x4 pack8(const f32x4 a, const f32x4 b) { u32x4 w; w.x = cvt_pk_bf16(a[0], a[1]); w.y = cvt_pk_bf16(a[2], a[3]); w.z = cvt_pk_bf16(b[0], b[1]); w.w = cvt_pk_bf16(b[2], b[3]); return w; }

struct EpiP1a {
    static constexpr bool PERM = true, AFTER_DRAIN = false, KEEPS = false;
    const float* ssq; bf16_t *BA, *V, *XBp, *GG;
    __device__ __forceinline__ bool keep(const Unit&) const { return false; }
    __device__ __forceinline__ void operator()(f32x4 (&acc)[2][2][4][2], const Unit& u, int wr, int wc, int fr, int fq) const {
        int row0 = u.pm * BM + wr * 64 + fr; asm volatile("" : "+v"(row0));
        const int pn = u.pn;
        float rs[2][4]; rstd8(ssq, row0, rs);
        if (pn >= 4 && pn < 12) {
            const int col = (pn - 4) * 128 + wc * 32 + 8 * fq;
#pragma unroll
            for (int ai = 0; ai < 2; ++ai)
#pragma unroll
                for (int m = 0; m < 4; ++m) { const int row = row0 + ai * HALF + m * 16; const float r = rs[ai][m], r2 = r * r;
                    const f32x4 v0 = acc[ai][0][m][0] * acc[ai][1][m][0] * r2, v1 = acc[ai][0][m][1] * acc[ai][1][m][1] * r2;
                    *(u32x4*)(V + (size_t)row * DM + col) = pack8(v0, v1); }
        } else {
            bf16_t* O; int colt; bool act = false;
            if (pn < 4) { O = BA; colt = pn * 256; } else if (pn < 16) { O = XBp; colt = (pn - 12) * 256; } else { O = GG; colt = (pn - 16) * 256; act = true; }
            const int col = colt + wc * 32 + 8 * fq;
#pragma unroll
            for (int ai = 0; ai < 2; ++ai)
#pragma unroll
                for (int m = 0; m < 4; ++m) { const int row = row0 + ai * HALF + m * 16; const float r = rs[ai][m];
#pragma unroll
                    for (int bj = 0; bj < 2; ++bj) { f32x4 v0 = acc[ai][bj][m][0] * r, v1 = acc[ai][bj][m][1] * r;
                        if (act) {
#pragma unroll
                            for (int i = 0; i < 4; ++i) { v0[i] = gelu_tanh(v0[i]); v1[i] = gelu_tanh(v1[i]); } }
                        *(u32x4*)(O + (size_t)row * DM + col + bj * HALF) = pack8(v0, v1); } }
        }
    }
};
struct EpiGG {
    static constexpr bool PERM = true, AFTER_DRAIN = false, KEEPS = false;
    const float* ssq; const float* gbias;
    bf16_t *RA, *SB;
    __device__ __forceinline__ bool keep(const Unit&) const { return false; }
    __device__ __forceinline__ void operator()(f32x4 (&acc)[2][2][4][2], const Unit& u, int wr, int wc, int fr, int fq) const {
        int row0 = u.pm * BM + wr * 64 + fr; asm volatile("" : "+v"(row0));
        {
            const int col = u.pn * 128 + wc * 32 + 8 * fq;
#pragma unroll
            for (int ai = 0; ai < 2; ++ai) {
                float rs4[4];
                { f32x4 q[4];
#pragma unroll
                  for (int m = 0; m < 4; ++m) q[m] = *(const f32x4*)(ssq + (size_t)(row0 + ai * HALF + m * 16) * 4);
#pragma unroll
                  for (int m = 0; m < 4; ++m) rs4[m] = __builtin_amdgcn_rsqf(((q[m].x + q[m].y) + (q[m].z + q[m].w)) * (1.0f / DM) + RMS_EPS); }
#pragma unroll
                for (int m = 0; m < 4; ++m) { const int row = row0 + ai * HALF + m * 16; const float r = rs4[m];
                    unsigned wra[4], wsb[4];
#pragma unroll
                    for (int n = 0; n < 2; ++n) {
                        const f32x4 ba = *(const f32x4*)(gbias + col + 4 * n), bb = *(const f32x4*)(gbias + DM + col + 4 * n);
                        float ra[4], sb[4];
#pragma unroll
                        for (int i = 0; i < 4; ++i) {
                            float p = acc[ai][0][m][n][i] * r + ba[i], q = acc[ai][1][m][n][i] * r + bb[i];
                            p = fminf(fmaxf(p, -30.f), 30.f); q = fminf(fmaxf(q, -30.f), 30.f);
                            const float ep = 1.0f + fast_exp(-p), eq = 1.0f + fast_exp(-q);
                            ra[i] = eq * __builtin_amdgcn_rcpf(ep); sb[i] = __builtin_amdgcn_rcpf(eq); }
                        wra[2 * n] = cvt_pk_bf16(ra[0], ra[1]); wra[2 * n + 1] = cvt_pk_bf16(ra[2], ra[3]);
                        wsb[2 * n] = cvt_pk_bf16(sb[0], sb[1]); wsb[2 * n + 1] = cvt_pk_bf16(sb[2], sb[3]); }
                    *(u32x4*)(RA + (size_t)row * DM + col) = (u32x4){wra[0], wra[1], wra[2], wra[3]};
                    *(u32x4*)(SB + (size_t)row * DM + col) = (u32x4){wsb[0], wsb[1], wsb[2], wsb[3]}; }
                asm volatile("" ::: "memory"); }
        }
    }
};
struct EpiOut {
    static constexpr bool PERM = true, AFTER_DRAIN = false, KEEPS = true;
    const bf16_t *RA, *SB; bf16_t* MG;
    __device__ __forceinline__ bool keep(const Unit& u) const { return u.kind == 1; }
    __device__ __forceinline__ void operator()(f32x4 (&acc)[2][2][4][2], const Unit& u, int wr, int wc, int fr, int fq) const {
        int row0 = u.pm * BM + wr * 64 + fr; asm volatile("" : "+v"(row0));
        if (u.kind == 2) {
            const int col = u.pn * 256 + wc * 32 + 8 * fq;
#pragma unroll
            for (int ai = 0; ai < 2; ++ai)
#pragma unroll
                for (int mh = 0; mh < 2; ++mh) {
                    u32x4 g[2][2];
#pragma unroll
                    for (int m2 = 0; m2 < 2; ++m2)
#pragma unroll
                        for (int bj = 0; bj < 2; ++bj) g[m2][bj] = *(const u32x4*)(SB + (size_t)(row0 + ai * HALF + (2 * mh + m2) * 16) * DM + col + bj * HALF);
#pragma unroll
                    for (int m2 = 0; m2 < 2; ++m2) { const int m = 2 * mh + m2, row = row0 + ai * HALF + m * 16;
#pragma unroll
                        for (int bj = 0; bj < 2; ++bj) { const u32x4 gg = g[m2][bj];
                            const f32x4 g0 = {bflo(gg.x), bfhi(gg.x), bflo(gg.y), bfhi(gg.y)}, g1 = {bflo(gg.z), bfhi(gg.z), bflo(gg.w), bfhi(gg.w)};
                            *(u32x4*)(MG + (size_t)row * DM + col + bj * HALF) = pack8(acc[ai][bj][m][0] * g0, acc[ai][bj][m][1] * g1); } }
                    asm volatile("" ::: "memory"); }
        }
    }
    __device__ __forceinline__ void rescale(f32x4 (&acc)[2][2][4][2], const Unit& u, int wr, int wc, int fr, int fq) const {
        int row0 = u.pm * BM + wr * 64 + fr; asm volatile("" : "+v"(row0)); const int col = u.pn * 256 + wc * 32 + 8 * fq;
#pragma unroll
        for (int ai = 0; ai < 2; ++ai)
#pragma unroll
            for (int mh = 0; mh < 2; ++mh) {
                u32x4 g[2][2];
#pragma unroll
                for (int m2 = 0; m2 < 2; ++m2)
#pragma unroll
                    for (int bj = 0; bj < 2; ++bj) g[m2][bj] = *(const u32x4*)(RA + (size_t)(row0 + ai * HALF + (2 * mh + m2) * 16) * DM + col + bj * HALF);
#pragma unroll
                for (int m2 = 0; m2 < 2; ++m2) { const int m = 2 * mh + m2;
#pragma unroll
                    for (int bj = 0; bj < 2; ++bj) { const u32x4 gg = g[m2][bj];
                        const f32x4 g0 = {bflo(gg.x), bfhi(gg.x), bflo(gg.y), bfhi(gg.y)}, g1 = {bflo(gg.z), bfhi(gg.z), bflo(gg.w), bfhi(gg.w)};
                        acc[ai][bj][m][0] = acc[ai][bj][m][0] * g0; acc[ai][bj][m][1] = acc[ai][bj][m][1] * g1; } }
                asm volatile("" ::: "memory"); }
    }
};
struct EpiP6 {
    static constexpr bool PERM = true, AFTER_DRAIN = false, KEEPS = false;
    const float* ssq; bf16_t* H;
    __device__ __forceinline__ bool keep(const Unit&) const { return false; }
    __device__ __forceinline__ void operator()(f32x4 (&acc)[2][2][4][2], const Unit& u, int wr, int wc, int fr, int fq) const {
        int row0 = u.pm * BM + wr * 64 + fr; asm volatile("" : "+v"(row0)); const int col = u.pn * 128 + wc * 32 + 8 * fq;
        float rs[2][4]; rstd8(ssq, row0, rs);
#pragma unroll
        for (int ai = 0; ai < 2; ++ai)
#pragma unroll
            for (int m = 0; m < 4; ++m) { const int row = row0 + ai * HALF + m * 16; const float r = rs[ai][m];
                f32x4 h[2];
#pragma unroll
                for (int n = 0; n < 2; ++n)
#pragma unroll
                    for (int i = 0; i < 4; ++i) { const float g = acc[ai][0][m][n][i] * r, uu = acc[ai][1][m][n][i] * r;
                        h[n][i] = g * uu * __builtin_amdgcn_rcpf(1.0f + fast_exp(-g)); }
                *(u32x4*)(H + (size_t)row * DFF + col) = pack8(h[0], h[1]); }
    }
};
struct EpiRes {
    static constexpr bool PERM = false, AFTER_DRAIN = true, KEEPS = false;
    const float* base; float* X; bf16_t* XBo; float* ssq;
    __device__ __forceinline__ bool keep(const Unit&) const { return false; }
    __device__ __forceinline__ void fused(f32x4 (&acc)[2][2][4][2], const Unit& u, int wr, int wc, int fr, int fq, LAS unsigned char* lds, int wid, int lane) const {
        LAS float* P = (LAS float*)lds;
        const int col0 = u.pn * BM + wc * 32 + 4 * fq;
#pragma unroll
        for (int ai = 0; ai < 2; ++ai) {
            f32x4 bs[4][2][2];
#pragma unroll
            for (int m = 0; m < 4; ++m) { const size_t off = (size_t)(u.pm * BM + ai * HALF + wr * 64 + m * 16 + fr) * DM + col0;
#pragma unroll
                for (int bj = 0; bj < 2; ++bj)
#pragma unroll
                    for (int n = 0; n < 2; ++n) bs[m][bj][n] = *(const f32x4*)(base + off + bj * HALF + n * 16); }
#pragma unroll
            for (int m = 0; m < 4; ++m) { const int rl = ai * HALF + wr * 64 + m * 16 + fr; const size_t off = (size_t)(u.pm * BM + rl) * DM + col0;
                float ss = 0.f;
#pragma unroll
                for (int bj = 0; bj < 2; ++bj)
#pragma unroll
                    for (int n = 0; n < 2; ++n) { const f32x4 xn = bs[m][bj][n] + acc[ai][bj][m][n];
                        *(f32x4*)(X + off + bj * HALF + n * 16) = xn;
                        u32x2 w; w.x = cvt_pk_bf16(xn[0], xn[1]); w.y = cvt_pk_bf16(xn[2], xn[3]);
                        *(u32x2*)(XBo + off + bj * HALF + n * 16) = w;
                        ss += (xn[0] * xn[0] + xn[1] * xn[1]) + (xn[2] * xn[2] + xn[3] * xn[3]); }
                ss += __shfl_xor(ss, 16); ss += __shfl_xor(ss, 32);
                if (fq == 0) P[rl * 4 + wc] = ss; }
            asm volatile("" ::: "memory"); }
        asm volatile("s_waitcnt lgkmcnt(0)" ::: "memory"); __builtin_amdgcn_s_barrier(); asm volatile("" ::: "memory");
        const int t = wid * 64 + lane;
        if (t < 256) { const f32x4 p = *(const LAS f32x4*)(P + t * 4); ssq[(size_t)(u.pm * BM + t) * 4 + u.pn] = (p.x + p.y) + (p.z + p.w); }
        asm volatile("s_waitcnt lgkmcnt(0)" ::: "memory"); __builtin_amdgcn_s_barrier(); asm volatile("" ::: "memory");
    }
};
}

struct Frame {
    LAS unsigned char* lds;
    volatile LAS unsigned* MISC;
    int tid, lane, wave, vcu, G, bx;
};
__device__ __forceinline__ Frame make_frame(LAS unsigned char* lds) {
    Frame F; int tid = threadIdx.x, bx = blockIdx.x, G = gridDim.x;
    asm volatile("" : "+v"(tid), "+s"(bx), "+s"(G));
    F.lds = lds; F.MISC = (volatile LAS unsigned*)(lds + MISC_OFF);
    F.tid = tid; F.lane = tid & 63; F.wave = __builtin_amdgcn_readfirstlane(tid >> 6);
    F.G = G; F.bx = bx; F.vcu = (G % 8 == 0) ? (bx % 8) * (G / 8) + bx / 8 : bx;
    return F;
}
struct Args { const float* in[20]; float* out; unsigned char* ws; int ph_lo, ph_hi; };
#define CAS __attribute__((address_space(4)))
typedef const CAS Args* KArgs;
__device__ __forceinline__ KArgs kargs() { KArgs p = (KArgs)__builtin_amdgcn_kernarg_segment_ptr(); asm volatile("" : "+s"(p)); return p; }
enum { I_X = 0, I_LN1 = 1, I_WIN = 2, I_CAW = 3, I_CBW = 4, I_CBB = 5, I_LWA = 6, I_LBA = 7, I_LWX = 8, I_LBX = 9, I_LAM = 10, I_WOA = 11, I_WOB = 12, I_GB = 13, I_WO = 14, I_LN2 = 15, I_WG = 16, I_WU = 17, I_WD = 18, I_FG = 19 };

__device__ __forceinline__ float wave_sum(float v) {
#pragma unroll
    for (int o = 1; o < 64; o <<= 1) v += __shfl_xor(v, o);
    return v;
}

__device__ __forceinline__ void tr_item(const float* W, int K, int N, bf16_t* WT, int drow, const float* gk, LAS float* scr, int k0, int n0, int lane) {
    const int ks = lane >> 3, nq = lane & 7;
    f32x4 v[8];
#pragma unroll
    for (int i = 0; i < 8; ++i) v[i] = *(const f32x4*)(W + (size_t)(k0 + 8 * i + ks) * N + n0 + 4 * nq);
#pragma unroll
    for (int i = 0; i < 8; ++i) { const int kk = 8 * i + ks; const float sc = gk ? gk[k0 + kk] : 1.0f; LAS float* d = scr + kk * 33 + 4 * nq;
        d[0] = v[i].x * sc; d[1] = v[i].y * sc; d[2] = v[i].z * sc; d[3] = v[i].w * sc; }
    LDS_WAIT(); asm volatile("" ::: "memory");
    const int c = lane & 7;
#pragma unroll
    for (int j = 0; j < 4; ++j) { const int n = (lane >> 3) + 8 * j; const LAS float* s = scr + (8 * c) * 33 + n;
        u32x4 o; o.x = pk2(s[0 * 33], s[1 * 33]); o.y = pk2(s[2 * 33], s[3 * 33]); o.z = pk2(s[4 * 33], s[5 * 33]); o.w = pk2(s[6 * 33], s[7 * 33]);
        *(GAS u32x4*)(WT + (size_t)(drow + n) * K + k0 + 8 * c) = o; }
    LDS_WAIT(); asm volatile("" ::: "memory");
}
__device__ __forceinline__ int win_row(int n0) {
    const int seg = n0 >> 10, o = n0 & 1023, j = o >> 7, i = o & 127;
    switch (seg) {
        case 0: return o;
        case 1: return 1024 + 256 * j + i;
        case 2: return 1024 + 256 * j + 128 + i;
        case 3: return 3072 + o;
        case 4: return 4096 + o;
        case 5: return ROW_GG + 256 * j + i;
        default: return ROW_GG + 256 * j + 128 + i;
    }
}
__device__ __forceinline__ void p0_weights(Frame& F, int l) {
    KArgs a = kargs();
    unsigned char* ws = a->ws;
    LAS float* scr = (LAS float*)(F.lds + F.wave * 16384);
    const int gw = F.vcu * NWAVES + F.wave, NGW = F.G * NWAVES;
    constexpr int I_IN = (DM / 64) * (NIN / 32), I_SQ = (DM / 64) * (DM / 32), I_FF = (DM / 64) * (DFF / 32), I_DN = (DFF / 64) * (DM / 32), I_LR = 16 * 2;
    constexpr int NITEMS = I_IN + 3 * I_SQ + 2 * I_FF + I_DN + 2 * I_LR;
    const float* ln1 = a->in[I_LN1] + (size_t)l * DM; const float* ln2 = a->in[I_LN2] + (size_t)l * DM;
    for (int it = gw; it < NITEMS; it += NGW) {
        int r = it;
        if (r < I_IN) { const int nblk = NIN / 32, kb = r / nblk, nb = r % nblk; tr_item(a->in[I_WIN] + (size_t)l * DM * NIN, DM, NIN, (bf16_t*)(ws + WS_WIN), win_row(nb * 32), ln1, scr, kb * 64, nb * 32, F.lane); continue; } r -= I_IN;
        if (r < I_SQ) { const int nblk = DM / 32, kb = r / nblk, nb = r % nblk; tr_item(a->in[I_WOA] + (size_t)l * DM * DM, DM, DM, (bf16_t*)(ws + WS_WOA), nb * 32, nullptr, scr, kb * 64, nb * 32, F.lane); continue; } r -= I_SQ;
        if (r < I_SQ) { const int nblk = DM / 32, kb = r / nblk, nb = r % nblk; tr_item(a->in[I_WOB] + (size_t)l * DM * DM, DM, DM, (bf16_t*)(ws + WS_WOB), nb * 32, nullptr, scr, kb * 64, nb * 32, F.lane); continue; } r -= I_SQ;
        if (r < I_SQ) { const int nblk = DM / 32, kb = r / nblk, nb = r % nblk; tr_item(a->in[I_WO] + (size_t)l * DM * DM, DM, DM, (bf16_t*)(ws + WS_WO), nb * 32, nullptr, scr, kb * 64, nb * 32, F.lane); continue; } r -= I_SQ;
        if (r < I_FF) { const int nblk = DFF / 32, kb = r / nblk, nb = r % nblk, n0 = nb * 32; tr_item(a->in[I_WG] + (size_t)l * DM * DFF, DM, DFF, (bf16_t*)(ws + WS_WGU), 256 * (n0 >> 7) + (n0 & 127), ln2, scr, kb * 64, n0, F.lane); continue; } r -= I_FF;
        if (r < I_FF) { const int nblk = DFF / 32, kb = r / nblk, nb = r % nblk, n0 = nb * 32; tr_item(a->in[I_WU] + (size_t)l * DM * DFF, DM, DFF, (bf16_t*)(ws + WS_WGU), 256 * (n0 >> 7) + 128 + (n0 & 127), ln2, scr, kb * 64, n0, F.lane); continue; } r -= I_FF;
        if (r < I_DN) { const int nblk = DM / 32, kb = r / nblk, nb = r % nblk; tr_item(a->in[I_WD] + (size_t)l * DFF * DM, DFF, DM, (bf16_t*)(ws + WS_WD), nb * 32, nullptr, scr, kb * 64, nb * 32, F.lane); continue; } r -= I_DN;
        if (r < I_LR) { const int h = r >> 1, nb = r & 1; tr_item(a->in[I_LWA] + ((size_t)l * NHEAD + h) * HD * HD, HD, HD, (bf16_t*)(ws + WS_LRU) + (size_t)h * HD * HD, nb * 32, nullptr, scr, 0, nb * 32, F.lane); continue; } r -= I_LR;
        { const int h = r >> 1, nb = r & 1; tr_item(a->in[I_LWX] + ((size_t)l * NHEAD + h) * HD * HD, HD, HD, (bf16_t*)(ws + WS_LRU) + (size_t)(NHEAD + h) * HD * HD, nb * 32, nullptr, scr, 0, nb * 32, F.lane); }
    }
}
__device__ __forceinline__ void p0_x(Frame& F) {
    KArgs a = kargs();
    const int gw = F.vcu * NWAVES + F.wave, NGW = F.G * NWAVES;
    const float* x = a->in[I_X]; bf16_t* XB = (bf16_t*)(a->ws + WS_S0); float* ssq = (float*)(a->ws + WS_SSQ);
    for (int m = gw; m < M; m += NGW) {
        const GAS f32x4* xr = (const GAS f32x4*)(x + (size_t)m * DM) + F.lane;
        f32x4 v[4]; float s = 0.f;
#pragma unroll
        for (int j = 0; j < 4; ++j) { v[j] = xr[64 * j]; s += (v[j].x * v[j].x + v[j].y * v[j].y) + (v[j].z * v[j].z + v[j].w * v[j].w); }
        s = wave_sum(s);
        GAS u32x2* o8 = (GAS u32x2*)(XB + (size_t)m * DM) + F.lane;
#pragma unroll
        for (int j = 0; j < 4; ++j) { u32x2 w; w.x = pk2(v[j].x, v[j].y); w.y = pk2(v[j].z, v[j].w); o8[64 * j] = w; }
        if (F.lane == 0) *(f32x4*)(ssq + (size_t)m * 4) = (f32x4){s, 0.f, 0.f, 0.f};
    }
}
__device__ __forceinline__ void p8_final(Frame& F) {
    KArgs a = kargs();
    const int gw = F.vcu * NWAVES + F.wave, NGW = F.G * NWAVES;
    float* X = a->out; const float* ssq = (const float*)(a->ws + WS_SSQ); const float* g = a->in[I_FG];
    f32x4 gv[4];
#pragma unroll
    for (int j = 0; j < 4; ++j) gv[j] = *((const f32x4*)g + F.lane + 64 * j);
    for (int m = gw; m < M; m += NGW) {
        const float r = rstd_of(ssq, m);
        GAS f32x4* xr = (GAS f32x4*)(X + (size_t)m * DM) + F.lane;
#pragma unroll
        for (int j = 0; j < 4; ++j) { const f32x4 v = xr[64 * j]; xr[64 * j] = v * r * gv[j]; }
    }
}

__device__ __forceinline__ void unpack8(const u32x4 w, float (&f)[8]) { f[0] = bflo(w.x); f[1] = bfhi(w.x); f[2] = bflo(w.y); f[3] = bfhi(w.y); f[4] = bflo(w.z); f[5] = bfhi(w.z); f[6] = bflo(w.w); f[7] = bfhi(w.w); }
template <bool JUNK = false>
__device__ __forceinline__ void p2_mixer_a(Frame& F, int l) {
    KArgs a = kargs();
    bf16_t* BA = (bf16_t*)(a->ws + WS_S1); const bf16_t* V = (const bf16_t*)(a->ws + WS_S2);
    const float* cw = a->in[I_CAW] + (size_t)l * 3 * DM;
    constexpr int RB = 8, NTASK = (M / RB) * (DM / 8);
    for (int task = F.vcu * (NWAVES * 64) + F.tid; task < NTASK; task += F.G * NWAVES * 64) {
        const int cg = task & 127, rb = task >> 7, c0 = cg * 8, t0 = rb * RB;
        const bool first = (t0 % SEQ) == 0;
        u32x4 vr[RB + 2], br[RB];
        vr[0] = first ? (u32x4){0u, 0u, 0u, 0u} : *(const u32x4*)(V + (size_t)(t0 - 2) * DM + c0);
        vr[1] = first ? (u32x4){0u, 0u, 0u, 0u} : *(const u32x4*)(V + (size_t)(t0 - 1) * DM + c0);
#pragma unroll
        for (int r = 0; r < RB; ++r) { vr[r + 2] = *(const u32x4*)(V + (size_t)(t0 + r) * DM + c0); br[r] = *(const u32x4*)(BA + (size_t)(t0 + r) * DM + c0); }
        float w0[8], w1[8], w2[8];
#pragma unroll
        for (int h = 0; h < 2; ++h) { const f32x4 q0 = *(const f32x4*)(cw + c0 + 4 * h), q1 = *(const f32x4*)(cw + DM + c0 + 4 * h), q2 = *(const f32x4*)(cw + 2 * DM + c0 + 4 * h);
#pragma unroll
            for (int i = 0; i < 4; ++i) { w0[4 * h + i] = q0[i]; w1[4 * h + i] = q1[i]; w2[4 * h + i] = q2[i]; } }
        float vm2[8], vm1[8];
        unpack8(vr[0], vm2); unpack8(vr[1], vm1);
#pragma unroll
        for (int r = 0; r < RB; ++r) {
            float v[8], b[8], o[8];
            unpack8(vr[r + 2], v); unpack8(br[r], b);
#pragma unroll
            for (int i = 0; i < 8; ++i) { o[i] = b[i] * (w0[i] * vm2[i] + w1[i] * vm1[i] + w2[i] * v[i]); vm2[i] = vm1[i]; vm1[i] = v[i]; }
            u32x4 w; w.x = pk2(o[0], o[1]); w.y = pk2(o[2], o[3]); w.z = pk2(o[4], o[5]); w.w = pk2(o[6], o[7]);
            *(u32x4*)((JUNK ? (bf16_t*)(a->ws + WS_S5) : BA) + (size_t)(t0 + r) * DM + c0) = w;
        }
    }
}

constexpr int MX_WAVE_BYTES = 12288, MX_UB = 0, MX_SA = 2048, MX_SB = 6144, MX_GT = 10240, MX_WS = 8 * MX_WAVE_BYTES;
template <bool APPLY, bool JUNK = false>
__device__ __forceinline__ void mixer_b(Frame& F, int l) {
    KArgs a = kargs();
    const int lane = F.lane, w = F.wave;
    const bf16_t* XBp = (const bf16_t*)(a->ws + WS_S3); bf16_t* GG = (bf16_t*)(a->ws + WS_S4);
    f32x2* SUM = (f32x2*)(a->ws + WS_SUM); f32x2* SUMG = (f32x2*)(a->ws + WS_SUMG);
    const bf16_t* WaT = (const bf16_t*)(a->ws + WS_LRU); const bf16_t* WxT = WaT + (size_t)NHEAD * HD * HD;
    LAS unsigned char* wl = F.lds + w * MX_WAVE_BYTES;
    LAS float* SA = (LAS float*)(wl + MX_SA); LAS float* SBm = (LAS float*)(wl + MX_SB);
    LAS unsigned short* GT = (LAS unsigned short*)(wl + MX_GT);
    LAS f32x2* WSX = (LAS f32x2*)(F.lds + MX_WS);
    for (int item = F.bx; item < BATCH * NHEAD * 8; item += F.G) {
        const int b = item >> 7, hd = (item >> 3) & 15, g8 = item & 7, span = g8 * 8 + w, chb = hd * HD;
        const int t0 = b * SEQ + span * 128;
        f32x2 pg[7], ps[7];
        if (APPLY) {
#pragma unroll
            for (int j = 0; j < 7; ++j) { pg[j] = (j < g8) ? SUMG[((size_t)(b * 8 + j)) * DM + chb + lane] : (f32x2){1.f, 0.f};
                                          ps[j] = (j < w) ? SUM[((size_t)(b * 64 + g8 * 8 + j)) * DM + chb + lane] : (f32x2){1.f, 0.f}; }
        }
        const int g = lane & 7, tr = lane >> 3, ch0 = chb + 8 * g;
        u32x4 xr[5], gt[2];
#pragma unroll
        for (int k = 0; k < 5; ++k) { const int row = t0 + 2 * tr - 3 + k; xr[k] = (row >= b * SEQ) ? *(const u32x4*)(XBp + (size_t)row * DM + ch0) : (u32x4){0u, 0u, 0u, 0u}; }
        if (APPLY) {
#pragma unroll
            for (int e = 0; e < 2; ++e) gt[e] = *(const u32x4*)(GG + (size_t)(t0 + tr + 8 * e) * DM + ch0);
        }
        float cw[4][8], cb[8];
        { const float* cbw = a->in[I_CBW] + (size_t)l * 4 * DM + ch0; const float* cbb = a->in[I_CBB] + (size_t)l * DM + ch0;
#pragma unroll
          for (int h2 = 0; h2 < 2; ++h2) { const f32x4 bb = *(const f32x4*)(cbb + 4 * h2);
#pragma unroll
              for (int i2 = 0; i2 < 4; ++i2) cb[4 * h2 + i2] = bb[i2];
#pragma unroll
              for (int k = 0; k < 4; ++k) { const f32x4 wk = *(const f32x4*)(cbw + (size_t)k * DM + 4 * h2);
#pragma unroll
                  for (int i2 = 0; i2 < 4; ++i2) cw[k][4 * h2 + i2] = wk[i2]; } } }
        const int cc = lane & 15, kq = lane >> 4;
        bf16x8 bR[4][2], bI[4][2], idf[2];
        float gba[4], gbx[4], gkk[4];
#pragma unroll
        for (int n = 0; n < 4; ++n) { const int e = 16 * n + cc;
#pragma unroll
            for (int s2 = 0; s2 < 2; ++s2) { bR[n][s2] = *(const bf16x8*)(WaT + ((size_t)hd * HD + e) * HD + 32 * s2 + 8 * kq); bI[n][s2] = *(const bf16x8*)(WxT + ((size_t)hd * HD + e) * HD + 32 * s2 + 8 * kq); }
            gba[n] = a->in[I_LBA][(size_t)l * DM + chb + e]; gbx[n] = a->in[I_LBX][(size_t)l * DM + chb + e];
            gkk[n] = -8.0f * log1pf(__expf(-a->in[I_LAM][(size_t)l * DM + chb + e])) * 1.4426950408889634f; }
#pragma unroll
        for (int p2 = 0; p2 < 2; ++p2)
#pragma unroll
            for (int j = 0; j < 8; ++j) idf[p2][j] = (8 * kq + j == 16 * p2 + cc) ? (short)0x3f80 : (short)0;
        float Pw = 1.f, Hw = 0.f;
        if (APPLY) {
#pragma unroll
            for (int j = 0; j < 7; ++j) Hw = pg[j].x * Hw + pg[j].y;
#pragma unroll
            for (int j = 0; j < 7; ++j) Hw = ps[j].x * Hw + ps[j].y;
        }
#pragma unroll 1
        for (int s = 0; s < 8; ++s) {
            const int tb = t0 + 16 * s;
            {
                float u0[8], u1[8];
#pragma unroll
                for (int i2 = 0; i2 < 8; ++i2) { u0[i2] = cb[i2]; u1[i2] = cb[i2]; }
#pragma unroll
                for (int k = 0; k < 5; ++k) { float x[8]; unpack8(xr[k], x);
#pragma unroll
                    for (int i2 = 0; i2 < 8; ++i2) { if (k < 4) u0[i2] += cw[k][i2] * x[i2]; if (k >= 1) u1[i2] += cw[k - 1][i2] * x[i2]; } }
                const int tk0 = 2 * tr, tk1 = 2 * tr + 1;
                u32x4 p0, p1; p0.x = pk2(u0[0], u0[1]); p0.y = pk2(u0[2], u0[3]); p0.z = pk2(u0[4], u0[5]); p0.w = pk2(u0[6], u0[7]);
                p1.x = pk2(u1[0], u1[1]); p1.y = pk2(u1[2], u1[3]); p1.z = pk2(u1[4], u1[5]); p1.w = pk2(u1[6], u1[7]);
                *(LAS u32x4*)(wl + MX_UB + tk0 * 128 + ((g ^ (tk0 & 7)) * 16)) = p0;
                *(LAS u32x4*)(wl + MX_UB + tk1 * 128 + ((g ^ (tk1 & 7)) * 16)) = p1;
                if (APPLY) {
#pragma unroll
                    for (int e = 0; e < 2; ++e) *(LAS u32x4*)(wl + MX_GT + (tr + 8 * e) * 128 + g * 16) = gt[e];
                }
            }
            if (s < 7) {
#pragma unroll
                for (int k = 0; k < 5; ++k) xr[k] = *(const u32x4*)(XBp + (size_t)(tb + 16 + 2 * tr - 3 + k) * DM + ch0);
                if (APPLY) {
#pragma unroll
                    for (int e = 0; e < 2; ++e) gt[e] = *(const u32x4*)(GG + (size_t)(tb + 16 + tr + 8 * e) * DM + ch0);
                }
            }
            LDS_WAIT(); asm volatile("" ::: "memory");
            {
                bf16x8 Af[2];
#pragma unroll
                for (int s2 = 0; s2 < 2; ++s2) Af[s2] = *(const LAS bf16x8*)(wl + MX_UB + cc * 128 + (((4 * s2 + kq) ^ (cc & 7)) * 16));
#pragma unroll
                for (int n = 0; n < 4; ++n) {
                    f32x4 aR = {0.f, 0.f, 0.f, 0.f}, aI = {0.f, 0.f, 0.f, 0.f}, aU = {0.f, 0.f, 0.f, 0.f};
#pragma unroll
                    for (int s2 = 0; s2 < 2; ++s2) { aR = __builtin_amdgcn_mfma_f32_16x16x32_bf16(Af[s2], bR[n][s2], aR, 0, 0, 0); aI = __builtin_amdgcn_mfma_f32_16x16x32_bf16(Af[s2], bI[n][s2], aI, 0, 0, 0); }
                    aU = __builtin_amdgcn_mfma_f32_16x16x32_bf16(Af[n >> 1], idf[n & 1], aU, 0, 0, 0);
#pragma unroll
                    for (int r = 0; r < 4; ++r) {
                        const float rg = fast_sigmoid(aR[r] + gba[n]), ig = fast_sigmoid(aI[r] + gbx[n]);
                        const float av = __builtin_amdgcn_exp2f(rg * gkk[n]);
                        const float bv = __builtin_amdgcn_sqrtf(fmaxf(1.0f - av * av, 0.f)) * (ig * aU[r]);
                        const int tok = 4 * kq + r;
                        SA[tok * 64 + 16 * n + cc] = av; SBm[tok * 64 + 16 * n + cc] = bv;
                    }
                }
            }
            LDS_WAIT(); asm volatile("" ::: "memory");
            if (!APPLY) {
#pragma unroll
                for (int t = 0; t < 16; ++t) { const float av = SA[t * 64 + lane], bv = SBm[t * 64 + lane]; Hw = av * Hw + bv; Pw *= av; }
            } else {
#pragma unroll
                for (int t = 0; t < 16; ++t) { const float av = SA[t * 64 + lane], bv = SBm[t * 64 + lane]; Hw = av * Hw + bv;
                    const float gv = __builtin_bit_cast(float, (unsigned)GT[t * 64 + lane] << 16);
                    GT[t * 64 + lane] = (unsigned short)f2bf(Hw * gv); }
                LDS_WAIT(); asm volatile("" ::: "memory");
#pragma unroll
                for (int e = 0; e < 2; ++e) { const u32x4 o = *(const LAS u32x4*)(wl + MX_GT + (tr + 8 * e) * 128 + g * 16);
                    *(u32x4*)((JUNK ? (bf16_t*)(a->ws + WS_S5) : GG) + (size_t)(tb + tr + 8 * e) * DM + ch0) = o; }
            }
        }
        if (!APPLY) {
            SUM[((size_t)(b * 64 + span)) * DM + chb + lane] = (f32x2){Pw, Hw};
            WSX[w * 64 + lane] = (f32x2){Pw, Hw};
            LDS_WAIT(); __syncthreads();
            if (w == 0) { float Pu = 1.f, Hu = 0.f;
#pragma unroll
                for (int j = 0; j < 8; ++j) { const f32x2 sj = WSX[j * 64 + lane]; Hu = sj.x * Hu + sj.y; Pu *= sj.x; }
                SUMG[((size_t)(b * 8 + g8)) * DM + chb + lane] = (f32x2){Pu, Hu}; }
            LDS_WAIT(); __syncthreads();
        }
    }
}

constexpr int N_PHASES = 8 * DEPTH + 1;
__global__ void __launch_bounds__(NWAVES * 64, 2) fwd_kernel(Args args_unused) {
    extern __shared__ __attribute__((aligned(16))) unsigned char lds[];
    LAS unsigned char* const ldsb = (LAS unsigned char*)lds;
    for (int u = threadIdx.x; u < (LDS_BYTES - LDSCTL_OFF) / 4; u += NWAVES * 64) ((LAS unsigned*)(ldsb + LDSCTL_OFF))[u] = 0u;
    __syncthreads();
    int lo, hi;
    { KArgs a = kargs(); lo = a->ph_lo; hi = a->ph_hi;
      if (hi - lo > 1) (void)xcd_barrier_post((unsigned*)(a->ws + WS_CTL) + CW_BAR, (volatile LAS unsigned*)(ldsb + MISC_OFF) + 8); }
#define IN(k) (lo <= (k) && (k) < hi)
#define SEAM(k) do { if (IN(k) && IN((k) + 1)) { XcdBarrier b_; b_.bar = (unsigned*)(kargs()->ws + WS_CTL) + CW_BAR; b_.x = xb_xcc_id(); b_.st = (volatile LAS unsigned*)(ldsb + MISC_OFF) + 8; xcd_barrier(b_); } } while (0)
    constexpr size_t TS1 = (size_t)256 * DM * 2, TSF = (size_t)256 * DFF * 2;

#pragma unroll 1
    for (int l = 0; l < DEPTH; ++l) {
        const int pb = 8 * l;
        if (IN(pb + 0)) { Frame F = make_frame(ldsb); p0_weights(F, l); if (l == 0) p0_x(F); }
        if (PROBE_REPEAT == 0 && IN(pb + 0)) { Frame F = make_frame(ldsb); p0_weights(F, l); if (l == 0) p0_x(F); }
        SEAM(pb + 0);
        if (IN(pb + 1)) {
            Frame F = make_frame(ldsb); KArgs a = kargs(); unsigned char* ws = a->ws;
            pg8::SchedPlain S; S.so.init(M, N1A, F.G, F.bx); S.A0 = (const char*)(ws + WS_S0); S.B0 = (const char*)(ws + WS_WIN); S.tstep = TS1;
            pg8::EpiP1a E{(const float*)(ws + WS_SSQ), (bf16_t*)(ws + WS_S1), (bf16_t*)(ws + WS_S2), (bf16_t*)(ws + WS_S3), (bf16_t*)(ws + WS_S4)};
            pg8::gemm_phase<pg8::EpiP1a, pg8::SchedPlain, true, true>(F.lds, F.tid, DM, S, E);
        }
        if (PROBE_REPEAT == 1 && IN(pb + 1)) {
            Frame F = make_frame(ldsb); KArgs a = kargs(); unsigned char* ws = a->ws;
            pg8::SchedPlain S; S.so.init(M, N1A, F.G, F.bx); S.A0 = (const char*)(ws + WS_S0); S.B0 = (const char*)(ws + WS_WIN); S.tstep = TS1;
            pg8::EpiP1a E{(const float*)(ws + WS_SSQ), (bf16_t*)(ws + WS_S1), (bf16_t*)(ws + WS_S2), (bf16_t*)(ws + WS_S3), (bf16_t*)(ws + WS_S4)};
            pg8::gemm_phase<pg8::EpiP1a, pg8::SchedPlain, true, true>(F.lds, F.tid, DM, S, E);
        }
        SEAM(pb + 1);
        if (IN(pb + 2)) { { Frame F = make_frame(ldsb); p2_mixer_a(F, l); } { Frame F = make_frame(ldsb); mixer_b<false>(F, l); } }
        if (PROBE_REPEAT == 2 && IN(pb + 2)) { __syncthreads(); Frame F = make_frame(ldsb); mixer_b<false>(F, l); }
        SEAM(pb + 2);
        if (IN(pb + 3)) {
            { Frame F = make_frame(ldsb); mixer_b<true>(F, l); }
            __syncthreads();
            Frame F = make_frame(ldsb); KArgs a = kargs(); unsigned char* ws = a->ws;
            pg8::StaticOrder so; so.init(M, DM, F.G, F.bx);
            int pm_ = 0, pn_ = 0; const bool ok_ = so.next(0, pm_, pn_);
            pg8::SchedGG S; S.valid = ok_; S.pm = pm_; S.pn = pn_; S.ws = (const char*)ws;
            pg8::EpiGG E{(const float*)(ws + WS_SSQ), a->in[I_GB] + (size_t)l * 2 * DM, (bf16_t*)(ws + WS_S2), (bf16_t*)(ws + WS_S5)};
            pg8::gemm_phase<pg8::EpiGG, pg8::SchedGG, true, true>(F.lds, F.tid, DM, S, E);
        }
        SEAM(pb + 3);
        if (IN(pb + 4)) {
            Frame F = make_frame(ldsb); KArgs a = kargs(); unsigned char* ws = a->ws;
            pg8::StaticOrder so; so.init(M, DM, F.G, F.bx);
            int pm_ = 0, pn_ = 0; const bool ok_ = so.next(0, pm_, pn_);
            pg8::SchedOut S; S.valid = ok_; S.pm = pm_; S.pn = pn_; S.ws = (const char*)ws;
            pg8::EpiOut E{(const bf16_t*)(ws + WS_S2), (const bf16_t*)(ws + WS_S5), (bf16_t*)(ws + WS_S3)};
            pg8::gemm_phase<pg8::EpiOut, pg8::SchedOut, false, true>(F.lds, F.tid, DM, S, E);
        }
        SEAM(pb + 4);
        if (IN(pb + 5)) {
            Frame F = make_frame(ldsb); KArgs a = kargs(); unsigned char* ws = a->ws;
            pg8::SchedPlain S; S.so.init(M, DM, F.G, F.bx); S.A0 = (const char*)(ws + WS_S3); S.B0 = (const char*)(ws + WS_WO); S.tstep = TS1;
            pg8::EpiRes E{l == 0 ? a->in[I_X] : a->out, a->out, (bf16_t*)(ws + WS_S0), (float*)(ws + WS_SSQ)};
            pg8::gemm_phase<pg8::EpiRes, pg8::SchedPlain, false, true>(F.lds, F.tid, DM, S, E);
        }
        SEAM(pb + 5);
        if (IN(pb + 6)) {
            Frame F = make_frame(ldsb); KArgs a = kargs(); unsigned char* ws = a->ws;
            pg8::SchedPlain S; S.so.init(M, NGU, F.G, F.bx); S.A0 = (const char*)(ws + WS_S0); S.B0 = (const char*)(ws + WS_WGU); S.tstep = TS1;
            pg8::EpiP6 E{(const float*)(ws + WS_SSQ), (bf16_t*)(ws + WS_S1)};
            pg8::gemm_phase<pg8::EpiP6, pg8::SchedPlain, true, true>(F.lds, F.tid, DM, S, E);
        }
        if (PROBE_REPEAT == 6 && IN(pb + 6)) {
            Frame F = make_frame(ldsb); KArgs a = kargs(); unsigned char* ws = a->ws;
            pg8::SchedPlain S; S.so.init(M, NGU, F.G, F.bx); S.A0 = (const char*)(ws + WS_S0); S.B0 = (const char*)(ws + WS_WGU); S.tstep = TS1;
            pg8::EpiP6 E{(const float*)(ws + WS_SSQ), (bf16_t*)(ws + WS_S1)};
            pg8::gemm_phase<pg8::EpiP6, pg8::SchedPlain, true, true>(F.lds, F.tid, DM, S, E);
        }
        SEAM(pb + 6);
        if (IN(pb + 7)) {
            Frame F = make_frame(ldsb); KArgs a = kargs(); unsigned char* ws = a->ws;
            pg8::SchedPlain S; S.so.init(M, DM, F.G, F.bx); S.A0 = (const char*)(ws + WS_S1); S.B0 = (const char*)(ws + WS_WD); S.tstep = TSF;
            pg8::EpiRes E{a->out, a->out, (bf16_t*)(ws + WS_S0), (float*)(ws + WS_SSQ)};
            pg8::gemm_phase<pg8::EpiRes, pg8::SchedPlain, false, true>(F.lds, F.tid, DFF, S, E);
        }
        SEAM(pb + 7);
    }
    if (IN(8 * DEPTH)) { Frame F = make_frame(ldsb); p8_final(F); }
#undef IN
#undef SEAM
}

extern "C" void kernel_launch(void* const* d_in, const int* in_sizes, int n_in, void* d_out, int out_size, void* d_ws, size_t ws_size, hipStream_t stream) {
    static int grid = 0;
    if (grid == 0) {
        if (n_in != 20 || in_sizes[0] != M * DM || out_size != M * DM || ws_size < WS_END) {
            fprintf(stderr, "kernel_launch: unexpected shapes: n_in %d in0 %d out %d ws %zu (need %zu)\n", n_in, n_in > 0 ? in_sizes[0] : -1, out_size, ws_size, (size_t)WS_END); grid = -1; return; }
        int dev = 0, cus = 0, per_cu = 0;
        if (hipGetDevice(&dev) != hipSuccess || hipDeviceGetAttribute(&cus, hipDeviceAttributeMultiprocessorCount, dev) != hipSuccess) { grid = -1; return; }
        if (hipFuncSetAttribute((const void*)fwd_kernel, hipFuncAttributeMaxDynamicSharedMemorySize, LDS_BYTES) != hipSuccess) { fprintf(stderr, "kernel_launch: hipFuncSetAttribute failed\n"); grid = -1; return; }
        if (hipOccupancyMaxActiveBlocksPerMultiprocessor(&per_cu, (const void*)fwd_kernel, NWAVES * 64, LDS_BYTES) != hipSuccess || per_cu < 1)
            fprintf(stderr, "kernel_launch: occupancy query reports %d workgroups per CU\n", per_cu);
        (void)hipGetLastError();
        grid = cus;
        if (grid != 256) fprintf(stderr, "kernel_launch: %d CUs (built for 256)\n", grid);
    }
    if (grid < 0) return;
    (void)hipMemsetAsync((char*)d_ws + WS_CTL, 0, CTL_ZERO_BYTES, stream);
    Args a{};
    for (int i = 0; i < 20; ++i) a.in[i] = (const float*)d_in[i];
    a.out = (float*)d_out; a.ws = (unsigned char*)d_ws;
#if MK_PER_PHASE
    for (int p = 0; p < N_PHASES; ++p) { a.ph_lo = p; a.ph_hi = p + 1; hipLaunchKernelGGL(fwd_kernel, dim3(grid), dim3(NWAVES * 64), LDS_BYTES, stream, a); }
#else
    a.ph_lo = 0; a.ph_hi = N_PHASES;
    hipLaunchKernelGGL(fwd_kernel, dim3(grid), dim3(NWAVES * 64), LDS_BYTES, stream, a);
#endif
}
```

```cpp
#include <hip/hip_runtime.h>
#include <cstdio>
#include <cstdint>

#ifndef PROBE_REPEAT
#define PROBE_REPEAT -1
#endif
#ifndef MK_PER_PHASE
#define MK_PER_PHASE 0
#endif

#define LAS __attribute__((address_space(3)))
#define GAS __attribute__((address_space(1)))
typedef unsigned short bf16_t;
typedef short bf16x8 __attribute__((ext_vector_type(8)));
typedef float f32x4 __attribute__((ext_vector_type(4)));
typedef float f32x2 __attribute__((ext_vector_type(2)));
typedef unsigned u32x4 __attribute__((ext_vector_type(4)));
typedef unsigned u32x2 __attribute__((ext_vector_type(2)));
typedef GAS unsigned gu32;

constexpr int BATCH = 2, SEQ = 8192, DM = 1024, M = BATCH * SEQ, NIN = 7168, DFF = 2816, NGU = 2 * DFF, NHEAD = 16, HD = 64, DEPTH = 2;
constexpr float RMS_EPS = 1e-6f;
constexpr int NWAVES = 8;
constexpr int N1A = 5120;
constexpr int ROW_GG = 5120;

constexpr size_t MiB = 1u << 20;
constexpr size_t WS_CTL = 0, CTL_ZERO_BYTES = 1 * MiB;
constexpr size_t WS_SSQ = 1 * MiB;
constexpr size_t WS_SUM = 2 * MiB;
constexpr size_t WS_LRU = 3 * MiB;
constexpr size_t WS_SUMG = 3 * MiB + 512 * 1024;
constexpr size_t WS_WIN = 4 * MiB, WS_WOA = 18 * MiB, WS_WOB = 20 * MiB, WS_WO = 22 * MiB, WS_WGU = 24 * MiB, WS_WD = 35 * MiB;
constexpr size_t WS_S0 = 48 * MiB, SLOT = 32 * MiB;
constexpr size_t WS_S1 = WS_S0 + SLOT, WS_S2 = WS_S1 + SLOT, WS_S3 = WS_S2 + SLOT, WS_S4 = WS_S3 + SLOT, WS_S5 = WS_S4 + SLOT, WS_END = WS_S5 + SLOT;
static_assert(WS_WD + (size_t)DM * DFF * 2 <= WS_S0 && WS_END <= 256 * MiB, "d_ws map");
constexpr int CW_BAR = 4096;

constexpr int RING_BYTES = 131072;
constexpr int LDSCTL_OFF = RING_BYTES, MISC_OFF = LDSCTL_OFF + 320;
constexpr int LDS_BYTES = 147456;

#define RLX_AGENT __ATOMIC_RELAXED, __HIP_MEMORY_SCOPE_AGENT
#define LDS_WAIT() asm volatile("s_waitcnt lgkmcnt(0)" ::: "memory")
#define VM_WAIT() asm volatile("s_waitcnt vmcnt(0)" ::: "memory")
__device__ __forceinline__ unsigned f2bf(float f) { unsigned u = __builtin_bit_cast(unsigned, f); return (u + 0x7fffu + ((u >> 16) & 1u)) >> 16; }
__device__ __forceinline__ unsigned pk2(float lo, float hi) { return f2bf(lo) | (f2bf(hi) << 16); }
__device__ __forceinline__ unsigned cvt_pk_bf16(float lo, float hi) { unsigned r; asm volatile("v_cvt_pk_bf16_f32 %0, %1, %2" : "=v"(r) : "v"(lo), "v"(hi)); return r; }
__device__ __forceinline__ float bflo(unsigned w) { return __builtin_bit_cast(float, w << 16); }
__device__ __forceinline__ float bfhi(unsigned w) { return __builtin_bit_cast(float, w & 0xffff0000u); }
__device__ __forceinline__ float fast_exp(float x) { return __builtin_amdgcn_exp2f(x * 1.4426950408889634f); }
__device__ __forceinline__ float fast_sigmoid(float x) { return __builtin_amdgcn_rcpf(1.0f + fast_exp(-x)); }
__device__ __forceinline__ float gelu_tanh(float x) {
    const float z = 1.5957691216057308f * (x + 0.044715f * x * x * x);
    return x * __builtin_amdgcn_rcpf(1.0f + fast_exp(-z));
}
__device__ __forceinline__ float rstd_of(const float* ssq, int row) {
    const f32x4 s = *(const f32x4*)(ssq + (size_t)row * 4);
    return __builtin_amdgcn_rsqf(((s.x + s.y) + (s.z + s.w)) * (1.0f / DM) + RMS_EPS);
}

#define XB_TMO      128
#define XB_XCNT(j)  (256  + 64 * (j))
#define XB_XSUB(j)  (1280 + 64 * (j))
#define XB_XGEN(j)  (2304 + 64 * (j))
#define XB_TOP      3328
#define XB_TOPGEN   3392
#define XCD_BAR_WORDS 3456
#define XB_SPIN_CAP (1u << 22)
__device__ __forceinline__ unsigned xb_ld(unsigned* p)              { return __hip_atomic_load(p, __ATOMIC_RELAXED, __HIP_MEMORY_SCOPE_AGENT); }
__device__ __forceinline__ unsigned xb_add(unsigned* p, unsigned v) { return __hip_atomic_fetch_add(p, v, __ATOMIC_RELAXED, __HIP_MEMORY_SCOPE_AGENT); }
__device__ __forceinline__ unsigned xb_xcc_id() { return (unsigned)__builtin_amdgcn_s_getreg((3 << 11) | 20) & 0xFu; }
#define XB_SPIN(cond, bar) do { unsigned _sp = 0; while (cond) { __builtin_amdgcn_s_sleep(1); \
    if ((++_sp & 255u) == 0u) { if (xb_ld(&(bar)[XB_TMO])) break; if (_sp > XB_SPIN_CAP) { atomicAdd(&(bar)[XB_TMO], 1u); break; } } } } while (0)
struct XcdBarrier { unsigned* bar; unsigned x; volatile LAS unsigned* st; };
__device__ __forceinline__ XcdBarrier xcd_barrier_post(unsigned* bar, volatile LAS unsigned* st) {
    XcdBarrier b; b.bar = bar; b.x = xb_xcc_id(); b.st = st;
    if (threadIdx.x == 0) (void)xb_add(&bar[XB_XCNT(b.x)], 1u);
    return b;
}
__device__ __forceinline__ void xcd_barrier_complete(unsigned* bar, unsigned x, unsigned& nloc, unsigned& nx) {
    const unsigned G = gridDim.x * gridDim.y * gridDim.z;
    unsigned sum, cnt, mine, sp = 0u;
    for (;;) {
        sum = 0u; cnt = 0u; mine = 0u;
#pragma unroll
        for (unsigned j = 0; j < 16; ++j) { const unsigned c = xb_ld(&bar[XB_XCNT(j)]); sum += c; cnt += (c > 0u) ? 1u : 0u; mine = (j == x) ? c : mine; }
        if (sum == G) break;
        __builtin_amdgcn_s_sleep(1);
        if ((++sp & 255u) == 0u) { if (xb_ld(&bar[XB_TMO])) break; if (sp > XB_SPIN_CAP) { atomicAdd(&bar[XB_TMO], 1u); break; } }
    }
    nloc = mine > 0u ? mine : 1u; nx = cnt > 0u ? cnt : 1u;
}
__device__ __forceinline__ void xcd_barrier(const XcdBarrier& b) {
    asm volatile("s_waitcnt vmcnt(0)" ::: "memory");
    __syncthreads();
    if (threadIdx.x == 0) {
        unsigned* bar = b.bar;
        __builtin_amdgcn_s_waitcnt(0);
        unsigned nloc = b.st[0], nx = b.st[1];
        if (nloc == 0u) { xcd_barrier_complete(bar, b.x, nloc, nx); b.st[0] = nloc; b.st[1] = nx; }
        const unsigned old = xb_add(&bar[XB_XSUB(b.x)], 1u);
        const unsigned gen = old / nloc;
        if (old + 1u == (gen + 1u) * nloc) {
            __builtin_amdgcn_fence(__ATOMIC_RELEASE, "agent");
            asm volatile("s_waitcnt vmcnt(0)" ::: "memory");
            const unsigned og = xb_add(&bar[XB_TOP], 1u);
            const unsigned tg = og / nx;
            if (og + 1u == (tg + 1u) * nx) xb_add(&bar[XB_TOPGEN], 1u);
            else XB_SPIN(xb_ld(&bar[XB_TOPGEN]) == tg, bar);
            __builtin_amdgcn_fence(__ATOMIC_ACQUIRE, "agent");
            xb_add(&bar[XB_XGEN(b.x)], 1u);
            asm volatile("s_waitcnt vmcnt(0)" ::: "memory");
        } else {
            XB_SPIN(xb_ld(&bar[XB_XGEN(b.x)]) == gen, bar);
            __builtin_amdgcn_fence(__ATOMIC_ACQUIRE, "agent");
            asm volatile("s_waitcnt vmcnt(0)" ::: "memory");
        }
    }
    __syncthreads();
}

namespace pg8 {
constexpr int BM = 256, BK = 64, HALF = 128, HTB = HALF * BK * 2, NXCD = 8, WGM = 8;
__host__ __device__ __forceinline__ int lds_byte(int r, int c) { const int st = (r >> 4) * 2 + (c >> 5), rr = r & 15, cc = c & 31, ob = rr * 64 + cc * 2; return st * 1024 + (ob ^ (((ob >> 9) & 1) << 5)); }
__host__ __device__ __forceinline__ void stage_rc(int b, int& R, int& C) { const int st = b / 1024, sb = b % 1024, swz = sb ^ (((sb >> 9) & 1) << 5); R = (st >> 1) * 16 + swz / 64; C = (st & 1) * 32 + (swz % 64) / 2; }
__host__ __device__ __forceinline__ int perm32(int rho) { const int n = rho >> 4, i = rho & 15; return 8 * (i >> 2) + 4 * n + (i & 3); }

struct Unit { int pm, pn, kind; };

struct StaticOrder {
    int nM, nN, nwg, G, c;
    __device__ __forceinline__ void init(int M_, int N_, int G_, int c_) { nM = M_ / BM; nN = N_ / BM; nwg = nM * nN; G = G_; c = c_; }
    __device__ __forceinline__ bool next(int i, int& pm, int& pn) const {
        const long L = (long)i * G + c; if (L >= nwg) return false;
        int wgid = (int)L; { const int q = nwg / NXCD, r = nwg % NXCD, xcd = wgid % NXCD, off = wgid / NXCD; wgid = (xcd < r ? xcd * (q + 1) : r * (q + 1) + (xcd - r) * q) + off; }
        const int nig = WGM * nN, gid = wgid / nig, fm = gid * WGM, gsz = (nM - fm) < WGM ? (nM - fm) : WGM;
        pm = fm + ((wgid % nig) % gsz); pn = (wgid % nig) / gsz; return true;
    }
};
struct SchedPlain {
    StaticOrder so; const char* A0; const char* B0; size_t tstep;
    __device__ __forceinline__ bool next(int i, Unit& u) const { int pm_ = 0, pn_ = 0; const bool ok_ = so.next(i, pm_, pn_); u.pm = pm_; u.pn = pn_; u.kind = 0; return ok_; }
    __device__ __forceinline__ const char* a_ptr(const Unit& u) const { return A0 + (size_t)u.pm * tstep; }
    __device__ __forceinline__ const char* b_ptr(const Unit& u) const { return B0 + (size_t)u.pn * tstep; }
};
struct SchedGG {
    int pm, pn; bool valid; const char* ws;
    static constexpr size_t TS = (size_t)256 * DM * 2;
    __device__ __forceinline__ bool next(int i, Unit& u) const { if (!valid || i >= 2) return false; u.pm = pm; u.kind = 0; u.pn = 2 * pn + i; return true; }
    __device__ __forceinline__ const char* a_ptr(const Unit& u) const { return ws + WS_S0 + (size_t)u.pm * TS; }
    __device__ __forceinline__ const char* b_ptr(const Unit& u) const { return ws + WS_WIN + (size_t)ROW_GG * DM * 2 + (size_t)u.pn * TS; }
};
struct SchedOut {
    int pm, pn; bool valid; const char* ws;
    static constexpr size_t TS = (size_t)256 * DM * 2;
    __device__ __forceinline__ bool next(int i, Unit& u) const { if (!valid || i >= 2) return false; u.pm = pm; u.kind = i + 1; u.pn = pn; return true; }
    __device__ __forceinline__ const char* a_ptr(const Unit& u) const { return ws + WS_S1 + (size_t)(u.kind == 2) * (WS_S4 - WS_S1) + (size_t)u.pm * TS; }
    __device__ __forceinline__ const char* b_ptr(const Unit& u) const { return ws + WS_WOA + (size_t)(u.kind == 2) * (WS_WOB - WS_WOA) + (size_t)u.pn * TS; }
};

template <class Epi, class Sched, bool ALIGN_EPI, bool SP2>
__device__ __forceinline__ void gemm_phase(LAS unsigned char* lds, const int tid, const int K, const Sched& S, const Epi& E) {
    const int wid = __builtin_amdgcn_readfirstlane(tid >> 6), lane = tid & 63, wr = wid >> 2, wc = wid & 3, fr = lane & 15, fq = lane >> 4;
    const int nt = K / BK;
    unsigned voffA[2], voffB[2];
#pragma unroll
    for (int i = 0; i < 2; ++i) { int R, C; stage_rc(tid * 16 + i * 8192, R, C); const int Rb = Epi::PERM ? ((R & ~31) + perm32(R & 31)) : R;
        voffA[i] = (unsigned)(R * K + C) * 2u; voffB[i] = (unsigned)(Rb * K + C) * 2u; }
    const size_t kstep = (size_t)(BK * 2);
    const size_t hstep = (size_t)HALF * K * 2;
    const unsigned ldsw = (unsigned)wid * 1024u;
    const int aoff = lds_byte(wr * 64 + fr, fq * 8), boff = lds_byte(wc * 32 + fr, fq * 8);
#define PG8_SA(b, h) (((b) * 2 + (h)) * HTB)
#define PG8_SB(b, h) ((4 + (b) * 2 + (h)) * HTB)
#define PG8_STAGE(bufoff, gbase, voff) do { _Pragma("unroll") for (int _i = 0; _i < 2; ++_i) \
        __builtin_amdgcn_global_load_lds((const unsigned*)((const char*)(gbase) + (voff)[_i]), (LAS unsigned*)(lds + (bufoff) + ldsw + _i * 8192), 16, 0, 0); } while (0)
#define PG8_LDA(dst, b, h) do { _Pragma("unroll") for (int m = 0; m < 4; ++m) _Pragma("unroll") for (int k = 0; k < 2; ++k) dst[m][k] = *(const LAS bf16x8*)(lds + PG8_SA(b, h) + aoff + m * 2048 + k * 1024); } while (0)
#define PG8_LDB(dst, b, h) do { _Pragma("unroll") for (int n = 0; n < 2; ++n) _Pragma("unroll") for (int k = 0; k < 2; ++k) dst[n][k] = *(const LAS bf16x8*)(lds + PG8_SB(b, h) + boff + n * 2048 + k * 1024); } while (0)
#define PG8_MMA(ai, bj, At, Bt) do { __builtin_amdgcn_s_setprio(1); _Pragma("unroll") for (int m = 0; m < 4; ++m) _Pragma("unroll") for (int n = 0; n < 2; ++n) _Pragma("unroll") for (int k = 0; k < 2; ++k) \
        acc[ai][bj][m][n] = __builtin_amdgcn_mfma_f32_16x16x32_bf16(Bt[n][k], At[m][k], acc[ai][bj][m][n], 0, 0, 0); __builtin_amdgcn_s_setprio(0); } while (0)
#define PG8_WAIT_V(n) asm volatile("s_waitcnt vmcnt(" #n ")" ::: "memory")
#define PG8_WAIT_L(n) asm volatile("s_waitcnt lgkmcnt(" #n ")" ::: "memory")
#define PG8_BAR __builtin_amdgcn_s_barrier()
#define PG8_SCHED __builtin_amdgcn_sched_barrier(0)
    Unit cur, nxt; int ui = 0;
    if (!S.next(0, cur)) return;
    f32x4 acc[2][2][4][2];
#pragma unroll
    for (int a = 0; a < 2; ++a)
#pragma unroll
        for (int b = 0; b < 2; ++b)
#pragma unroll
            for (int m = 0; m < 4; ++m)
#pragma unroll
                for (int n = 0; n < 2; ++n) acc[a][b][m][n] = (f32x4){0.f, 0.f, 0.f, 0.f};
    bf16x8 At[4][2], B0[2][2], B1[2][2];
    const char* cA = S.a_ptr(cur); const char* cB = S.b_ptr(cur);
    if constexpr (SP2) {
        PG8_STAGE(PG8_SB(0, 0), cB, voffB); PG8_STAGE(PG8_SB(0, 1), cB + hstep, voffB); PG8_STAGE(PG8_SA(0, 0), cA, voffA); PG8_STAGE(PG8_SA(0, 1), cA + hstep, voffA);
        if (wr == 1) PG8_BAR;
        PG8_WAIT_V(2); PG8_BAR;
        PG8_STAGE(PG8_SB(1, 0), cB + kstep, voffB); PG8_STAGE(PG8_SA(1, 0), cA + kstep, voffA); PG8_STAGE(PG8_SB(1, 1), cB + hstep + kstep, voffB);
        PG8_WAIT_V(6); PG8_BAR;
    } else {
        PG8_STAGE(PG8_SB(0, 0), cB, voffB); PG8_STAGE(PG8_SA(0, 0), cA, voffA); PG8_STAGE(PG8_SB(0, 1), cB + hstep, voffB); PG8_STAGE(PG8_SA(0, 1), cA + hstep, voffA);
        if (wr == 1) PG8_BAR;
        PG8_WAIT_V(4); PG8_BAR;
        PG8_STAGE(PG8_SB(1, 0), cB + kstep, voffB); PG8_STAGE(PG8_SA(1, 0), cA + kstep, voffA); PG8_STAGE(PG8_SB(1, 1), cB + hstep + kstep, voffB);
        PG8_WAIT_V(6); PG8_BAR;
    }
    for (;;) {
        const bool has_next = S.next(ui + 1, nxt);
        const char* nA = has_next ? S.a_ptr(nxt) : cA; const char* nB = has_next ? S.b_ptr(nxt) : cB;
        for (int t = 0; t < nt; t += 2) {
            const bool last = (t == nt - 2);
            const char* a1 = cA + (size_t)(t + 1) * kstep;
            const char* a2 = last ? nA : cA + (size_t)(t + 2) * kstep; const char* b2 = last ? nB : cB + (size_t)(t + 2) * kstep;
            const char* a3 = a2 + kstep; const char* b3 = b2 + kstep;
            if constexpr (SP2) {
            PG8_LDB(B0, 0, 0); PG8_LDB(B1, 0, 1); PG8_SCHED; PG8_LDA(At, 0, 0); PG8_STAGE(PG8_SA(1, 1), a1 + hstep, voffA);
            PG8_WAIT_V(8); PG8_WAIT_L(0); PG8_BAR; PG8_MMA(0, 0, At, B0); PG8_MMA(0, 1, At, B1); PG8_BAR; PG8_SCHED;
            PG8_LDA(At, 0, 1); PG8_STAGE(PG8_SB(0, 0), b2, voffB); PG8_STAGE(PG8_SB(0, 1), b2 + hstep, voffB); PG8_STAGE(PG8_SA(0, 0), a2, voffA);
            PG8_WAIT_V(8); PG8_WAIT_L(0); PG8_BAR; PG8_MMA(1, 0, At, B0); PG8_MMA(1, 1, At, B1); PG8_BAR; PG8_SCHED;
            PG8_LDB(B0, 1, 0); PG8_LDB(B1, 1, 1); PG8_SCHED; PG8_LDA(At, 1, 0); PG8_STAGE(PG8_SA(0, 1), a2 + hstep, voffA);
            PG8_WAIT_V(8); PG8_WAIT_L(0); PG8_BAR; PG8_MMA(0, 0, At, B0); PG8_MMA(0, 1, At, B1); PG8_BAR; PG8_SCHED;
            PG8_LDA(At, 1, 1); PG8_STAGE(PG8_SB(1, 0), b3, voffB); PG8_STAGE(PG8_SB(1, 1), b3 + hstep, voffB); PG8_STAGE(PG8_SA(1, 0), a3, voffA);
            PG8_WAIT_V(8); PG8_WAIT_L(0); PG8_BAR; PG8_MMA(1, 0, At, B0); PG8_MMA(1, 1, At, B1); PG8_BAR; PG8_SCHED;
            } else {
            PG8_LDB(B0, 0, 0); PG8_SCHED; PG8_LDA(At, 0, 0); PG8_STAGE(PG8_SA(1, 1), a1 + hstep, voffA);
            PG8_WAIT_L(8); PG8_BAR; PG8_WAIT_L(0); PG8_MMA(0, 0, At, B0); PG8_BAR; PG8_SCHED;
            PG8_LDB(B1, 0, 1); PG8_STAGE(PG8_SB(0, 0), b2, voffB);
            PG8_BAR; PG8_WAIT_L(0); PG8_MMA(0, 1, At, B1); PG8_BAR;
            PG8_LDA(At, 0, 1); PG8_STAGE(PG8_SA(0, 0), a2, voffA);
            PG8_BAR; PG8_WAIT_L(0); PG8_MMA(1, 0, At, B0); PG8_BAR; PG8_SCHED;
            PG8_STAGE(PG8_SB(0, 1), b2 + hstep, voffB);
            PG8_WAIT_V(6); PG8_BAR; PG8_MMA(1, 1, At, B1); PG8_BAR;
            PG8_LDB(B0, 1, 0); PG8_SCHED; PG8_LDA(At, 1, 0); PG8_STAGE(PG8_SA(0, 1), a2 + hstep, voffA);
            PG8_WAIT_L(8); PG8_BAR; PG8_WAIT_L(0); PG8_MMA(0, 0, At, B0); PG8_BAR; PG8_SCHED;
            PG8_LDB(B1, 1, 1); PG8_STAGE(PG8_SB(1, 0), b3, voffB);
            PG8_BAR; PG8_WAIT_L(0); PG8_MMA(0, 1, At, B1); PG8_BAR;
            PG8_LDA(At, 1, 1); PG8_STAGE(PG8_SA(1, 0), a3, voffA);
            PG8_BAR; PG8_WAIT_L(0); PG8_MMA(1, 0, At, B0); PG8_BAR; PG8_SCHED;
            PG8_STAGE(PG8_SB(1, 1), b3 + hstep, voffB);
            PG8_WAIT_V(6); PG8_BAR; PG8_MMA(1, 1, At, B1); PG8_BAR;
            }
        }
        if constexpr (ALIGN_EPI) { if (wr == 0) PG8_BAR; }
        if constexpr (!Epi::AFTER_DRAIN) { E(acc, cur, wr, wc, fr, fq); }
        if (!has_next) break;
        if constexpr (Epi::KEEPS) {
            E.rescale(acc, cur, wr, wc, fr, fq);
        } else {
#pragma unroll
            for (int a = 0; a < 2; ++a)
#pragma unroll
                for (int b = 0; b < 2; ++b)
#pragma unroll
                    for (int m = 0; m < 4; ++m)
#pragma unroll
                        for (int n = 0; n < 2; ++n) acc[a][b][m][n] = (f32x4){0.f, 0.f, 0.f, 0.f};
        }
        cur = nxt; cA = nA; cB = nB; ++ui;
        if constexpr (ALIGN_EPI) { if (wr == 1) PG8_BAR; }
    }
    PG8_WAIT_V(0);
    if constexpr (!ALIGN_EPI) { if (wr == 0) PG8_BAR; }
    PG8_BAR;
    if constexpr (Epi::AFTER_DRAIN) { E.fused(acc, cur, wr, wc, fr, fq, lds, wid, lane); }
#undef PG8_SA
#undef PG8_SB
#undef PG8_STAGE
#undef PG8_LDA
#undef PG8_LDB
#undef PG8_MMA
#undef PG8_WAIT_V
#undef PG8_WAIT_L
#undef PG8_BAR
#undef PG8_SCHED
}

__device__ __forceinline__ void rstd8(const float* ssq, int row0, float (&rs)[2][4]) {
    f32x4 q[2][4];
#pragma unroll
    for (int ai = 0; ai < 2; ++ai)
#pragma unroll
        for (int m = 0; m < 4; ++m) q[ai][m] = *(const f32x4*)(ssq + (size_t)(row0 + ai * HALF + m * 16) * 4);
#pragma unroll
    for (int ai = 0; ai < 2; ++ai)
#pragma unroll
        for (int m = 0; m < 4; ++m) rs[ai][m] = __builtin_amdgcn_rsqf(((q[ai][m].x + q[ai][m].y) + (q[ai][m].z + q[ai][m].w)) * (1.0f / DM) + RMS_EPS);
}
__device__ __forceinline__ u32x4 pack8(const f32x4 a, const f32x4 b) { u32x4 w; w.x = cvt_pk_bf16(a[0], a[1]); w.y = cvt_pk_bf16(a[2], a[3]); w.z = cvt_pk_bf16(b[0], b[1]); w.w = cvt_pk_bf16(b[2], b[3]); return w; }

struct EpiP1a {
    static constexpr bool PERM = true, AFTER_DRAIN = false, KEEPS = false;
    const float* ssq; bf16_t *BA, *V, *XBp, *GG;
    __device__ __forceinline__ bool keep(const Unit&) const { return false; }
    __device__ __forceinline__ void operator()(f32x4 (&acc)[2][2][4][2], const Unit& u, int wr, int wc, int fr, int fq) const {
        int row0 = u.pm * BM + wr * 64 + fr; asm volatile("" : "+v"(row0));
        const int pn = u.pn;
        float rs[2][4]; rstd8(ssq, row0, rs);
        if (pn >= 4 && pn < 12) {
            const int col = (pn - 4) * 128 + wc * 32 + 8 * fq;
#pragma unroll
            for (int ai = 0; ai < 2; ++ai)
#pragma unroll
                for (int m = 0; m < 4; ++m) { const int row = row0 + ai * HALF + m * 16; const float r = rs[ai][m], r2 = r * r;
                    const f32x4 v0 = acc[ai][0][m][0] * acc[ai][1][m][0] * r2, v1 = acc[ai][0][m][1] * acc[ai][1][m][1] * r2;
                    *(u32x4*)(V + (size_t)row * DM + col) = pack8(v0, v1); }
        } else {
            bf16_t* O; int colt; bool act = false;
            if (pn < 4) { O = BA; colt = pn * 256; } else if (pn < 16) { O = XBp; colt = (pn - 12) * 256; } else { O = GG; colt = (pn - 16) * 256; act = true; }
            const int col = colt + wc * 32 + 8 * fq;
#pragma unroll
            for (int ai = 0; ai < 2; ++ai)
#pragma unroll
                for (int m = 0; m < 4; ++m) { const int row = row0 + ai * HALF + m * 16; const float r = rs[ai][m];
#pragma unroll
                    for (int bj = 0; bj < 2; ++bj) { f32x4 v0 = acc[ai][bj][m][0] * r, v1 = acc[ai][bj][m][1] * r;
                        if (act) {
#pragma unroll
                            for (int i = 0; i < 4; ++i) { v0[i] = gelu_tanh(v0[i]); v1[i] = gelu_tanh(v1[i]); } }
                        *(u32x4*)(O + (size_t)row * DM + col + bj * HALF) = pack8(v0, v1); } }
        }
    }
};
struct EpiGG {
    static constexpr bool PERM = true, AFTER_DRAIN = false, KEEPS = false;
    const float* ssq; const float* gbias;
    bf16_t *RA, *SB;
    __device__ __forceinline__ bool keep(const Unit&) const { return false; }
    __device__ __forceinline__ void operator()(f32x4 (&acc)[2][2][4][2], const Unit& u, int wr, int wc, int fr, int fq) const {
        int row0 = u.pm * BM + wr * 64 + fr; asm volatile("" : "+v"(row0));
        {
            const int col = u.pn * 128 + wc * 32 + 8 * fq;
#pragma unroll
            for (int ai = 0; ai < 2; ++ai) {
                float rs4[4];
                { f32x4 q[4];
#pragma unroll
                  for (int m = 0; m < 4; ++m) q[m] = *(const f32x4*)(ssq + (size_t)(row0 + ai * HALF + m * 16) * 4);
#pragma unroll
                  for (int m = 0; m < 4; ++m) rs4[m] = __builtin_amdgcn_rsqf(((q[m].x + q[m].y) + (q[m].z + q[m].w)) * (1.0f / DM) + RMS_EPS); }
#pragma unroll
                for (int m = 0; m < 4; ++m) { const int row = row0 + ai * HALF + m * 16; const float r = rs4[m];
                    unsigned wra[4], wsb[4];
#pragma unroll
                    for (int n = 0; n < 2; ++n) {
                        const f32x4 ba = *(const f32x4*)(gbias + col + 4 * n), bb = *(const f32x4*)(gbias + DM + col + 4 * n);
                        float ra[4], sb[4];
#pragma unroll
                        for (int i = 0; i < 4; ++i) {
                            float p = acc[ai][0][m][n][i] * r + ba[i], q = acc[ai][1][m][n][i] * r + bb[i];
                            p = fminf(fmaxf(p, -30.f), 30.f); q = fminf(fmaxf(q, -30.f), 30.f);
                            const float ep = 1.0f + fast_exp(-p), eq = 1.0f + fast_exp(-q);
                            ra[i] = eq * __builtin_amdgcn_rcpf(ep); sb[i] = __builtin_amdgcn_rcpf(eq); }
                        wra[2 * n] = cvt_pk_bf16(ra[0], ra[1]); wra[2 * n + 1] = cvt_pk_bf16(ra[2], ra[3]);
                        wsb[2 * n] = cvt_pk_bf16(sb[0], sb[1]); wsb[2 * n + 1] = cvt_pk_bf16(sb[2], sb[3]); }
                    *(u32x4*)(RA + (size_t)row * DM + col) = (u32x4){wra[0], wra[1], wra[2], wra[3]};
                    *(u32x4*)(SB + (size_t)row * DM + col) = (u32x4){wsb[0], wsb[1], wsb[2], wsb[3]}; }
                asm volatile("" ::: "memory"); }
        }
    }
};
struct EpiOut {
    static constexpr bool PERM = true, AFTER_DRAIN = false, KEEPS = true;
    const bf16_t *RA, *SB; bf16_t* MG;
    __device__ __forceinline__ bool keep(const Unit& u) const { return u.kind == 1; }
    __device__ __forceinline__ void operator()(f32x4 (&acc)[2][2][4][2], const Unit& u, int wr, int wc, int fr, int fq) const {
        int row0 = u.pm * BM + wr * 64 + fr; asm volatile("" : "+v"(row0));
        if (u.kind == 2) {
            const int col = u.pn * 256 + wc * 32 + 8 * fq;
#pragma unroll
            for (int ai = 0; ai < 2; ++ai)
#pragma unroll
                for (int mh = 0; mh < 2; ++mh) {
                    u32x4 g[2][2];
#pragma unroll
                    for (int m2 = 0; m2 < 2; ++m2)
#pragma unroll
                        for (int bj = 0; bj < 2; ++bj) g[m2][bj] = *(const u32x4*)(SB + (size_t)(row0 + ai * HALF + (2 * mh + m2) * 16) * DM + col + bj * HALF);
#pragma unroll
                    for (int m2 = 0; m2 < 2; ++m2) { const int m = 2 * mh + m2, row = row0 + ai * HALF + m * 16;
#pragma unroll
                        for (int bj = 0; bj < 2; ++bj) { const u32x4 gg = g[m2][bj];
                            const f32x4 g0 = {bflo(gg.x), bfhi(gg.x), bflo(gg.y), bfhi(gg.y)}, g1 = {bflo(gg.z), bfhi(gg.z), bflo(gg.w), bfhi(gg.w)};
                            *(u32x4*)(MG + (size_t)row * DM + col + bj * HALF) = pack8(acc[ai][bj][m][0] * g0, acc[ai][bj][m][1] * g1); } }
                    asm volatile("" ::: "memory"); }
        }
    }
    __device__ __forceinline__ void rescale(f32x4 (&acc)[2][2][4][2], const Unit& u, int wr, int wc, int fr, int fq) const {
        int row0 = u.pm * BM + wr * 64 + fr; asm volatile("" : "+v"(row0)); const int col = u.pn * 256 + wc * 32 + 8 * fq;
#pragma unroll
        for (int ai = 0; ai < 2; ++ai)
#pragma unroll
            for (int mh = 0; mh < 2; ++mh) {
                u32x4 g[2][2];
#pragma unroll
                for (int m2 = 0; m2 < 2; ++m2)
#pragma unroll
                    for (int bj = 0; bj < 2; ++bj) g[m2][bj] = *(const u32x4*)(RA + (size_t)(row0 + ai * HALF + (2 * mh + m2) * 16) * DM + col + bj * HALF);
#pragma unroll
                for (int m2 = 0; m2 < 2; ++m2) { const int m = 2 * mh + m2;
#pragma unroll
                    for (int bj = 0; bj < 2; ++bj) { const u32x4 gg = g[m2][bj];
                        const f32x4 g0 = {bflo(gg.x), bfhi(gg.x), bflo(gg.y), bfhi(gg.y)}, g1 = {bflo(gg.z), bfhi(gg.z), bflo(gg.w), bfhi(gg.w)};
                        acc[ai][bj][m][0] = acc[ai][bj][m][0] * g0; acc[ai][bj][m][1] = acc[ai][bj][m][1] * g1; } }
                asm volatile("" ::: "memory"); }
    }
};
struct EpiP6 {
    static constexpr bool PERM = true, AFTER_DRAIN = false, KEEPS = false;
    const float* ssq; bf16_t* H;
    __device__ __forceinline__ bool keep(const Unit&) const { return false; }
    __device__ __forceinline__ void operator()(f32x4 (&acc)[2][2][4][2], const Unit& u, int wr, int wc, int fr, int fq) const {
        int row0 = u.pm * BM + wr * 64 + fr; asm volatile("" : "+v"(row0)); const int col = u.pn * 128 + wc * 32 + 8 * fq;
        float rs[2][4]; rstd8(ssq, row0, rs);
#pragma unroll
        for (int ai = 0; ai < 2; ++ai)
#pragma unroll
            for (int m = 0; m < 4; ++m) { const int row = row0 + ai * HALF + m * 16; const float r = rs[ai][m];
                f32x4 h[2];
#pragma unroll
                for (int n = 0; n < 2; ++n)
#pragma unroll
                    for (int i = 0; i < 4; ++i) { const float g = acc[ai][0][m][n][i] * r, uu = acc[ai][1][m][n][i] * r;
                        h[n][i] = g * uu * __builtin_amdgcn_rcpf(1.0f + fast_exp(-g)); }
                *(u32x4*)(H + (size_t)row * DFF + col) = pack8(h[0], h[1]); }
    }
};
struct EpiRes {
    static constexpr bool PERM = true, AFTER_DRAIN = true, KEEPS = false;
    bf16_t* XB; float* Xf; float* ssq; bool fin;
    __device__ __forceinline__ bool keep(const Unit&) const { return false; }
    __device__ __forceinline__ void fused(f32x4 (&acc)[2][2][4][2], const Unit& u, int wr, int wc, int fr, int fq, LAS unsigned char* lds, int wid, int lane) const {
        LAS float* P = (LAS float*)lds;
        int row0 = u.pm * BM + wr * 64 + fr; asm volatile("" : "+v"(row0));
        const int col = u.pn * BM + wc * 32 + 8 * fq;
#pragma unroll
        for (int ai = 0; ai < 2; ++ai)
#pragma unroll
            for (int mh = 0; mh < 2; ++mh) {
                u32x4 g[2][2];
#pragma unroll
                for (int m2 = 0; m2 < 2; ++m2)
#pragma unroll
                    for (int bj = 0; bj < 2; ++bj) g[m2][bj] = *(const u32x4*)(XB + (size_t)(row0 + ai * HALF + (2 * mh + m2) * 16) * DM + col + bj * HALF);
#pragma unroll
                for (int m2 = 0; m2 < 2; ++m2) { const int m = 2 * mh + m2; const size_t off = (size_t)(row0 + ai * HALF + m * 16) * DM + col;
                    float ss = 0.f;
#pragma unroll
                    for (int bj = 0; bj < 2; ++bj) { const u32x4 gg = g[m2][bj];
                        const f32x4 x0 = (f32x4){bflo(gg.x), bfhi(gg.x), bflo(gg.y), bfhi(gg.y)} + acc[ai][bj][m][0], x1 = (f32x4){bflo(gg.z), bfhi(gg.z), bflo(gg.w), bfhi(gg.w)} + acc[ai][bj][m][1];
                        ss += ((x0[0] * x0[0] + x0[1] * x0[1]) + (x0[2] * x0[2] + x0[3] * x0[3])) + ((x1[0] * x1[0] + x1[1] * x1[1]) + (x1[2] * x1[2] + x1[3] * x1[3]));
                        if (fin) { *(f32x4*)(Xf + off + bj * HALF) = x0; *(f32x4*)(Xf + off + bj * HALF + 4) = x1; }
                        else *(u32x4*)(XB + off + bj * HALF) = pack8(x0, x1); }
                    ss += __shfl_xor(ss, 16); ss += __shfl_xor(ss, 32);
                    if (fq == 0) P[(ai * HALF + wr * 64 + m * 16 + fr) * 4 + wc] = ss; }
                asm volatile("" ::: "memory"); }
        asm volatile("s_waitcnt lgkmcnt(0)" ::: "memory"); __builtin_amdgcn_s_barrier(); asm volatile("" ::: "memory");
        const int t = wid * 64 + lane;
        if (t < 256) { const f32x4 p = *(const LAS f32x4*)(P + t * 4); ssq[(size_t)(u.pm * BM + t) * 4 + u.pn] = (p.x + p.y) + (p.z + p.w); }
        asm volatile("s_waitcnt lgkmcnt(0)" ::: "memory"); __builtin_amdgcn_s_barrier(); asm volatile("" ::: "memory");
    }
};
}

struct Frame {
    LAS unsigned char* lds;
    volatile LAS unsigned* MISC;
    int tid, lane, wave, vcu, G, bx;
};
__device__ __forceinline__ Frame make_frame(LAS unsigned char* lds) {
    Frame F; int tid = threadIdx.x, bx = blockIdx.x, G = gridDim.x;
    asm volatile("" : "+v"(tid), "+s"(bx), "+s"(G));
    F.lds = lds; F.MISC = (volatile LAS unsigned*)(lds + MISC_OFF);
    F.tid = tid; F.lane = tid & 63; F.wave = __builtin_amdgcn_readfirstlane(tid >> 6);
    F.G = G; F.bx = bx; F.vcu = (G % 8 == 0) ? (bx % 8) * (G / 8) + bx / 8 : bx;
    return F;
}
struct Args { const float* in[20]; float* out; unsigned char* ws; int ph_lo, ph_hi; };
#define CAS __attribute__((address_space(4)))
typedef const CAS Args* KArgs;
__device__ __forceinline__ KArgs kargs() { KArgs p = (KArgs)__builtin_amdgcn_kernarg_segment_ptr(); asm volatile("" : "+s"(p)); return p; }
enum { I_X = 0, I_LN1 = 1, I_WIN = 2, I_CAW = 3, I_CBW = 4, I_CBB = 5, I_LWA = 6, I_LBA = 7, I_LWX = 8, I_LBX = 9, I_LAM = 10, I_WOA = 11, I_WOB = 12, I_GB = 13, I_WO = 14, I_LN2 = 15, I_WG = 16, I_WU = 17, I_WD = 18, I_FG = 19 };

__device__ __forceinline__ float wave_sum(float v) {
#pragma unroll
    for (int o = 1; o < 64; o <<= 1) v += __shfl_xor(v, o);
    return v;
}

__device__ __forceinline__ void tr_item(const float* W, int K, int N, bf16_t* WT, int drow, const float* gk, LAS float* scr, int k0, int n0, int lane) {
    const int ks = lane >> 3, nq = lane & 7;
    f32x4 v[8];
#pragma unroll
    for (int i = 0; i < 8; ++i) v[i] = *(const f32x4*)(W + (size_t)(k0 + 8 * i + ks) * N + n0 + 4 * nq);
#pragma unroll
    for (int i = 0; i < 8; ++i) { const int kk = 8 * i + ks; const float sc = gk ? gk[k0 + kk] : 1.0f; LAS float* d = scr + kk * 33 + 4 * nq;
        d[0] = v[i].x * sc; d[1] = v[i].y * sc; d[2] = v[i].z * sc; d[3] = v[i].w * sc; }
    LDS_WAIT(); asm volatile("" ::: "memory");
    const int c = lane & 7;
#pragma unroll
    for (int j = 0; j < 4; ++j) { const int n = (lane >> 3) + 8 * j; const LAS float* s = scr + (8 * c) * 33 + n;
        u32x4 o; o.x = pk2(s[0 * 33], s[1 * 33]); o.y = pk2(s[2 * 33], s[3 * 33]); o.z = pk2(s[4 * 33], s[5 * 33]); o.w = pk2(s[6 * 33], s[7 * 33]);
        *(GAS u32x4*)(WT + (size_t)(drow + n) * K + k0 + 8 * c) = o; }
    LDS_WAIT(); asm volatile("" ::: "memory");
}
__device__ __forceinline__ int win_row(int n0) {
    const int seg = n0 >> 10, o = n0 & 1023, j = o >> 7, i = o & 127;
    switch (seg) {
        case 0: return o;
        case 1: return 1024 + 256 * j + i;
        case 2: return 1024 + 256 * j + 128 + i;
        case 3: return 3072 + o;
        case 4: return 4096 + o;
        case 5: return ROW_GG + 256 * j + i;
        default: return ROW_GG + 256 * j + 128 + i;
    }
}
__device__ __forceinline__ void p0_weights(Frame& F, int l) {
    KArgs a = kargs();
    unsigned char* ws = a->ws;
    LAS float* scr = (LAS float*)(F.lds + F.wave * 16384);
    const int gw = F.vcu * NWAVES + F.wave, NGW = F.G * NWAVES;
    constexpr int I_IN = (DM / 64) * (NIN / 32), I_SQ = (DM / 64) * (DM / 32), I_FF = (DM / 64) * (DFF / 32), I_DN = (DFF / 64) * (DM / 32), I_LR = 16 * 2;
    constexpr int NITEMS = I_IN + 3 * I_SQ + 2 * I_FF + I_DN + 2 * I_LR;
    const float* ln1 = a->in[I_LN1] + (size_t)l * DM; const float* ln2 = a->in[I_LN2] + (size_t)l * DM;
    for (int it = gw; it < NITEMS; it += NGW) {
        int r = it;
        if (r < I_IN) { const int nblk = NIN / 32, kb = r / nblk, nb = r % nblk; tr_item(a->in[I_WIN] + (size_t)l * DM * NIN, DM, NIN, (bf16_t*)(ws + WS_WIN), win_row(nb * 32), ln1, scr, kb * 64, nb * 32, F.lane); continue; } r -= I_IN;
        if (r < I_SQ) { const int nblk = DM / 32, kb = r / nblk, nb = r % nblk; tr_item(a->in[I_WOA] + (size_t)l * DM * DM, DM, DM, (bf16_t*)(ws + WS_WOA), nb * 32, nullptr, scr, kb * 64, nb * 32, F.lane); continue; } r -= I_SQ;
        if (r < I_SQ) { const int nblk = DM / 32, kb = r / nblk, nb = r % nblk; tr_item(a->in[I_WOB] + (size_t)l * DM * DM, DM, DM, (bf16_t*)(ws + WS_WOB), nb * 32, nullptr, scr, kb * 64, nb * 32, F.lane); continue; } r -= I_SQ;
        if (r < I_SQ) { const int nblk = DM / 32, kb = r / nblk, nb = r % nblk; tr_item(a->in[I_WO] + (size_t)l * DM * DM, DM, DM, (bf16_t*)(ws + WS_WO), nb * 32, nullptr, scr, kb * 64, nb * 32, F.lane); continue; } r -= I_SQ;
        if (r < I_FF) { const int nblk = DFF / 32, kb = r / nblk, nb = r % nblk, n0 = nb * 32; tr_item(a->in[I_WG] + (size_t)l * DM * DFF, DM, DFF, (bf16_t*)(ws + WS_WGU), 256 * (n0 >> 7) + (n0 & 127), ln2, scr, kb * 64, n0, F.lane); continue; } r -= I_FF;
        if (r < I_FF) { const int nblk = DFF / 32, kb = r / nblk, nb = r % nblk, n0 = nb * 32; tr_item(a->in[I_WU] + (size_t)l * DM * DFF, DM, DFF, (bf16_t*)(ws + WS_WGU), 256 * (n0 >> 7) + 128 + (n0 & 127), ln2, scr, kb * 64, n0, F.lane); continue; } r -= I_FF;
        if (r < I_DN) { const int nblk = DM / 32, kb = r / nblk, nb = r % nblk; tr_item(a->in[I_WD] + (size_t)l * DFF * DM, DFF, DM, (bf16_t*)(ws + WS_WD), nb * 32, nullptr, scr, kb * 64, nb * 32, F.lane); continue; } r -= I_DN;
        if (r < I_LR) { const int h = r >> 1, nb = r & 1; tr_item(a->in[I_LWA] + ((size_t)l * NHEAD + h) * HD * HD, HD, HD, (bf16_t*)(ws + WS_LRU) + (size_t)h * HD * HD, nb * 32, nullptr, scr, 0, nb * 32, F.lane); continue; } r -= I_LR;
        { const int h = r >> 1, nb = r & 1; tr_item(a->in[I_LWX] + ((size_t)l * NHEAD + h) * HD * HD, HD, HD, (bf16_t*)(ws + WS_LRU) + (size_t)(NHEAD + h) * HD * HD, nb * 32, nullptr, scr, 0, nb * 32, F.lane); }
    }
}
__device__ __forceinline__ void p0_x(Frame& F) {
    KArgs a = kargs();
    const int gw = F.vcu * NWAVES + F.wave, NGW = F.G * NWAVES;
    const float* x = a->in[I_X]; bf16_t* XB = (bf16_t*)(a->ws + WS_S0); float* ssq = (float*)(a->ws + WS_SSQ);
    for (int m = gw; m < M; m += NGW) {
        const GAS f32x4* xr = (const GAS f32x4*)(x + (size_t)m * DM) + F.lane;
        f32x4 v[4]; float s = 0.f;
#pragma unroll
        for (int j = 0; j < 4; ++j) { v[j] = xr[64 * j]; s += (v[j].x * v[j].x + v[j].y * v[j].y) + (v[j].z * v[j].z + v[j].w * v[j].w); }
        s = wave_sum(s);
        GAS u32x2* o8 = (GAS u32x2*)(XB + (size_t)m * DM) + F.lane;
#pragma unroll
        for (int j = 0; j < 4; ++j) { u32x2 w; w.x = pk2(v[j].x, v[j].y); w.y = pk2(v[j].z, v[j].w); o8[64 * j] = w; }
        if (F.lane == 0) *(f32x4*)(ssq + (size_t)m * 4) = (f32x4){s, 0.f, 0.f, 0.f};
    }
}
__device__ __forceinline__ void p8_final(Frame& F) {
    KArgs a = kargs();
    const int gw = F.vcu * NWAVES + F.wave, NGW = F.G * NWAVES;
    float* X = a->out; const float* ssq = (const float*)(a->ws + WS_SSQ); const float* g = a->in[I_FG];
    f32x4 gv[4];
#pragma unroll
    for (int j = 0; j < 4; ++j) gv[j] = *((const f32x4*)g + F.lane + 64 * j);
    for (int m = gw; m < M; m += NGW) {
        const float r = rstd_of(ssq, m);
        GAS f32x4* xr = (GAS f32x4*)(X + (size_t)m * DM) + F.lane;
#pragma unroll
        for (int j = 0; j < 4; ++j) { const f32x4 v = xr[64 * j]; xr[64 * j] = v * r * gv[j]; }
    }
}

__device__ __forceinline__ void unpack8(const u32x4 w, float (&f)[8]) { f[0] = bflo(w.x); f[1] = bfhi(w.x); f[2] = bflo(w.y); f[3] = bfhi(w.y); f[4] = bflo(w.z); f[5] = bfhi(w.z); f[6] = bflo(w.w); f[7] = bfhi(w.w); }
template <bool JUNK = false>
__device__ __forceinline__ void p2_mixer_a(Frame& F, int l) {
    KArgs a = kargs();
    bf16_t* BA = (bf16_t*)(a->ws + WS_S1); const bf16_t* V = (const bf16_t*)(a->ws + WS_S2);
    const float* cw = a->in[I_CAW] + (size_t)l * 3 * DM;
    constexpr int RB = 8, NTASK = (M / RB) * (DM / 8);
    for (int task = F.vcu * (NWAVES * 64) + F.tid; task < NTASK; task += F.G * NWAVES * 64) {
        const int cg = task & 127, rb = task >> 7, c0 = cg * 8, t0 = rb * RB;
        const bool first = (t0 % SEQ) == 0;
        u32x4 vr[RB + 2], br[RB];
        vr[0] = first ? (u32x4){0u, 0u, 0u, 0u} : *(const u32x4*)(V + (size_t)(t0 - 2) * DM + c0);
        vr[1] = first ? (u32x4){0u, 0u, 0u, 0u} : *(const u32x4*)(V + (size_t)(t0 - 1) * DM + c0);
#pragma unroll
        for (int r = 0; r < RB; ++r) { vr[r + 2] = *(const u32x4*)(V + (size_t)(t0 + r) * DM + c0); br[r] = *(const u32x4*)(BA + (size_t)(t0 + r) * DM + c0); }
        float w0[8], w1[8], w2[8];
#pragma unroll
        for (int h = 0; h < 2; ++h) { const f32x4 q0 = *(const f32x4*)(cw + c0 + 4 * h), q1 = *(const f32x4*)(cw + DM + c0 + 4 * h), q2 = *(const f32x4*)(cw + 2 * DM + c0 + 4 * h);
#pragma unroll
            for (int i = 0; i < 4; ++i) { w0[4 * h + i] = q0[i]; w1[4 * h + i] = q1[i]; w2[4 * h + i] = q2[i]; } }
        float vm2[8], vm1[8];
        unpack8(vr[0], vm2); unpack8(vr[1], vm1);
#pragma unroll
        for (int r = 0; r < RB; ++r) {
            float v[8], b[8], o[8];
            unpack8(vr[r + 2], v); unpack8(br[r], b);
#pragma unroll
            for (int i = 0; i < 8; ++i) { o[i] = b[i] * (w0[i] * vm2[i] + w1[i] * vm1[i] + w2[i] * v[i]); vm2[i] = vm1[i]; vm1[i] = v[i]; }
            u32x4 w; w.x = pk2(o[0], o[1]); w.y = pk2(o[2], o[3]); w.z = pk2(o[4], o[5]); w.w = pk2(o[6], o[7]);
            *(u32x4*)((JUNK ? (bf16_t*)(a->ws + WS_S5) : BA) + (size_t)(t0 + r) * DM + c0) = w;
        }
    }
}

constexpr int MX_WAVE_BYTES = 12288, MX_UB = 0, MX_SA = 2048, MX_SB = 6144, MX_GT = 10240, MX_WS = 8 * MX_WAVE_BYTES;
template <bool APPLY, bool JUNK = false>
__device__ __forceinline__ void mixer_b(Frame& F, int l) {
    KArgs a = kargs();
    const int lane = F.lane, w = F.wave;
    const bf16_t* XBp = (const bf16_t*)(a->ws + WS_S3); bf16_t* GG = (bf16_t*)(a->ws + WS_S4);
    f32x2* SUM = (f32x2*)(a->ws + WS_SUM); f32x2* SUMG = (f32x2*)(a->ws + WS_SUMG);
    const bf16_t* WaT = (const bf16_t*)(a->ws + WS_LRU); const bf16_t* WxT = WaT + (size_t)NHEAD * HD * HD;
    LAS unsigned char* wl = F.lds + w * MX_WAVE_BYTES;
    LAS float* SA = (LAS float*)(wl + MX_SA); LAS float* SBm = (LAS float*)(wl + MX_SB);
    LAS unsigned short* GT = (LAS unsigned short*)(wl + MX_GT);
    LAS f32x2* WSX = (LAS f32x2*)(F.lds + MX_WS);
    for (int item = F.bx; item < BATCH * NHEAD * 8; item += F.G) {
        const int b = item >> 7, hd = (item >> 3) & 15, g8 = item & 7, span = g8 * 8 + w, chb = hd * HD;
        const int t0 = b * SEQ + span * 128;
        f32x2 pg[7], ps[7];
        if (APPLY) {
#pragma unroll
            for (int j = 0; j < 7; ++j) { pg[j] = (j < g8) ? SUMG[((size_t)(b * 8 + j)) * DM + chb + lane] : (f32x2){1.f, 0.f};
                                          ps[j] = (j < w) ? SUM[((size_t)(b * 64 + g8 * 8 + j)) * DM + chb + lane] : (f32x2){1.f, 0.f}; }
        }
        const int g = lane & 7, tr = lane >> 3, ch0 = chb + 8 * g;
        u32x4 xr[5], gt[2];
#pragma unroll
        for (int k = 0; k < 5; ++k) { const int row = t0 + 2 * tr - 3 + k; xr[k] = (row >= b * SEQ) ? *(const u32x4*)(XBp + (size_t)row * DM + ch0) : (u32x4){0u, 0u, 0u, 0u}; }
        if (APPLY) {
#pragma unroll
            for (int e = 0; e < 2; ++e) gt[e] = *(const u32x4*)(GG + (size_t)(t0 + tr + 8 * e) * DM + ch0);
        }
        float cw[4][8], cb[8];
        { const float* cbw = a->in[I_CBW] + (size_t)l * 4 * DM + ch0; const float* cbb = a->in[I_CBB] + (size_t)l * DM + ch0;
#pragma unroll
          for (int h2 = 0; h2 < 2; ++h2) { const f32x4 bb = *(const f32x4*)(cbb + 4 * h2);
#pragma unroll
              for (int i2 = 0; i2 < 4; ++i2) cb[4 * h2 + i2] = bb[i2];
#pragma unroll
              for (int k = 0; k < 4; ++k) { const f32x4 wk = *(const f32x4*)(cbw + (size_t)k * DM + 4 * h2);
#pragma unroll
                  for (int i2 = 0; i2 < 4; ++i2) cw[k][4 * h2 + i2] = wk[i2]; } } }
        const int cc = lane & 15, kq = lane >> 4;
        bf16x8 bR[4][2], bI[4][2], idf[2];
        float gba[4], gbx[4], gkk[4];
#pragma unroll
        for (int n = 0; n < 4; ++n) { const int e = 16 * n + cc;
#pragma unroll
            for (int s2 = 0; s2 < 2; ++s2) { bR[n][s2] = *(const bf16x8*)(WaT + ((size_t)hd * HD + e) * HD + 32 * s2 + 8 * kq); bI[n][s2] = *(const bf16x8*)(WxT + ((size_t)hd * HD + e) * HD + 32 * s2 + 8 * kq); }
            gba[n] = a->in[I_LBA][(size_t)l * DM + chb + e]; gbx[n] = a->in[I_LBX][(size_t)l * DM + chb + e];
            gkk[n] = -8.0f * log1pf(__expf(-a->in[I_LAM][(size_t)l * DM + chb + e])) * 1.4426950408889634f; }
#pragma unroll
        for (int p2 = 0; p2 < 2; ++p2)
#pragma unroll
            for (int j = 0; j < 8; ++j) idf[p2][j] = (8 * kq + j == 16 * p2 + cc) ? (short)0x3f80 : (short)0;
        float Pw = 1.f, Hw = 0.f;
        if (APPLY) {
#pragma unroll
            for (int j = 0; j < 7; ++j) Hw = pg[j].x * Hw + pg[j].y;
#pragma unroll
            for (int j = 0; j < 7; ++j) Hw = ps[j].x * Hw + ps[j].y;
        }
#pragma unroll 1
        for (int s = 0; s < 8; ++s) {
            const int tb = t0 + 16 * s;
            {
                float u0[8], u1[8];
#pragma unroll
                for (int i2 = 0; i2 < 8; ++i2) { u0[i2] = cb[i2]; u1[i2] = cb[i2]; }
#pragma unroll
                for (int k = 0; k < 5; ++k) { float x[8]; unpack8(xr[k], x);
#pragma unroll
                    for (int i2 = 0; i2 < 8; ++i2) { if (k < 4) u0[i2] += cw[k][i2] * x[i2]; if (k >= 1) u1[i2] += cw[k - 1][i2] * x[i2]; } }
                const int tk0 = 2 * tr, tk1 = 2 * tr + 1;
                u32x4 p0, p1; p0.x = pk2(u0[0], u0[1]); p0.y = pk2(u0[2], u0[3]); p0.z = pk2(u0[4], u0[5]); p0.w = pk2(u0[6], u0[7]);
                p1.x = pk2(u1[0], u1[1]); p1.y = pk2(u1[2], u1[3]); p1.z = pk2(u1[4], u1[5]); p1.w = pk2(u1[6], u1[7]);
                *(LAS u32x4*)(wl + MX_UB + tk0 * 128 + ((g ^ (tk0 & 7)) * 16)) = p0;
                *(LAS u32x4*)(wl + MX_UB + tk1 * 128 + ((g ^ (tk1 & 7)) * 16)) = p1;
                if (APPLY) {
#pragma unroll
                    for (int e = 0; e < 2; ++e) *(LAS u32x4*)(wl + MX_GT + (tr + 8 * e) * 128 + g * 16) = gt[e];
                }
            }
            if (s < 7) {
#pragma unroll
                for (int k = 0; k < 5; ++k) xr[k] = *(const u32x4*)(XBp + (size_t)(tb + 16 + 2 * tr - 3 + k) * DM + ch0);
                if (APPLY) {
#pragma unroll
                    for (int e = 0; e < 2; ++e) gt[e] = *(const u32x4*)(GG + (size_t)(tb + 16 + tr + 8 * e) * DM + ch0);
                }
            }
            LDS_WAIT(); asm volatile("" ::: "memory");
            {
                bf16x8 Af[2];
#pragma unroll
                for (int s2 = 0; s2 < 2; ++s2) Af[s2] = *(const LAS bf16x8*)(wl + MX_UB + cc * 128 + (((4 * s2 + kq) ^ (cc & 7)) * 16));
#pragma unroll
                for (int n = 0; n < 4; ++n) {
                    f32x4 aR = {0.f, 0.f, 0.f, 0.f}, aI = {0.f, 0.f, 0.f, 0.f}, aU = {0.f, 0.f, 0.f, 0.f};
#pragma unroll
                    for (int s2 = 0; s2 < 2; ++s2) { aR = __builtin_amdgcn_mfma_f32_16x16x32_bf16(Af[s2], bR[n][s2], aR, 0, 0, 0); aI = __builtin_amdgcn_mfma_f32_16x16x32_bf16(Af[s2], bI[n][s2], aI, 0, 0, 0); }
                    aU = __builtin_amdgcn_mfma_f32_16x16x32_bf16(Af[n >> 1], idf[n & 1], aU, 0, 0, 0);
#pragma unroll
                    for (int r = 0; r < 4; ++r) {
                        const float rg = fast_sigmoid(aR[r] + gba[n]), ig = fast_sigmoid(aI[r] + gbx[n]);
                        const float av = __builtin_amdgcn_exp2f(rg * gkk[n]);
                        const float bv = __builtin_amdgcn_sqrtf(fmaxf(1.0f - av * av, 0.f)) * (ig * aU[r]);
                        const int tok = 4 * kq + r;
                        SA[tok * 64 + 16 * n + cc] = av; SBm[tok * 64 + 16 * n + cc] = bv;
                    }
                }
            }
            LDS_WAIT(); asm volatile("" ::: "memory");
            if (!APPLY) {
#pragma unroll
                for (int t = 0; t < 16; ++t) { const float av = SA[t * 64 + lane], bv = SBm[t * 64 + lane]; Hw = av * Hw + bv; Pw *= av; }
            } else {
#pragma unroll
                for (int t = 0; t < 16; ++t) { const float av = SA[t * 64 + lane], bv = SBm[t * 64 + lane]; Hw = av * Hw + bv;
                    const float gv = __builtin_bit_cast(float, (unsigned)GT[t * 64 + lane] << 16);
                    GT[t * 64 + lane] = (unsigned short)f2bf(Hw * gv); }
                LDS_WAIT(); asm volatile("" ::: "memory");
#pragma unroll
                for (int e = 0; e < 2; ++e) { const u32x4 o = *(const LAS u32x4*)(wl + MX_GT + (tr + 8 * e) * 128 + g * 16);
                    *(u32x4*)((JUNK ? (bf16_t*)(a->ws + WS_S5) : GG) + (size_t)(tb + tr + 8 * e) * DM + ch0) = o; }
            }
        }
        if (!APPLY) {
            SUM[((size_t)(b * 64 + span)) * DM + chb + lane] = (f32x2){Pw, Hw};
            WSX[w * 64 + lane] = (f32x2){Pw, Hw};
            LDS_WAIT(); __syncthreads();
            if (w == 0) { float Pu = 1.f, Hu = 0.f;
#pragma unroll
                for (int j = 0; j < 8; ++j) { const f32x2 sj = WSX[j * 64 + lane]; Hu = sj.x * Hu + sj.y; Pu *= sj.x; }
                SUMG[((size_t)(b * 8 + g8)) * DM + chb + lane] = (f32x2){Pu, Hu}; }
            LDS_WAIT(); __syncthreads();
        }
    }
}

constexpr int N_PHASES = 8 * DEPTH + 1;
__global__ void __launch_bounds__(NWAVES * 64, 2) fwd_kernel(Args args_unused) {
    extern __shared__ __attribute__((aligned(16))) unsigned char lds[];
    LAS unsigned char* const ldsb = (LAS unsigned char*)lds;
    for (int u = threadIdx.x; u < (LDS_BYTES - LDSCTL_OFF) / 4; u += NWAVES * 64) ((LAS unsigned*)(ldsb + LDSCTL_OFF))[u] = 0u;
    __syncthreads();
    int lo, hi;
    { KArgs a = kargs(); lo = a->ph_lo; hi = a->ph_hi;
      if (hi - lo > 1) (void)xcd_barrier_post((unsigned*)(a->ws + WS_CTL) + CW_BAR, (volatile LAS unsigned*)(ldsb + MISC_OFF) + 8); }
#define IN(k) (lo <= (k) && (k) < hi)
#define SEAM(k) do { if (IN(k) && IN((k) + 1)) { XcdBarrier b_; b_.bar = (unsigned*)(kargs()->ws + WS_CTL) + CW_BAR; b_.x = xb_xcc_id(); b_.st = (volatile LAS unsigned*)(ldsb + MISC_OFF) + 8; xcd_barrier(b_); } } while (0)
    constexpr size_t TS1 = (size_t)256 * DM * 2, TSF = (size_t)256 * DFF * 2;

#pragma unroll 1
    for (int l = 0; l < DEPTH; ++l) {
        const int pb = 8 * l;
        if (IN(pb + 0)) { Frame F = make_frame(ldsb); p0_weights(F, l); if (l == 0) p0_x(F); }
        if (PROBE_REPEAT == 0 && IN(pb + 0)) { Frame F = make_frame(ldsb); p0_weights(F, l); if (l == 0) p0_x(F); }
        SEAM(pb + 0);
        if (IN(pb + 1)) {
            Frame F = make_frame(ldsb); KArgs a = kargs(); unsigned char* ws = a->ws;
            pg8::SchedPlain S; S.so.init(M, N1A, F.G, F.bx); S.A0 = (const char*)(ws + WS_S0); S.B0 = (const char*)(ws + WS_WIN); S.tstep = TS1;
            pg8::EpiP1a E{(const float*)(ws + WS_SSQ), (bf16_t*)(ws + WS_S1), (bf16_t*)(ws + WS_S2), (bf16_t*)(ws + WS_S3), (bf16_t*)(ws + WS_S4)};
            pg8::gemm_phase<pg8::EpiP1a, pg8::SchedPlain, true, true>(F.lds, F.tid, DM, S, E);
        }
        if (PROBE_REPEAT == 1 && IN(pb + 1)) {
            Frame F = make_frame(ldsb); KArgs a = kargs(); unsigned char* ws = a->ws;
            pg8::SchedPlain S; S.so.init(M, N1A, F.G, F.bx); S.A0 = (const char*)(ws + WS_S0); S.B0 = (const char*)(ws + WS_WIN); S.tstep = TS1;
            pg8::EpiP1a E{(const float*)(ws + WS_SSQ), (bf16_t*)(ws + WS_S1), (bf16_t*)(ws + WS_S2), (bf16_t*)(ws + WS_S3), (bf16_t*)(ws + WS_S4)};
            pg8::gemm_phase<pg8::EpiP1a, pg8::SchedPlain, true, true>(F.lds, F.tid, DM, S, E);
        }
        SEAM(pb + 1);
        if (IN(pb + 2)) { { Frame F = make_frame(ldsb); p2_mixer_a(F, l); } { Frame F = make_frame(ldsb); mixer_b<false>(F, l); } }
        if (PROBE_REPEAT == 2 && IN(pb + 2)) { __syncthreads(); Frame F = make_frame(ldsb); mixer_b<false>(F, l); }
        SEAM(pb + 2);
        if (IN(pb + 3)) {
            { Frame F = make_frame(ldsb); mixer_b<true>(F, l); }
            __syncthreads();
            Frame F = make_frame(ldsb); KArgs a = kargs(); unsigned char* ws = a->ws;
            pg8::StaticOrder so; so.init(M, DM, F.G, F.bx);
            int pm_ = 0, pn_ = 0; const bool ok_ = so.next(0, pm_, pn_);
            pg8::SchedGG S; S.valid = ok_; S.pm = pm_; S.pn = pn_; S.ws = (const char*)ws;
            pg8::EpiGG E{(const float*)(ws + WS_SSQ), a->in[I_GB] + (size_t)l * 2 * DM, (bf16_t*)(ws + WS_S2), (bf16_t*)(ws + WS_S5)};
            pg8::gemm_phase<pg8::EpiGG, pg8::SchedGG, true, true>(F.lds, F.tid, DM, S, E);
        }
        if (PROBE_REPEAT == 3 && IN(pb + 3)) {
            __syncthreads();
            Frame F = make_frame(ldsb); KArgs a = kargs(); unsigned char* ws = a->ws;
            pg8::StaticOrder so; so.init(M, DM, F.G, F.bx);
            int pm_ = 0, pn_ = 0; const bool ok_ = so.next(0, pm_, pn_);
            pg8::SchedGG S; S.valid = ok_; S.pm = pm_; S.pn = pn_; S.ws = (const char*)ws;
            pg8::EpiGG E{(const float*)(ws + WS_SSQ), a->in[I_GB] + (size_t)l * 2 * DM, (bf16_t*)(ws + WS_S2), (bf16_t*)(ws + WS_S5)};
            pg8::gemm_phase<pg8::EpiGG, pg8::SchedGG, true, true>(F.lds, F.tid, DM, S, E);
        }
        SEAM(pb + 3);
        if (IN(pb + 4)) {
            Frame F = make_frame(ldsb); KArgs a = kargs(); unsigned char* ws = a->ws;
            pg8::StaticOrder so; so.init(M, DM, F.G, F.bx);
            int pm_ = 0, pn_ = 0; const bool ok_ = so.next(0, pm_, pn_);
            pg8::SchedOut S; S.valid = ok_; S.pm = pm_; S.pn = pn_; S.ws = (const char*)ws;
            pg8::EpiOut E{(const bf16_t*)(ws + WS_S2), (const bf16_t*)(ws + WS_S5), (bf16_t*)(ws + WS_S3)};
            pg8::gemm_phase<pg8::EpiOut, pg8::SchedOut, false, true>(F.lds, F.tid, DM, S, E);
        }
        if (PROBE_REPEAT == 4 && IN(pb + 4)) {
            Frame F = make_frame(ldsb); KArgs a = kargs(); unsigned char* ws = a->ws;
            pg8::StaticOrder so; so.init(M, DM, F.G, F.bx);
            int pm_ = 0, pn_ = 0; const bool ok_ = so.next(0, pm_, pn_);
            pg8::SchedOut S; S.valid = ok_; S.pm = pm_; S.pn = pn_; S.ws = (const char*)ws;
            pg8::EpiOut E{(const bf16_t*)(ws + WS_S2), (const bf16_t*)(ws + WS_S5), (bf16_t*)(ws + WS_S3)};
            pg8::gemm_phase<pg8::EpiOut, pg8::SchedOut, false, true>(F.lds, F.tid, DM, S, E);
        }
        SEAM(pb + 4);
        if (IN(pb + 5)) {
            Frame F = make_frame(ldsb); KArgs a = kargs(); unsigned char* ws = a->ws;
            pg8::SchedPlain S; S.so.init(M, DM, F.G, F.bx); S.A0 = (const char*)(ws + WS_S3); S.B0 = (const char*)(ws + WS_WO); S.tstep = TS1;
            pg8::EpiRes E{(bf16_t*)(ws + WS_S0), a->out, (float*)(ws + WS_SSQ), false};
            pg8::gemm_phase<pg8::EpiRes, pg8::SchedPlain, false, true>(F.lds, F.tid, DM, S, E);
        }
        SEAM(pb + 5);
        if (IN(pb + 6)) {
            Frame F = make_frame(ldsb); KArgs a = kargs(); unsigned char* ws = a->ws;
            pg8::SchedPlain S; S.so.init(M, NGU, F.G, F.bx); S.A0 = (const char*)(ws + WS_S0); S.B0 = (const char*)(ws + WS_WGU); S.tstep = TS1;
            pg8::EpiP6 E{(const float*)(ws + WS_SSQ), (bf16_t*)(ws + WS_S1)};
            pg8::gemm_phase<pg8::EpiP6, pg8::SchedPlain, true, true>(F.lds, F.tid, DM, S, E);
        }
        if (PROBE_REPEAT == 6 && IN(pb + 6)) {
            Frame F = make_frame(ldsb); KArgs a = kargs(); unsigned char* ws = a->ws;
            pg8::SchedPlain S; S.so.init(M, NGU, F.G, F.bx); S.A0 = (const char*)(ws + WS_S0); S.B0 = (const char*)(ws + WS_WGU); S.tstep = TS1;
            pg8::EpiP6 E{(const float*)(ws + WS_SSQ), (bf16_t*)(ws + WS_S1)};
            pg8::gemm_phase<pg8::EpiP6, pg8::SchedPlain, true, true>(F.lds, F.tid, DM, S, E);
        }
        SEAM(pb + 6);
        if (IN(pb + 7)) {
            Frame F = make_frame(ldsb); KArgs a = kargs(); unsigned char* ws = a->ws;
            pg8::SchedPlain S; S.so.init(M, DM, F.G, F.bx); S.A0 = (const char*)(ws + WS_S1); S.B0 = (const char*)(ws + WS_WD); S.tstep = TSF;
            pg8::EpiRes E{(bf16_t*)(ws + WS_S0), a->out, (float*)(ws + WS_SSQ), l == DEPTH - 1};
            pg8::gemm_phase<pg8::EpiRes, pg8::SchedPlain, false, true>(F.lds, F.tid, DFF, S, E);
        }
        SEAM(pb + 7);
    }
    if (IN(8 * DEPTH)) { Frame F = make_frame(ldsb); p8_final(F); }
#undef IN
#undef SEAM
}

extern "C" void kernel_launch(void* const* d_in, const int* in_sizes, int n_in, void* d_out, int out_size, void* d_ws, size_t ws_size, hipStream_t stream) {
    static int grid = 0;
    if (grid == 0) {
        if (n_in != 20 || in_sizes[0] != M * DM || out_size != M * DM || ws_size < WS_END) {
            fprintf(stderr, "kernel_launch: unexpected shapes: n_in %d in0 %d out %d ws %zu (need %zu)\n", n_in, n_in > 0 ? in_sizes[0] : -1, out_size, ws_size, (size_t)WS_END); grid = -1; return; }
        int dev = 0, cus = 0, per_cu = 0;
        if (hipGetDevice(&dev) != hipSuccess || hipDeviceGetAttribute(&cus, hipDeviceAttributeMultiprocessorCount, dev) != hipSuccess) { grid = -1; return; }
        if (hipFuncSetAttribute((const void*)fwd_kernel, hipFuncAttributeMaxDynamicSharedMemorySize, LDS_BYTES) != hipSuccess) { fprintf(stderr, "kernel_launch: hipFuncSetAttribute failed\n"); grid = -1; return; }
        if (hipOccupancyMaxActiveBlocksPerMultiprocessor(&per_cu, (const void*)fwd_kernel, NWAVES * 64, LDS_BYTES) != hipSuccess || per_cu < 1)
            fprintf(stderr, "kernel_launch: occupancy query reports %d workgroups per CU\n", per_cu);
        (void)hipGetLastError();
        grid = cus;
        if (grid != 256) fprintf(stderr, "kernel_launch: %d CUs (built for 256)\n", grid);
    }
    if (grid < 0) return;
    (void)hipMemsetAsync((char*)d_ws + WS_CTL, 0, CTL_ZERO_BYTES, stream);
    Args a{};
    for (int i = 0; i < 20; ++i) a.in[i] = (const float*)d_in[i];
    a.out = (float*)d_out; a.ws = (unsigned char*)d_ws;
#if MK_PER_PHASE
    for (int p = 0; p < N_PHASES; ++p) { a.ph_lo = p; a.ph_hi = p + 1; hipLaunchKernelGGL(fwd_kernel, dim3(grid), dim3(NWAVES * 64), LDS_BYTES, stream, a); }
#else
    a.ph_lo = 0; a.ph_hi = N_PHASES;
    hipLaunchKernelGGL(fwd_kernel, dim3(grid), dim3(NWAVES * 64), LDS_BYTES, stream, a);
#endif
}
```

```cpp
#include <hip/hip_runtime.h>
#include <cstdio>
#include <cstdint>

#ifndef PROBE_REPEAT
#define PROBE_REPEAT -1
#endif
#ifndef MK_PER_PHASE
#define MK_PER_PHASE 0
#endif

#define LAS __attribute__((address_space(3)))
#define GAS __attribute__((address_space(1)))
typedef unsigned short bf16_t;
typedef short bf16x8 __attribute__((ext_vector_type(8)));
typedef float f32x4 __attribute__((ext_vector_type(4)));
typedef float f32x2 __attribute__((ext_vector_type(2)));
typedef unsigned u32x4 __attribute__((ext_vector_type(4)));
typedef unsigned u32x2 __attribute__((ext_vector_type(2)));
typedef GAS unsigned gu32;

constexpr int BATCH = 2, SEQ = 8192, DM = 1024, M = BATCH * SEQ, NIN = 7168, DFF = 2816, NGU = 2 * DFF, NHEAD = 16, HD = 64, DEPTH = 2;
constexpr float RMS_EPS = 1e-6f;
constexpr int NWAVES = 8;
constexpr int N1A = 5120;
constexpr int ROW_GG = 5120;

constexpr size_t MiB = 1u << 20;
constexpr size_t WS_CTL = 0, CTL_ZERO_BYTES = 1 * MiB;
constexpr size_t WS_SSQ = 1 * MiB;
constexpr size_t WS_SUM = 2 * MiB;
constexpr size_t WS_LRU = 3 * MiB;
constexpr size_t WS_SUMG = 3 * MiB + 512 * 1024;
constexpr size_t WS_WIN = 4 * MiB, WS_WOA = 18 * MiB, WS_WOB = 20 * MiB, WS_WO = 22 * MiB, WS_WGU = 24 * MiB, WS_WD = 35 * MiB;
constexpr size_t WS_S0 = 48 * MiB, SLOT = 32 * MiB;
constexpr size_t WS_S1 = WS_S0 + SLOT, WS_S2 = WS_S1 + SLOT, WS_S3 = WS_S2 + SLOT, WS_S4 = WS_S3 + SLOT, WS_S5 = WS_S4 + SLOT, WS_END = WS_S5 + SLOT;
static_assert(WS_WD + (size_t)DM * DFF * 2 <= WS_S0 && WS_END <= 256 * MiB, "d_ws map");
constexpr int CW_BAR = 4096;

constexpr int RING_BYTES = 131072;
constexpr int LDSCTL_OFF = RING_BYTES, MISC_OFF = LDSCTL_OFF + 320;
constexpr int LDS_BYTES = 147456;

#define RLX_AGENT __ATOMIC_RELAXED, __HIP_MEMORY_SCOPE_AGENT
#define LDS_WAIT() asm volatile("s_waitcnt lgkmcnt(0)" ::: "memory")
#define VM_WAIT() asm volatile("s_waitcnt vmcnt(0)" ::: "memory")
__device__ __forceinline__ unsigned f2bf(float f) { unsigned u = __builtin_bit_cast(unsigned, f); return (u + 0x7fffu + ((u >> 16) & 1u)) >> 16; }
__device__ __forceinline__ unsigned pk2(float lo, float hi) { return f2bf(lo) | (f2bf(hi) << 16); }
__device__ __forceinline__ unsigned cvt_pk_bf16(float lo, float hi) { unsigned r; asm volatile("v_cvt_pk_bf16_f32 %0, %1, %2" : "=v"(r) : "v"(lo), "v"(hi)); return r; }
__device__ __forceinline__ float bflo(unsigned w) { return __builtin_bit_cast(float, w << 16); }
__device__ __forceinline__ float bfhi(unsigned w) { return __builtin_bit_cast(float, w & 0xffff0000u); }
__device__ __forceinline__ float fast_exp(float x) { return __builtin_amdgcn_exp2f(x * 1.4426950408889634f); }
__device__ __forceinline__ float fast_sigmoid(float x) { return __builtin_amdgcn_rcpf(1.0f + fast_exp(-x)); }
__device__ __forceinline__ float gelu_tanh(float x) {
    const float z = 1.5957691216057308f * (x + 0.044715f * x * x * x);
    return x * __builtin_amdgcn_rcpf(1.0f + fast_exp(-z));
}
__device__ __forceinline__ float rstd_of(const float* ssq, int row) {
    const f32x4 s = *(const f32x4*)(ssq + (size_t)row * 4);
    return __builtin_amdgcn_rsqf(((s.x + s.y) + (s.z + s.w)) * (1.0f / DM) + RMS_EPS);
}

#define XB_TMO      128
#define XB_XCNT(j)  (256  + 64 * (j))
#define XB_XSUB(j)  (1280 + 64 * (j))
#define XB_XGEN(j)  (2304 + 64 * (j))
#define XB_TOP      3328
#define XB_TOPGEN   3392
#define XCD_BAR_WORDS 3456
#define XB_SPIN_CAP (1u << 22)
__device__ __forceinline__ unsigned xb_ld(unsigned* p)              { return __hip_atomic_load(p, __ATOMIC_RELAXED, __HIP_MEMORY_SCOPE_AGENT); }
__device__ __forceinline__ unsigned xb_add(unsigned* p, unsigned v) { return __hip_atomic_fetch_add(p, v, __ATOMIC_RELAXED, __HIP_MEMORY_SCOPE_AGENT); }
__device__ __forceinline__ unsigned xb_xcc_id() { return (unsigned)__builtin_amdgcn_s_getreg((3 << 11) | 20) & 0xFu; }
#define XB_SPIN(cond, bar) do { unsigned _sp = 0; while (cond) { __builtin_amdgcn_s_sleep(1); \
    if ((++_sp & 255u) == 0u) { if (xb_ld(&(bar)[XB_TMO])) break; if (_sp > XB_SPIN_CAP) { atomicAdd(&(bar)[XB_TMO], 1u); break; } } } } while (0)
struct XcdBarrier { unsigned* bar; unsigned x; volatile LAS unsigned* st; };
__device__ __forceinline__ XcdBarrier xcd_barrier_post(unsigned* bar, volatile LAS unsigned* st) {
    XcdBarrier b; b.bar = bar; b.x = xb_xcc_id(); b.st = st;
    if (threadIdx.x == 0) (void)xb_add(&bar[XB_XCNT(b.x)], 1u);
    return b;
}
__device__ __forceinline__ void xcd_barrier_complete(unsigned* bar, unsigned x, unsigned& nloc, unsigned& nx) {
    const unsigned G = gridDim.x * gridDim.y * gridDim.z;
    unsigned sum, cnt, mine, sp = 0u;
    for (;;) {
        sum = 0u; cnt = 0u; mine = 0u;
#pragma unroll
        for (unsigned j = 0; j < 16; ++j) { const unsigned c = xb_ld(&bar[XB_XCNT(j)]); sum += c; cnt += (c > 0u) ? 1u : 0u; mine = (j == x) ? c : mine; }
        if (sum == G) break;
        __builtin_amdgcn_s_sleep(1);
        if ((++sp & 255u) == 0u) { if (xb_ld(&bar[XB_TMO])) break; if (sp > XB_SPIN_CAP) { atomicAdd(&bar[XB_TMO], 1u); break; } }
    }
    nloc = mine > 0u ? mine : 1u; nx = cnt > 0u ? cnt : 1u;
}
__device__ __forceinline__ void xcd_barrier(const XcdBarrier& b) {
    asm volatile("s_waitcnt vmcnt(0)" ::: "memory");
    __syncthreads();
    if (threadIdx.x == 0) {
        unsigned* bar = b.bar;
        __builtin_amdgcn_s_waitcnt(0);
        unsigned nloc = b.st[0], nx = b.st[1];
        if (nloc == 0u) { xcd_barrier_complete(bar, b.x, nloc, nx); b.st[0] = nloc; b.st[1] = nx; }
        const unsigned old = xb_add(&bar[XB_XSUB(b.x)], 1u);
        const unsigned gen = old / nloc;
        if (old + 1u == (gen + 1u) * nloc) {
            __builtin_amdgcn_fence(__ATOMIC_RELEASE, "agent");
            asm volatile("s_waitcnt vmcnt(0)" ::: "memory");
            const unsigned og = xb_add(&bar[XB_TOP], 1u);
            const unsigned tg = og / nx;
            if (og + 1u == (tg + 1u) * nx) xb_add(&bar[XB_TOPGEN], 1u);
            else XB_SPIN(xb_ld(&bar[XB_TOPGEN]) == tg, bar);
            __builtin_amdgcn_fence(__ATOMIC_ACQUIRE, "agent");
            xb_add(&bar[XB_XGEN(b.x)], 1u);
            asm volatile("s_waitcnt vmcnt(0)" ::: "memory");
        } else {
            XB_SPIN(xb_ld(&bar[XB_XGEN(b.x)]) == gen, bar);
            __builtin_amdgcn_fence(__ATOMIC_ACQUIRE, "agent");
            asm volatile("s_waitcnt vmcnt(0)" ::: "memory");
        }
    }
    __syncthreads();
}

namespace pg8 {
constexpr int BM = 256, BK = 64, HALF = 128, HTB = HALF * BK * 2, NXCD = 8, WGM = 8;
__host__ __device__ __forceinline__ int lds_byte(int r, int c) { const int st = (r >> 4) * 2 + (c >> 5), rr = r & 15, cc = c & 31, ob = rr * 64 + cc * 2; return st * 1024 + (ob ^ (((ob >> 9) & 1) << 5)); }
__host__ __device__ __forceinline__ void stage_rc(int b, int& R, int& C) { const int st = b / 1024, sb = b % 1024, swz = sb ^ (((sb >> 9) & 1) << 5); R = (st >> 1) * 16 + swz / 64; C = (st & 1) * 32 + (swz % 64) / 2; }
__host__ __device__ __forceinline__ int perm32(int rho) { const int n = rho >> 4, i = rho & 15; return 8 * (i >> 2) + 4 * n + (i & 3); }

struct Unit { int pm, pn, kind; };

struct StaticOrder {
    int nM, nN, nwg, G, c;
    __device__ __forceinline__ void init(int M_, int N_, int G_, int c_) { nM = M_ / BM; nN = N_ / BM; nwg = nM * nN; G = G_; c = c_; }
    __device__ __forceinline__ bool next(int i, int& pm, int& pn) const {
        const long L = (long)i * G + c; if (L >= nwg) return false;
        int wgid = (int)L; { const int q = nwg / NXCD, r = nwg % NXCD, xcd = wgid % NXCD, off = wgid / NXCD; wgid = (xcd < r ? xcd * (q + 1) : r * (q + 1) + (xcd - r) * q) + off; }
        const int nig = WGM * nN, gid = wgid / nig, fm = gid * WGM, gsz = (nM - fm) < WGM ? (nM - fm) : WGM;
        pm = fm + ((wgid % nig) % gsz); pn = (wgid % nig) / gsz; return true;
    }
};
struct SchedPlain {
    StaticOrder so; const char* A0; const char* B0; size_t tstep;
    __device__ __forceinline__ bool next(int i, Unit& u) const { int pm_ = 0, pn_ = 0; const bool ok_ = so.next(i, pm_, pn_); u.pm = pm_; u.pn = pn_; u.kind = 0; return ok_; }
    __device__ __forceinline__ const char* a_ptr(const Unit& u) const { return A0 + (size_t)u.pm * tstep; }
    __device__ __forceinline__ const char* b_ptr(const Unit& u) const { return B0 + (size_t)u.pn * tstep; }
};
struct SchedGG {
    int pm, pn; bool valid; const char* ws;
    static constexpr size_t TS = (size_t)256 * DM * 2;
    __device__ __forceinline__ bool next(int i, Unit& u) const { if (!valid || i >= 2) return false; u.pm = pm; u.kind = 0; u.pn = 2 * pn + i; return true; }
    __device__ __forceinline__ const char* a_ptr(const Unit& u) const { return ws + WS_S0 + (size_t)u.pm * TS; }
    __device__ __forceinline__ const char* b_ptr(const Unit& u) const { return ws + WS_WIN + (size_t)ROW_GG * DM * 2 + (size_t)u.pn * TS; }
};
struct SchedOut {
    int pm, pn; bool valid; const char* ws;
    static constexpr size_t TS = (size_t)256 * DM * 2;
    __device__ __forceinline__ bool next(int i, Unit& u) const { if (!valid || i >= 2) return false; u.pm = pm; u.kind = i + 1; u.pn = pn; return true; }
    __device__ __forceinline__ const char* a_ptr(const Unit& u) const { return ws + WS_S1 + (size_t)(u.kind == 2) * (WS_S4 - WS_S1) + (size_t)u.pm * TS; }
    __device__ __forceinline__ const char* b_ptr(const Unit& u) const { return ws + WS_WOA + (size_t)(u.kind == 2) * (WS_WOB - WS_WOA) + (size_t)u.pn * TS; }
};

template <class Epi, class Sched, bool ALIGN_EPI, bool SP2>
__device__ __forceinline__ void gemm_phase(LAS unsigned char* lds, const int tid, const int K, const Sched& S, const Epi& E) {
    const int wid = __builtin_amdgcn_readfirstlane(tid >> 6), lane = tid & 63, wr = wid >> 2, wc = wid & 3, fr = lane & 15, fq = lane >> 4;
    const int nt = K / BK;
    unsigned voffA[2], voffB[2];
#pragma unroll
    for (int i = 0; i < 2; ++i) { int R, C; stage_rc(tid * 16 + i * 8192, R, C); const int Rb = Epi::PERM ? ((R & ~31) + perm32(R & 31)) : R;
        voffA[i] = (unsigned)(R * K + C) * 2u; voffB[i] = (unsigned)(Rb * K + C) * 2u; }
    const size_t kstep = (size_t)(BK * 2);
    const size_t hstep = (size_t)HALF * K * 2;
    const unsigned ldsw = (unsigned)wid * 1024u;
    const int aoff = lds_byte(wr * 64 + fr, fq * 8), boff = lds_byte(wc * 32 + fr, fq * 8);
#define PG8_SA(b, h) (((b) * 2 + (h)) * HTB)
#define PG8_SB(b, h) ((4 + (b) * 2 + (h)) * HTB)
#define PG8_STAGE(bufoff, gbase, voff) do { _Pragma("unroll") for (int _i = 0; _i < 2; ++_i) \
        __builtin_amdgcn_global_load_lds((const unsigned*)((const char*)(gbase) + (voff)[_i]), (LAS unsigned*)(lds + (bufoff) + ldsw + _i * 8192), 16, 0, 0); } while (0)
#define PG8_LDA(dst, b, h) do { _Pragma("unroll") for (int m = 0; m < 4; ++m) _Pragma("unroll") for (int k = 0; k < 2; ++k) dst[m][k] = *(const LAS bf16x8*)(lds + PG8_SA(b, h) + aoff + m * 2048 + k * 1024); } while (0)
#define PG8_LDB(dst, b, h) do { _Pragma("unroll") for (int n = 0; n < 2; ++n) _Pragma("unroll") for (int k = 0; k < 2; ++k) dst[n][k] = *(const LAS bf16x8*)(lds + PG8_SB(b, h) + boff + n * 2048 + k * 1024); } while (0)
#define PG8_MMA(ai, bj, At, Bt) do { __builtin_amdgcn_s_setprio(1); _Pragma("unroll") for (int m = 0; m < 4; ++m) _Pragma("unroll") for (int n = 0; n < 2; ++n) _Pragma("unroll") for (int k = 0; k < 2; ++k) \
        acc[ai][bj][m][n] = __builtin_amdgcn_mfma_f32_16x16x32_bf16(Bt[n][k], At[m][k], acc[ai][bj][m][n], 0, 0, 0); __builtin_amdgcn_s_setprio(0); } while (0)
#define PG8_WAIT_V(n) asm volatile("s_waitcnt vmcnt(" #n ")" ::: "memory")
#define PG8_WAIT_L(n) asm volatile("s_waitcnt lgkmcnt(" #n ")" ::: "memory")
#define PG8_BAR __builtin_amdgcn_s_barrier()
#define PG8_SCHED __builtin_amdgcn_sched_barrier(0)
    Unit cur, nxt; int ui = 0;
    if (!S.next(0, cur)) return;
    f32x4 acc[2][2][4][2];
#pragma unroll
    for (int a = 0; a < 2; ++a)
#pragma unroll
        for (int b = 0; b < 2; ++b)
#pragma unroll
            for (int m = 0; m < 4; ++m)
#pragma unroll
                for (int n = 0; n < 2; ++n) acc[a][b][m][n] = (f32x4){0.f, 0.f, 0.f, 0.f};
    bf16x8 At[4][2], B0[2][2], B1[2][2];
    const char* cA = S.a_ptr(cur); const char* cB = S.b_ptr(cur);
    if constexpr (SP2) {
        PG8_STAGE(PG8_SB(0, 0), cB, voffB); PG8_STAGE(PG8_SB(0, 1), cB + hstep, voffB); PG8_STAGE(PG8_SA(0, 0), cA, voffA); PG8_STAGE(PG8_SA(0, 1), cA + hstep, voffA);
        if (wr == 1) PG8_BAR;
        PG8_WAIT_V(2); PG8_BAR;
        PG8_STAGE(PG8_SB(1, 0), cB + kstep, voffB); PG8_STAGE(PG8_SA(1, 0), cA + kstep, voffA); PG8_STAGE(PG8_SB(1, 1), cB + hstep + kstep, voffB);
        PG8_WAIT_V(6); PG8_BAR;
    } else {
        PG8_STAGE(PG8_SB(0, 0), cB, voffB); PG8_STAGE(PG8_SA(0, 0), cA, voffA); PG8_STAGE(PG8_SB(0, 1), cB + hstep, voffB); PG8_STAGE(PG8_SA(0, 1), cA + hstep, voffA);
        if (wr == 1) PG8_BAR;
        PG8_WAIT_V(4); PG8_BAR;
        PG8_STAGE(PG8_SB(1, 0), cB + kstep, voffB); PG8_STAGE(PG8_SA(1, 0), cA + kstep, voffA); PG8_STAGE(PG8_SB(1, 1), cB + hstep + kstep, voffB);
        PG8_WAIT_V(6); PG8_BAR;
    }
    for (;;) {
        const bool has_next = S.next(ui + 1, nxt);
        const char* nA = has_next ? S.a_ptr(nxt) : cA; const char* nB = has_next ? S.b_ptr(nxt) : cB;
        for (int t = 0; t < nt; t += 2) {
            const bool last = (t == nt - 2);
            const char* a1 = cA + (size_t)(t + 1) * kstep;
            const char* a2 = last ? nA : cA + (size_t)(t + 2) * kstep; const char* b2 = last ? nB : cB + (size_t)(t + 2) * kstep;
            const char* a3 = a2 + kstep; const char* b3 = b2 + kstep;
            if constexpr (SP2) {
            PG8_LDB(B0, 0, 0); PG8_LDB(B1, 0, 1); PG8_SCHED; PG8_LDA(At, 0, 0); PG8_STAGE(PG8_SA(1, 1), a1 + hstep, voffA);
            PG8_WAIT_V(8); PG8_WAIT_L(0); PG8_BAR; PG8_MMA(0, 0, At, B0); PG8_MMA(0, 1, At, B1); PG8_BAR; PG8_SCHED;
            PG8_LDA(At, 0, 1); PG8_STAGE(PG8_SB(0, 0), b2, voffB); PG8_STAGE(PG8_SB(0, 1), b2 + hstep, voffB); PG8_STAGE(PG8_SA(0, 0), a2, voffA);
            PG8_WAIT_V(8); PG8_WAIT_L(0); PG8_BAR; PG8_MMA(1, 0, At, B0); PG8_MMA(1, 1, At, B1); PG8_BAR; PG8_SCHED;
            PG8_LDB(B0, 1, 0); PG8_LDB(B1, 1, 1); PG8_SCHED; PG8_LDA(At, 1, 0); PG8_STAGE(PG8_SA(0, 1), a2 + hstep, voffA);
            PG8_WAIT_V(8); PG8_WAIT_L(0); PG8_BAR; PG8_MMA(0, 0, At, B0); PG8_MMA(0, 1, At, B1); PG8_BAR; PG8_SCHED;
            PG8_LDA(At, 1, 1); PG8_STAGE(PG8_SB(1, 0), b3, voffB); PG8_STAGE(PG8_SB(1, 1), b3 + hstep, voffB); PG8_STAGE(PG8_SA(1, 0), a3, voffA);
            PG8_WAIT_V(8); PG8_WAIT_L(0); PG8_BAR; PG8_MMA(1, 0, At, B0); PG8_MMA(1, 1, At, B1); PG8_BAR; PG8_SCHED;
            } else {
            PG8_LDB(B0, 0, 0); PG8_SCHED; PG8_LDA(At, 0, 0); PG8_STAGE(PG8_SA(1, 1), a1 + hstep, voffA);
            PG8_WAIT_L(8); PG8_BAR; PG8_WAIT_L(0); PG8_MMA(0, 0, At, B0); PG8_BAR; PG8_SCHED;
            PG8_LDB(B1, 0, 1); PG8_STAGE(PG8_SB(0, 0), b2, voffB);
            PG8_BAR; PG8_WAIT_L(0); PG8_MMA(0, 1, At, B1); PG8_BAR;
            PG8_LDA(At, 0, 1); PG8_STAGE(PG8_SA(0, 0), a2, voffA);
            PG8_BAR; PG8_WAIT_L(0); PG8_MMA(1, 0, At, B0); PG8_BAR; PG8_SCHED;
            PG8_STAGE(PG8_SB(0, 1), b2 + hstep, voffB);
            PG8_WAIT_V(6); PG8_BAR; PG8_MMA(1, 1, At, B1); PG8_BAR;
            PG8_LDB(B0, 1, 0); PG8_SCHED; PG8_LDA(At, 1, 0); PG8_STAGE(PG8_SA(0, 1), a2 + hstep, voffA);
            PG8_WAIT_L(8); PG8_BAR; PG8_WAIT_L(0); PG8_MMA(0, 0, At, B0); PG8_BAR; PG8_SCHED;
            PG8_LDB(B1, 1, 1); PG8_STAGE(PG8_SB(1, 0), b3, voffB);
            PG8_BAR; PG8_WAIT_L(0); PG8_MMA(0, 1, At, B1); PG8_BAR;
            PG8_LDA(At, 1, 1); PG8_STAGE(PG8_SA(1, 0), a3, voffA);
            PG8_BAR; PG8_WAIT_L(0); PG8_MMA(1, 0, At, B0); PG8_BAR; PG8_SCHED;
            PG8_STAGE(PG8_SB(1, 1), b3 + hstep, voffB);
            PG8_WAIT_V(6); PG8_BAR; PG8_MMA(1, 1, At, B1); PG8_BAR;
            }
        }
        if constexpr (ALIGN_EPI) { if (wr == 0) PG8_BAR; }
        if constexpr (!Epi::AFTER_DRAIN) { E(acc, cur, wr, wc, fr, fq); }
        if (!has_next) break;
        if constexpr (Epi::KEEPS) {
            E.rescale(acc, cur, wr, wc, fr, fq);
        } else {
#pragma unroll
            for (int a = 0; a < 2; ++a)
#pragma unroll
                for (int b = 0; b < 2; ++b)
#pragma unroll
                    for (int m = 0; m < 4; ++m)
#pragma unroll
                        for (int n = 0; n < 2; ++n) acc[a][b][m][n] = (f32x4){0.f, 0.f, 0.f, 0.f};
        }
        cur = nxt; cA = nA; cB = nB; ++ui;
        if constexpr (ALIGN_EPI) { if (wr == 1) PG8_BAR; }
    }
    PG8_WAIT_V(0);
    if constexpr (!ALIGN_EPI) { if (wr == 0) PG8_BAR; }
    PG8_BAR;
    if constexpr (Epi::AFTER_DRAIN) { E.fused(acc, cur, wr, wc, fr, fq, lds, wid, lane); }
#undef PG8_SA
#undef PG8_SB
#undef PG8_STAGE
#undef PG8_LDA
#undef PG8_LDB
#undef PG8_MMA
#undef PG8_WAIT_V
#undef PG8_WAIT_L
#undef PG8_BAR
#undef PG8_SCHED
}

__device__ __forceinline__ void rstd8(const float* ssq, int row0, float (&rs)[2][4]) {
    f32x4 q[2][4];
#pragma unroll
    for (int ai = 0; ai < 2; ++ai)
#pragma unroll
        for (int m = 0; m < 4; ++m) q[ai][m] = *(const f32x4*)(ssq + (size_t)(row0 + ai * HALF + m * 16) * 4);
#pragma unroll
    for (int ai = 0; ai < 2; ++ai)
#pragma unroll
        for (int m = 0; m < 4; ++m) rs[ai][m] = __builtin_amdgcn_rsqf(((q[ai][m].x + q[ai][m].y) + (q[ai][m].z + q[ai][m].w)) * (1.0f / DM) + RMS_EPS);
}
__device__ __forceinline__ u32x4 pack8(const f32x4 a, const f32x4 b) { u32x4 w; w.x = cvt_pk_bf16(a[0], a[1]); w.y = cvt_pk_bf16(a[2], a[3]); w.z = cvt_pk_bf16(b[0], b[1]); w.w = cvt_pk_bf16(b[2], b[3]); return w; }

struct EpiP1a {
    static constexpr bool PERM = true, AFTER_DRAIN = false, KEEPS = false;
    const float* ssq; bf16_t *BA, *V, *XBp, *GG;
    __device__ __forceinline__ bool keep(const Unit&) const { return false; }
    __device__ __forceinline__ void operator()(f32x4 (&acc)[2][2][4][2], const Unit& u, int wr, int wc, int fr, int fq) const {
        int row0 = u.pm * BM + wr * 64 + fr; asm volatile("" : "+v"(row0));
        const int pn = u.pn;
        float rs[2][4]; rstd8(ssq, row0, rs);
        if (pn >= 4 && pn < 12) {
            const int col = (pn - 4) * 128 + wc * 32 + 8 * fq;
#pragma unroll
            for (int ai = 0; ai < 2; ++ai)
#pragma unroll
                for (int m = 0; m < 4; ++m) { const int row = row0 + ai * HALF + m * 16; const float r = rs[ai][m], r2 = r * r;
                    const f32x4 v0 = acc[ai][0][m][0] * acc[ai][1][m][0] * r2, v1 = acc[ai][0][m][1] * acc[ai][1][m][1] * r2;
                    *(u32x4*)(V + (size_t)row * DM + col) = pack8(v0, v1); }
        } else {
            bf16_t* O; int colt; bool act = false;
            if (pn < 4) { O = BA; colt = pn * 256; } else if (pn < 16) { O = XBp; colt = (pn - 12) * 256; } else { O = GG; colt = (pn - 16) * 256; act = true; }
            const int col = colt + wc * 32 + 8 * fq;
#pragma unroll
            for (int ai = 0; ai < 2; ++ai)
#pragma unroll
                for (int m = 0; m < 4; ++m) { const int row = row0 + ai * HALF + m * 16; const float r = rs[ai][m];
#pragma unroll
                    for (int bj = 0; bj < 2; ++bj) { f32x4 v0 = acc[ai][bj][m][0] * r, v1 = acc[ai][bj][m][1] * r;
                        if (act) {
#pragma unroll
                            for (int i = 0; i < 4; ++i) { v0[i] = gelu_tanh(v0[i]); v1[i] = gelu_tanh(v1[i]); } }
                        *(u32x4*)(O + (size_t)row * DM + col + bj * HALF) = pack8(v0, v1); } }
        }
    }
};
struct EpiGG {
    static constexpr bool PERM = true, AFTER_DRAIN = false, KEEPS = false;
    const float* ssq; const float* gbias;
    bf16_t *RA, *SB;
    __device__ __forceinline__ bool keep(const Unit&) const { return false; }
    __device__ __forceinline__ void operator()(f32x4 (&acc)[2][2][4][2], const Unit& u, int wr, int wc, int fr, int fq) const {
        int row0 = u.pm * BM + wr * 64 + fr; asm volatile("" : "+v"(row0));
        {
            const int col = u.pn * 128 + wc * 32 + 8 * fq;
#pragma unroll
            for (int ai = 0; ai < 2; ++ai) {
                float rs4[4];
                { f32x4 q[4];
#pragma unroll
                  for (int m = 0; m < 4; ++m) q[m] = *(const f32x4*)(ssq + (size_t)(row0 + ai * HALF + m * 16) * 4);
#pragma unroll
                  for (int m = 0; m < 4; ++m) rs4[m] = __builtin_amdgcn_rsqf(((q[m].x + q[m].y) + (q[m].z + q[m].w)) * (1.0f / DM) + RMS_EPS); }
#pragma unroll
                for (int m = 0; m < 4; ++m) { const int row = row0 + ai * HALF + m * 16; const float r = rs4[m];
                    unsigned wra[4], wsb[4];
#pragma unroll
                    for (int n = 0; n < 2; ++n) {
                        const f32x4 ba = *(const f32x4*)(gbias + col + 4 * n), bb = *(const f32x4*)(gbias + DM + col + 4 * n);
                        float ra[4], sb[4];
#pragma unroll
                        for (int i = 0; i < 4; ++i) {
                            float p = acc[ai][0][m][n][i] * r + ba[i], q = acc[ai][1][m][n][i] * r + bb[i];
                            p = fminf(fmaxf(p, -30.f), 30.f); q = fminf(fmaxf(q, -30.f), 30.f);
                            const float ep = 1.0f + fast_exp(-p), eq = 1.0f + fast_exp(-q);
                            ra[i] = eq * __builtin_amdgcn_rcpf(ep); sb[i] = __builtin_amdgcn_rcpf(eq); }
                        wra[2 * n] = cvt_pk_bf16(ra[0], ra[1]); wra[2 * n + 1] = cvt_pk_bf16(ra[2], ra[3]);
                        wsb[2 * n] = cvt_pk_bf16(sb[0], sb[1]); wsb[2 * n + 1] = cvt_pk_bf16(sb[2], sb[3]); }
                    *(u32x4*)(RA + (size_t)row * DM + col) = (u32x4){wra[0], wra[1], wra[2], wra[3]};
                    *(u32x4*)(SB + (size_t)row * DM + col) = (u32x4){wsb[0], wsb[1], wsb[2], wsb[3]}; }
                asm volatile("" ::: "memory"); }
        }
    }
};
struct EpiOut {
    static constexpr bool PERM = true, AFTER_DRAIN = false, KEEPS = true;
    const bf16_t *RA, *SB; bf16_t* MG;
    __device__ __forceinline__ bool keep(const Unit& u) const { return u.kind == 1; }
    __device__ __forceinline__ void operator()(f32x4 (&acc)[2][2][4][2], const Unit& u, int wr, int wc, int fr, int fq) const {
        int row0 = u.pm * BM + wr * 64 + fr; asm volatile("" : "+v"(row0));
        if (u.kind == 2) {
            const int col = u.pn * 256 + wc * 32 + 8 * fq;
#pragma unroll
            for (int ai = 0; ai < 2; ++ai)
#pragma unroll
                for (int mh = 0; mh < 2; ++mh) {
                    u32x4 g[2][2];
#pragma unroll
                    for (int m2 = 0; m2 < 2; ++m2)
#pragma unroll
                        for (int bj = 0; bj < 2; ++bj) g[m2][bj] = *(const u32x4*)(SB + (size_t)(row0 + ai * HALF + (2 * mh + m2) * 16) * DM + col + bj * HALF);
#pragma unroll
                    for (int m2 = 0; m2 < 2; ++m2) { const int m = 2 * mh + m2, row = row0 + ai * HALF + m * 16;
#pragma unroll
                        for (int bj = 0; bj < 2; ++bj) { const u32x4 gg = g[m2][bj];
                            const f32x4 g0 = {bflo(gg.x), bfhi(gg.x), bflo(gg.y), bfhi(gg.y)}, g1 = {bflo(gg.z), bfhi(gg.z), bflo(gg.w), bfhi(gg.w)};
                            *(u32x4*)(MG + (size_t)row * DM + col + bj * HALF) = pack8(acc[ai][bj][m][0] * g0, acc[ai][bj][m][1] * g1); } }
                    asm volatile("" ::: "memory"); }
        }
    }
    __device__ __forceinline__ void rescale(f32x4 (&acc)[2][2][4][2], const Unit& u, int wr, int wc, int fr, int fq) const {
        int row0 = u.pm * BM + wr * 64 + fr; asm volatile("" : "+v"(row0)); const int col = u.pn * 256 + wc * 32 + 8 * fq;
#pragma unroll
        for (int ai = 0; ai < 2; ++ai)
#pragma unroll
            for (int mh = 0; mh < 2; ++mh) {
                u32x4 g[2][2];
#pragma unroll
                for (int m2 = 0; m2 < 2; ++m2)
#pragma unroll
                    for (int bj = 0; bj < 2; ++bj) g[m2][bj] = *(const u32x4*)(RA + (size_t)(row0 + ai * HALF + (2 * mh + m2) * 16) * DM + col + bj * HALF);
#pragma unroll
                for (int m2 = 0; m2 < 2; ++m2) { const int m = 2 * mh + m2;
#pragma unroll
                    for (int bj = 0; bj < 2; ++bj) { const u32x4 gg = g[m2][bj];
                        const f32x4 g0 = {bflo(gg.x), bfhi(gg.x), bflo(gg.y), bfhi(gg.y)}, g1 = {bflo(gg.z), bfhi(gg.z), bflo(gg.w), bfhi(gg.w)};
                        acc[ai][bj][m][0] = acc[ai][bj][m][0] * g0; acc[ai][bj][m][1] = acc[ai][bj][m][1] * g1; } }
                asm volatile("" ::: "memory"); }
    }
};
struct EpiP6 {
    static constexpr bool PERM = true, AFTER_DRAIN = false, KEEPS = false;
    const float* ssq; bf16_t* H;
    __device__ __forceinline__ bool keep(const Unit&) const { return false; }
    __device__ __forceinline__ void operator()(f32x4 (&acc)[2][2][4][2], const Unit& u, int wr, int wc, int fr, int fq) const {
        int row0 = u.pm * BM + wr * 64 + fr; asm volatile("" : "+v"(row0)); const int col = u.pn * 128 + wc * 32 + 8 * fq;
        float rs[2][4]; rstd8(ssq, row0, rs);
#pragma unroll
        for (int ai = 0; ai < 2; ++ai)
#pragma unroll
            for (int m = 0; m < 4; ++m) { const int row = row0 + ai * HALF + m * 16; const float r = rs[ai][m];
                f32x4 h[2];
#pragma unroll
                for (int n = 0; n < 2; ++n)
#pragma unroll
                    for (int i = 0; i < 4; ++i) { const float g = acc[ai][0][m][n][i] * r, uu = acc[ai][1][m][n][i] * r;
                        h[n][i] = g * uu * __builtin_amdgcn_rcpf(1.0f + fast_exp(-g)); }
                *(u32x4*)(H + (size_t)row * DFF + col) = pack8(h[0], h[1]); }
    }
};
struct EpiRes {
    static constexpr bool PERM = true, AFTER_DRAIN = true, KEEPS = false;
    bf16_t* XB; float* Xf; float* ssq; bool fin;
    __device__ __forceinline__ bool keep(const Unit&) const { return false; }
    __device__ __forceinline__ void fused(f32x4 (&acc)[2][2][4][2], const Unit& u, int wr, int wc, int fr, int fq, LAS unsigned char* lds, int wid, int lane) const {
        LAS float* P = (LAS float*)lds;
        int row0 = u.pm * BM + wr * 64 + fr; asm volatile("" : "+v"(row0));
        const int col = u.pn * BM + wc * 32 + 8 * fq;
#pragma unroll
        for (int ai = 0; ai < 2; ++ai)
#pragma unroll
            for (int mh = 0; mh < 2; ++mh) {
                u32x4 g[2][2];
#pragma unroll
                for (int m2 = 0; m2 < 2; ++m2)
#pragma unroll
                    for (int bj = 0; bj < 2; ++bj) g[m2][bj] = *(const u32x4*)(XB + (size_t)(row0 + ai * HALF + (2 * mh + m2) * 16) * DM + col + bj * HALF);
#pragma unroll
                for (int m2 = 0; m2 < 2; ++m2) { const int m = 2 * mh + m2; const size_t off = (size_t)(row0 + ai * HALF + m * 16) * DM + col;
                    float ss = 0.f;
#pragma unroll
                    for (int bj = 0; bj < 2; ++bj) { const u32x4 gg = g[m2][bj];
                        const f32x4 x0 = (f32x4){bflo(gg.x), bfhi(gg.x), bflo(gg.y), bfhi(gg.y)} + acc[ai][bj][m][0], x1 = (f32x4){bflo(gg.z), bfhi(gg.z), bflo(gg.w), bfhi(gg.w)} + acc[ai][bj][m][1];
                        ss += ((x0[0] * x0[0] + x0[1] * x0[1]) + (x0[2] * x0[2] + x0[3] * x0[3])) + ((x1[0] * x1[0] + x1[1] * x1[1]) + (x1[2] * x1[2] + x1[3] * x1[3]));
                        if (fin) { *(f32x4*)(Xf + off + bj * HALF) = x0; *(f32x4*)(Xf + off + bj * HALF + 4) = x1; }
                        else *(u32x4*)(XB + off + bj * HALF) = pack8(x0, x1); }
                    ss += __shfl_xor(ss, 16); ss += __shfl_xor(ss, 32);
                    if (fq == 0) P[(ai * HALF + wr * 64 + m * 16 + fr) * 4 + wc] = ss; }
                asm volatile("" ::: "memory"); }
        asm volatile("s_waitcnt lgkmcnt(0)" ::: "memory"); __builtin_amdgcn_s_barrier(); asm volatile("" ::: "memory");
        const int t = wid * 64 + lane;
        if (t < 256) { const f32x4 p = *(const LAS f32x4*)(P + t * 4); ssq[(size_t)(u.pm * BM + t) * 4 + u.pn] = (p.x + p.y) + (p.z + p.w); }
        asm volatile("s_waitcnt lgkmcnt(0)" ::: "memory"); __builtin_amdgcn_s_barrier(); asm volatile("" ::: "memory");
    }
};
}

struct Frame {
    LAS unsigned char* lds;
    volatile LAS unsigned* MISC;
    int tid, lane, wave, vcu, G, bx;
};
__device__ __forceinline__ Frame make_frame(LAS unsigned char* lds) {
    Frame F; int tid = threadIdx.x, bx = blockIdx.x, G = gridDim.x;
    asm volatile("" : "+v"(tid), "+s"(bx), "+s"(G));
    F.lds = lds; F.MISC = (volatile LAS unsigned*)(lds + MISC_OFF);
    F.tid = tid; F.lane = tid & 63; F.wave = __builtin_amdgcn_readfirstlane(tid >> 6);
    F.G = G; F.bx = bx; F.vcu = (G % 8 == 0) ? (bx % 8) * (G / 8) + bx / 8 : bx;
    return F;
}
struct Args { const float* in[20]; float* out; unsigned char* ws; int ph_lo, ph_hi; };
#define CAS __attribute__((address_space(4)))
typedef const CAS Args* KArgs;
__device__ __forceinline__ KArgs kargs() { KArgs p = (KArgs)__builtin_amdgcn_kernarg_segment_ptr(); asm volatile("" : "+s"(p)); return p; }
enum { I_X = 0, I_LN1 = 1, I_WIN = 2, I_CAW = 3, I_CBW = 4, I_CBB = 5, I_LWA = 6, I_LBA = 7, I_LWX = 8, I_LBX = 9, I_LAM = 10, I_WOA = 11, I_WOB = 12, I_GB = 13, I_WO = 14, I_LN2 = 15, I_WG = 16, I_WU = 17, I_WD = 18, I_FG = 19 };

__device__ __forceinline__ float wave_sum(float v) {
#pragma unroll
    for (int o = 1; o < 64; o <<= 1) v += __shfl_xor(v, o);
    return v;
}

__device__ __forceinline__ void tr_item(const float* W, int K, int N, bf16_t* WT, int drow, const float* gk, LAS float* scr, int k0, int n0, int lane) {
    const int ks = lane >> 3, nq = lane & 7;
    f32x4 v[8];
#pragma unroll
    for (int i = 0; i < 8; ++i) v[i] = *(const f32x4*)(W + (size_t)(k0 + 8 * i + ks) * N + n0 + 4 * nq);
#pragma unroll
    for (int i = 0; i < 8; ++i) { const int kk = 8 * i + ks; const float sc = gk ? gk[k0 + kk] : 1.0f; LAS float* d = scr + kk * 33 + 4 * nq;
        d[0] = v[i].x * sc; d[1] = v[i].y * sc; d[2] = v[i].z * sc; d[3] = v[i].w * sc; }
    LDS_WAIT(); asm volatile("" ::: "memory");
    const int c = lane & 7;
#pragma unroll
    for (int j = 0; j < 4; ++j) { const int n = (lane >> 3) + 8 * j; const LAS float* s = scr + (8 * c) * 33 + n;
        u32x4 o; o.x = pk2(s[0 * 33], s[1 * 33]); o.y = pk2(s[2 * 33], s[3 * 33]); o.z = pk2(s[4 * 33], s[5 * 33]); o.w = pk2(s[6 * 33], s[7 * 33]);
        *(GAS u32x4*)(WT + (size_t)(drow + n) * K + k0 + 8 * c) = o; }
    LDS_WAIT(); asm volatile("" ::: "memory");
}
__device__ __forceinline__ int win_row(int n0) {
    const int seg = n0 >> 10, o = n0 & 1023, j = o >> 7, i = o & 127;
    switch (seg) {
        case 0: return o;
        case 1: return 1024 + 256 * j + i;
        case 2: return 1024 + 256 * j + 128 + i;
        case 3: return 3072 + o;
        case 4: return 4096 + o;
        case 5: return ROW_GG + 256 * j + i;
        default: return ROW_GG + 256 * j + 128 + i;
    }
}
__device__ __forceinline__ void p0_weights(Frame& F, int l) {
    KArgs a = kargs();
    unsigned char* ws = a->ws;
    LAS float* scr = (LAS float*)(F.lds + F.wave * 16384);
    const int gw = F.vcu * NWAVES + F.wave, NGW = F.G * NWAVES;
    constexpr int I_IN = (DM / 64) * (NIN / 32), I_SQ = (DM / 64) * (DM / 32), I_FF = (DM / 64) * (DFF / 32), I_DN = (DFF / 64) * (DM / 32), I_LR = 16 * 2;
    constexpr int NITEMS = I_IN + 3 * I_SQ + 2 * I_FF + I_DN + 2 * I_LR;
    const float* ln1 = a->in[I_LN1] + (size_t)l * DM; const float* ln2 = a->in[I_LN2] + (size_t)l * DM;
    for (int it = gw; it < NITEMS; it += NGW) {
        int r = it;
        if (r < I_IN) { const int nblk = NIN / 32, kb = r / nblk, nb = r % nblk; tr_item(a->in[I_WIN] + (size_t)l * DM * NIN, DM, NIN, (bf16_t*)(ws + WS_WIN), win_row(nb * 32), ln1, scr, kb * 64, nb * 32, F.lane); continue; } r -= I_IN;
        if (r < I_SQ) { const int nblk = DM / 32, kb = r / nblk, nb = r % nblk; tr_item(a->in[I_WOA] + (size_t)l * DM * DM, DM, DM, (bf16_t*)(ws + WS_WOA), nb * 32, nullptr, scr, kb * 64, nb * 32, F.lane); continue; } r -= I_SQ;
        if (r < I_SQ) { const int nblk = DM / 32, kb = r / nblk, nb = r % nblk; tr_item(a->in[I_WOB] + (size_t)l * DM * DM, DM, DM, (bf16_t*)(ws + WS_WOB), nb * 32, nullptr, scr, kb * 64, nb * 32, F.lane); continue; } r -= I_SQ;
        if (r < I_SQ) { const int nblk = DM / 32, kb = r / nblk, nb = r % nblk; tr_item(a->in[I_WO] + (size_t)l * DM * DM, DM, DM, (bf16_t*)(ws + WS_WO), nb * 32, nullptr, scr, kb * 64, nb * 32, F.lane); continue; } r -= I_SQ;
        if (r < I_FF) { const int nblk = DFF / 32, kb = r / nblk, nb = r % nblk, n0 = nb * 32; tr_item(a->in[I_WG] + (size_t)l * DM * DFF, DM, DFF, (bf16_t*)(ws + WS_WGU), 256 * (n0 >> 7) + (n0 & 127), ln2, scr, kb * 64, n0, F.lane); continue; } r -= I_FF;
        if (r < I_FF) { const int nblk = DFF / 32, kb = r / nblk, nb = r % nblk, n0 = nb * 32; tr_item(a->in[I_WU] + (size_t)l * DM * DFF, DM, DFF, (bf16_t*)(ws + WS_WGU), 256 * (n0 >> 7) + 128 + (n0 & 127), ln2, scr, kb * 64, n0, F.lane); continue; } r -= I_FF;
        if (r < I_DN) { const int nblk = DM / 32, kb = r / nblk, nb = r % nblk; tr_item(a->in[I_WD] + (size_t)l * DFF * DM, DFF, DM, (bf16_t*)(ws + WS_WD), nb * 32, nullptr, scr, kb * 64, nb * 32, F.lane); continue; } r -= I_DN;
        if (r < I_LR) { const int h = r >> 1, nb = r & 1; tr_item(a->in[I_LWA] + ((size_t)l * NHEAD + h) * HD * HD, HD, HD, (bf16_t*)(ws + WS_LRU) + (size_t)h * HD * HD, nb * 32, nullptr, scr, 0, nb * 32, F.lane); continue; } r -= I_LR;
        { const int h = r >> 1, nb = r & 1; tr_item(a->in[I_LWX] + ((size_t)l * NHEAD + h) * HD * HD, HD, HD, (bf16_t*)(ws + WS_LRU) + (size_t)(NHEAD + h) * HD * HD, nb * 32, nullptr, scr, 0, nb * 32, F.lane); }
    }
}
__device__ __forceinline__ void p0_x(Frame& F) {
    KArgs a = kargs();
    const int gw = F.vcu * NWAVES + F.wave, NGW = F.G * NWAVES;
    const float* x = a->in[I_X]; bf16_t* XB = (bf16_t*)(a->ws + WS_S0); float* ssq = (float*)(a->ws + WS_SSQ);
    for (int m = gw; m < M; m += NGW) {
        const GAS f32x4* xr = (const GAS f32x4*)(x + (size_t)m * DM) + F.lane;
        f32x4 v[4]; float s = 0.f;
#pragma unroll
        for (int j = 0; j < 4; ++j) { v[j] = xr[64 * j]; s += (v[j].x * v[j].x + v[j].y * v[j].y) + (v[j].z * v[j].z + v[j].w * v[j].w); }
        s = wave_sum(s);
        GAS u32x2* o8 = (GAS u32x2*)(XB + (size_t)m * DM) + F.lane;
#pragma unroll
        for (int j = 0; j < 4; ++j) { u32x2 w; w.x = pk2(v[j].x, v[j].y); w.y = pk2(v[j].z, v[j].w); o8[64 * j] = w; }
        if (F.lane == 0) *(f32x4*)(ssq + (size_t)m * 4) = (f32x4){s, 0.f, 0.f, 0.f};
    }
}
__device__ __forceinline__ void p8_final(Frame& F) {
    KArgs a = kargs();
    const int gw = F.vcu * NWAVES + F.wave, NGW = F.G * NWAVES;
    float* O = a->out; const bf16_t* XB = (const bf16_t*)(a->ws + WS_S0); const float* ssq = (const float*)(a->ws + WS_SSQ); const float* g = a->in[I_FG];
    f32x4 gv[4];
#pragma unroll
    for (int j = 0; j < 2; ++j) { gv[2 * j] = *(const f32x4*)(g + 512 * j + 8 * F.lane); gv[2 * j + 1] = *(const f32x4*)(g + 512 * j + 8 * F.lane + 4); }
    for (int m = gw; m < M; m += NGW) {
        const float r = rstd_of(ssq, m);
#pragma unroll
        for (int j = 0; j < 2; ++j) { const u32x4 w = *(const u32x4*)(XB + (size_t)m * DM + 512 * j + 8 * F.lane);
            const f32x4 x0 = {bflo(w.x), bfhi(w.x), bflo(w.y), bfhi(w.y)}, x1 = {bflo(w.z), bfhi(w.z), bflo(w.w), bfhi(w.w)};
            *(f32x4*)(O + (size_t)m * DM + 512 * j + 8 * F.lane) = x0 * r * gv[2 * j]; *(f32x4*)(O + (size_t)m * DM + 512 * j + 8 * F.lane + 4) = x1 * r * gv[2 * j + 1]; }
    }
}

__device__ __forceinline__ void unpack8(const u32x4 w, float (&f)[8]) { f[0] = bflo(w.x); f[1] = bfhi(w.x); f[2] = bflo(w.y); f[3] = bfhi(w.y); f[4] = bflo(w.z); f[5] = bfhi(w.z); f[6] = bflo(w.w); f[7] = bfhi(w.w); }
template <bool JUNK = false>
__device__ __forceinline__ void p2_mixer_a(Frame& F, int l) {
    KArgs a = kargs();
    bf16_t* BA = (bf16_t*)(a->ws + WS_S1); const bf16_t* V = (const bf16_t*)(a->ws + WS_S2);
    const float* cw = a->in[I_CAW] + (size_t)l * 3 * DM;
    constexpr int RB = 8, NTASK = (M / RB) * (DM / 8);
    for (int task = F.vcu * (NWAVES * 64) + F.tid; task < NTASK; task += F.G * NWAVES * 64) {
        const int cg = task & 127, rb = task >> 7, c0 = cg * 8, t0 = rb * RB;
        const bool first = (t0 % SEQ) == 0;
        u32x4 vr[RB + 2], br[RB];
        vr[0] = first ? (u32x4){0u, 0u, 0u, 0u} : *(const u32x4*)(V + (size_t)(t0 - 2) * DM + c0);
        vr[1] = first ? (u32x4){0u, 0u, 0u, 0u} : *(const u32x4*)(V + (size_t)(t0 - 1) * DM + c0);
#pragma unroll
        for (int r = 0; r < RB; ++r) { vr[r + 2] = *(const u32x4*)(V + (size_t)(t0 + r) * DM + c0); br[r] = *(const u32x4*)(BA + (size_t)(t0 + r) * DM + c0); }
        float w0[8], w1[8], w2[8];
#pragma unroll
        for (int h = 0; h < 2; ++h) { const f32x4 q0 = *(const f32x4*)(cw + c0 + 4 * h), q1 = *(const f32x4*)(cw + DM + c0 + 4 * h), q2 = *(const f32x4*)(cw + 2 * DM + c0 + 4 * h);
#pragma unroll
            for (int i = 0; i < 4; ++i) { w0[4 * h + i] = q0[i]; w1[4 * h + i] = q1[i]; w2[4 * h + i] = q2[i]; } }
        float vm2[8], vm1[8];
        unpack8(vr[0], vm2); unpack8(vr[1], vm1);
#pragma unroll
        for (int r = 0; r < RB; ++r) {
            float v[8], b[8], o[8];
            unpack8(vr[r + 2], v); unpack8(br[r], b);
#pragma unroll
            for (int i = 0; i < 8; ++i) { o[i] = b[i] * (w0[i] * vm2[i] + w1[i] * vm1[i] + w2[i] * v[i]); vm2[i] = vm1[i]; vm1[i] = v[i]; }
            u32x4 w; w.x = pk2(o[0], o[1]); w.y = pk2(o[2], o[3]); w.z = pk2(o[4], o[5]); w.w = pk2(o[6], o[7]);
            *(u32x4*)((JUNK ? (bf16_t*)(a->ws + WS_S5) : BA) + (size_t)(t0 + r) * DM + c0) = w;
        }
    }
}

constexpr int MX_WAVE_BYTES = 12288, MX_UB = 0, MX_SA = 2048, MX_SB = 6144, MX_GT = 10240, MX_WS = 8 * MX_WAVE_BYTES;
template <bool APPLY, bool JUNK = false>
__device__ __forceinline__ void mixer_b(Frame& F, int l) {
    KArgs a = kargs();
    const int lane = F.lane, w = F.wave;
    const bf16_t* XBp = (const bf16_t*)(a->ws + WS_S3); bf16_t* GG = (bf16_t*)(a->ws + WS_S4);
    f32x2* SUM = (f32x2*)(a->ws + WS_SUM); f32x2* SUMG = (f32x2*)(a->ws + WS_SUMG);
    const bf16_t* WaT = (const bf16_t*)(a->ws + WS_LRU); const bf16_t* WxT = WaT + (size_t)NHEAD * HD * HD;
    LAS unsigned char* wl = F.lds + w * MX_WAVE_BYTES;
    LAS float* SA = (LAS float*)(wl + MX_SA); LAS float* SBm = (LAS float*)(wl + MX_SB);
    LAS unsigned short* GT = (LAS unsigned short*)(wl + MX_GT);
    LAS f32x2* WSX = (LAS f32x2*)(F.lds + MX_WS);
    for (int item = F.bx; item < BATCH * NHEAD * 8; item += F.G) {
        const int b = item >> 7, hd = (item >> 3) & 15, g8 = item & 7, span = g8 * 8 + w, chb = hd * HD;
        const int t0 = b * SEQ + span * 128;
        f32x2 pg[7], ps[7];
        if (APPLY) {
#pragma unroll
            for (int j = 0; j < 7; ++j) { pg[j] = (j < g8) ? SUMG[((size_t)(b * 8 + j)) * DM + chb + lane] : (f32x2){1.f, 0.f};
                                          ps[j] = (j < w) ? SUM[((size_t)(b * 64 + g8 * 8 + j)) * DM + chb + lane] : (f32x2){1.f, 0.f}; }
        }
        const int g = lane & 7, tr = lane >> 3, ch0 = chb + 8 * g;
        u32x4 xr[5], gt[2];
#pragma unroll
        for (int k = 0; k < 5; ++k) { const int row = t0 + 2 * tr - 3 + k; xr[k] = (row >= b * SEQ) ? *(const u32x4*)(XBp + (size_t)row * DM + ch0) : (u32x4){0u, 0u, 0u, 0u}; }
        if (APPLY) {
#pragma unroll
            for (int e = 0; e < 2; ++e) gt[e] = *(const u32x4*)(GG + (size_t)(t0 + tr + 8 * e) * DM + ch0);
        }
        float cw[4][8], cb[8];
        { const float* cbw = a->in[I_CBW] + (size_t)l * 4 * DM + ch0; const float* cbb = a->in[I_CBB] + (size_t)l * DM + ch0;
#pragma unroll
          for (int h2 = 0; h2 < 2; ++h2) { const f32x4 bb = *(const f32x4*)(cbb + 4 * h2);
#pragma unroll
              for (int i2 = 0; i2 < 4; ++i2) cb[4 * h2 + i2] = bb[i2];
#pragma unroll
              for (int k = 0; k < 4; ++k) { const f32x4 wk = *(const f32x4*)(cbw + (size_t)k * DM + 4 * h2);
#pragma unroll
                  for (int i2 = 0; i2 < 4; ++i2) cw[k][4 * h2 + i2] = wk[i2]; } } }
        const int cc = lane & 15, kq = lane >> 4;
        bf16x8 bR[4][2], bI[4][2], idf[2];
        float gba[4], gbx[4], gkk[4];
#pragma unroll
        for (int n = 0; n < 4; ++n) { const int e = 16 * n + cc;
#pragma unroll
            for (int s2 = 0; s2 < 2; ++s2) { bR[n][s2] = *(const bf16x8*)(WaT + ((size_t)hd * HD + e) * HD + 32 * s2 + 8 * kq); bI[n][s2] = *(const bf16x8*)(WxT + ((size_t)hd * HD + e) * HD + 32 * s2 + 8 * kq); }
            gba[n] = a->in[I_LBA][(size_t)l * DM + chb + e]; gbx[n] = a->in[I_LBX][(size_t)l * DM + chb + e];
            gkk[n] = -8.0f * log1pf(__expf(-a->in[I_LAM][(size_t)l * DM + chb + e])) * 1.4426950408889634f; }
#pragma unroll
        for (int p2 = 0; p2 < 2; ++p2)
#pragma unroll
            for (int j = 0; j < 8; ++j) idf[p2][j] = (8 * kq + j == 16 * p2 + cc) ? (short)0x3f80 : (short)0;
        float Pw = 1.f, Hw = 0.f;
        if (APPLY) {
#pragma unroll
            for (int j = 0; j < 7; ++j) Hw = pg[j].x * Hw + pg[j].y;
#pragma unroll
            for (int j = 0; j < 7; ++j) Hw = ps[j].x * Hw + ps[j].y;
        }
#pragma unroll 1
        for (int s = 0; s < 8; ++s) {
            const int tb = t0 + 16 * s;
            {
                float u0[8], u1[8];
#pragma unroll
                for (int i2 = 0; i2 < 8; ++i2) { u0[i2] = cb[i2]; u1[i2] = cb[i2]; }
#pragma unroll
                for (int k = 0; k < 5; ++k) { float x[8]; unpack8(xr[k], x);
#pragma unroll
                    for (int i2 = 0; i2 < 8; ++i2) { if (k < 4) u0[i2] += cw[k][i2] * x[i2]; if (k >= 1) u1[i2] += cw[k - 1][i2] * x[i2]; } }
                const int tk0 = 2 * tr, tk1 = 2 * tr + 1;
                u32x4 p0, p1; p0.x = pk2(u0[0], u0[1]); p0.y = pk2(u0[2], u0[3]); p0.z = pk2(u0[4], u0[5]); p0.w = pk2(u0[6], u0[7]);
                p1.x = pk2(u1[0], u1[1]); p1.y = pk2(u1[2], u1[3]); p1.z = pk2(u1[4], u1[5]); p1.w = pk2(u1[6], u1[7]);
                *(LAS u32x4*)(wl + MX_UB + tk0 * 128 + ((g ^ (tk0 & 7)) * 16)) = p0;
                *(LAS u32x4*)(wl + MX_UB + tk1 * 128 + ((g ^ (tk1 & 7)) * 16)) = p1;
                if (APPLY) {
#pragma unroll
                    for (int e = 0; e < 2; ++e) *(LAS u32x4*)(wl + MX_GT + (tr + 8 * e) * 128 + g * 16) = gt[e];
                }
            }
            if (s < 7) {
#pragma unroll
                for (int k = 0; k < 5; ++k) xr[k] = *(const u32x4*)(XBp + (size_t)(tb + 16 + 2 * tr - 3 + k) * DM + ch0);
                if (APPLY) {
#pragma unroll
                    for (int e = 0; e < 2; ++e) gt[e] = *(const u32x4*)(GG + (size_t)(tb + 16 + tr + 8 * e) * DM + ch0);
                }
            }
            LDS_WAIT(); asm volatile("" ::: "memory");
            {
                bf16x8 Af[2];
#pragma unroll
                for (int s2 = 0; s2 < 2; ++s2) Af[s2] = *(const LAS bf16x8*)(wl + MX_UB + cc * 128 + (((4 * s2 + kq) ^ (cc & 7)) * 16));
#pragma unroll
                for (int n = 0; n < 4; ++n) {
                    f32x4 aR = {0.f, 0.f, 0.f, 0.f}, aI = {0.f, 0.f, 0.f, 0.f}, aU = {0.f, 0.f, 0.f, 0.f};
#pragma unroll
                    for (int s2 = 0; s2 < 2; ++s2) { aR = __builtin_amdgcn_mfma_f32_16x16x32_bf16(Af[s2], bR[n][s2], aR, 0, 0, 0); aI = __builtin_amdgcn_mfma_f32_16x16x32_bf16(Af[s2], bI[n][s2], aI, 0, 0, 0); }
                    aU = __builtin_amdgcn_mfma_f32_16x16x32_bf16(Af[n >> 1], idf[n & 1], aU, 0, 0, 0);
#pragma unroll
                    for (int r = 0; r < 4; ++r) {
                        const float rg = fast_sigmoid(aR[r] + gba[n]), ig = fast_sigmoid(aI[r] + gbx[n]);
                        const float av = __builtin_amdgcn_exp2f(rg * gkk[n]);
                        const float bv = __builtin_amdgcn_sqrtf(fmaxf(1.0f - av * av, 0.f)) * (ig * aU[r]);
                        const int tok = 4 * kq + r;
                        SA[tok * 64 + 16 * n + cc] = av; SBm[tok * 64 + 16 * n + cc] = bv;
                    }
                }
            }
            LDS_WAIT(); asm volatile("" ::: "memory");
            if (!APPLY) {
#pragma unroll
                for (int t = 0; t < 16; ++t) { const float av = SA[t * 64 + lane], bv = SBm[t * 64 + lane]; Hw = av * Hw + bv; Pw *= av; }
            } else {
#pragma unroll
                for (int t = 0; t < 16; ++t) { const float av = SA[t * 64 + lane], bv = SBm[t * 64 + lane]; Hw = av * Hw + bv;
                    const float gv = __builtin_bit_cast(float, (unsigned)GT[t * 64 + lane] << 16);
                    GT[t * 64 + lane] = (unsigned short)f2bf(Hw * gv); }
                LDS_WAIT(); asm volatile("" ::: "memory");
#pragma unroll
                for (int e = 0; e < 2; ++e) { const u32x4 o = *(const LAS u32x4*)(wl + MX_GT + (tr + 8 * e) * 128 + g * 16);
                    *(u32x4*)((JUNK ? (bf16_t*)(a->ws + WS_S5) : GG) + (size_t)(tb + tr + 8 * e) * DM + ch0) = o; }
            }
        }
        if (!APPLY) {
            SUM[((size_t)(b * 64 + span)) * DM + chb + lane] = (f32x2){Pw, Hw};
            WSX[w * 64 + lane] = (f32x2){Pw, Hw};
            LDS_WAIT(); __syncthreads();
            if (w == 0) { float Pu = 1.f, Hu = 0.f;
#pragma unroll
                for (int j = 0; j < 8; ++j) { const f32x2 sj = WSX[j * 64 + lane]; Hu = sj.x * Hu + sj.y; Pu *= sj.x; }
                SUMG[((size_t)(b * 8 + g8)) * DM + chb + lane] = (f32x2){Pu, Hu}; }
            LDS_WAIT(); __syncthreads();
        }
    }
}

constexpr int N_PHASES = 8 * DEPTH + 1;
__global__ void __launch_bounds__(NWAVES * 64, 2) fwd_kernel(Args args_unused) {
    extern __shared__ __attribute__((aligned(16))) unsigned char lds[];
    LAS unsigned char* const ldsb = (LAS unsigned char*)lds;
    for (int u = threadIdx.x; u < (LDS_BYTES - LDSCTL_OFF) / 4; u += NWAVES * 64) ((LAS unsigned*)(ldsb + LDSCTL_OFF))[u] = 0u;
    __syncthreads();
    int lo, hi;
    { KArgs a = kargs(); lo = a->ph_lo; hi = a->ph_hi;
      if (hi - lo > 1) (void)xcd_barrier_post((unsigned*)(a->ws + WS_CTL) + CW_BAR, (volatile LAS unsigned*)(ldsb + MISC_OFF) + 8); }
#define IN(k) (lo <= (k) && (k) < hi)
#define SEAM(k) do { if (IN(k) && IN((k) + 1)) { XcdBarrier b_; b_.bar = (unsigned*)(kargs()->ws + WS_CTL) + CW_BAR; b_.x = xb_xcc_id(); b_.st = (volatile LAS unsigned*)(ldsb + MISC_OFF) + 8; xcd_barrier(b_); } } while (0)
    constexpr size_t TS1 = (size_t)256 * DM * 2, TSF = (size_t)256 * DFF * 2;

#pragma unroll 1
    for (int l = 0; l < DEPTH; ++l) {
        const int pb = 8 * l;
        if (IN(pb + 0)) { Frame F = make_frame(ldsb); p0_weights(F, l); if (l == 0) p0_x(F); }
        if (PROBE_REPEAT == 0 && IN(pb + 0)) { Frame F = make_frame(ldsb); p0_weights(F, l); if (l == 0) p0_x(F); }
        SEAM(pb + 0);
        if (IN(pb + 1)) {
            Frame F = make_frame(ldsb); KArgs a = kargs(); unsigned char* ws = a->ws;
            pg8::SchedPlain S; S.so.init(M, N1A, F.G, F.bx); S.A0 = (const char*)(ws + WS_S0); S.B0 = (const char*)(ws + WS_WIN); S.tstep = TS1;
            pg8::EpiP1a E{(const float*)(ws + WS_SSQ), (bf16_t*)(ws + WS_S1), (bf16_t*)(ws + WS_S2), (bf16_t*)(ws + WS_S3), (bf16_t*)(ws + WS_S4)};
            pg8::gemm_phase<pg8::EpiP1a, pg8::SchedPlain, true, true>(F.lds, F.tid, DM, S, E);
        }
        if (PROBE_REPEAT == 1 && IN(pb + 1)) {
            Frame F = make_frame(ldsb); KArgs a = kargs(); unsigned char* ws = a->ws;
            pg8::SchedPlain S; S.so.init(M, N1A, F.G, F.bx); S.A0 = (const char*)(ws + WS_S0); S.B0 = (const char*)(ws + WS_WIN); S.tstep = TS1;
            pg8::EpiP1a E{(const float*)(ws + WS_SSQ), (bf16_t*)(ws + WS_S1), (bf16_t*)(ws + WS_S2), (bf16_t*)(ws + WS_S3), (bf16_t*)(ws + WS_S4)};
            pg8::gemm_phase<pg8::EpiP1a, pg8::SchedPlain, true, true>(F.lds, F.tid, DM, S, E);
        }
        SEAM(pb + 1);
        if (IN(pb + 2)) { { Frame F = make_frame(ldsb); p2_mixer_a(F, l); } { Frame F = make_frame(ldsb); mixer_b<false>(F, l); } }
        if (PROBE_REPEAT == 2 && IN(pb + 2)) { __syncthreads(); Frame F = make_frame(ldsb); mixer_b<false>(F, l); }
        SEAM(pb + 2);
        if (IN(pb + 3)) {
            { Frame F = make_frame(ldsb); mixer_b<true>(F, l); }
            __syncthreads();
            Frame F = make_frame(ldsb); KArgs a = kargs(); unsigned char* ws = a->ws;
            pg8::StaticOrder so; so.init(M, DM, F.G, F.bx);
            int pm_ = 0, pn_ = 0; const bool ok_ = so.next(0, pm_, pn_);
            pg8::SchedGG S; S.valid = ok_; S.pm = pm_; S.pn = pn_; S.ws = (const char*)ws;
            pg8::EpiGG E{(const float*)(ws + WS_SSQ), a->in[I_GB] + (size_t)l * 2 * DM, (bf16_t*)(ws + WS_S2), (bf16_t*)(ws + WS_S5)};
            pg8::gemm_phase<pg8::EpiGG, pg8::SchedGG, true, true>(F.lds, F.tid, DM, S, E);
        }
        if (PROBE_REPEAT == 3 && IN(pb + 3)) {
            __syncthreads();
            Frame F = make_frame(ldsb); KArgs a = kargs(); unsigned char* ws = a->ws;
            pg8::StaticOrder so; so.init(M, DM, F.G, F.bx);
            int pm_ = 0, pn_ = 0; const bool ok_ = so.next(0, pm_, pn_);
            pg8::SchedGG S; S.valid = ok_; S.pm = pm_; S.pn = pn_; S.ws = (const char*)ws;
            pg8::EpiGG E{(const float*)(ws + WS_SSQ), a->in[I_GB] + (size_t)l * 2 * DM, (bf16_t*)(ws + WS_S2), (bf16_t*)(ws + WS_S5)};
            pg8::gemm_phase<pg8::EpiGG, pg8::SchedGG, true, true>(F.lds, F.tid, DM, S, E);
        }
        SEAM(pb + 3);
        if (IN(pb + 4)) {
            Frame F = make_frame(ldsb); KArgs a = kargs(); unsigned char* ws = a->ws;
            pg8::StaticOrder so; so.init(M, DM, F.G, F.bx);
            int pm_ = 0, pn_ = 0; const bool ok_ = so.next(0, pm_, pn_);
            pg8::SchedOut S; S.valid = ok_; S.pm = pm_; S.pn = pn_; S.ws = (const char*)ws;
            pg8::EpiOut E{(const bf16_t*)(ws + WS_S2), (const bf16_t*)(ws + WS_S5), (bf16_t*)(ws + WS_S3)};
            pg8::gemm_phase<pg8::EpiOut, pg8::SchedOut, false, true>(F.lds, F.tid, DM, S, E);
        }
        if (PROBE_REPEAT == 4 && IN(pb + 4)) {
            Frame F = make_frame(ldsb); KArgs a = kargs(); unsigned char* ws = a->ws;
            pg8::StaticOrder so; so.init(M, DM, F.G, F.bx);
            int pm_ = 0, pn_ = 0; const bool ok_ = so.next(0, pm_, pn_);
            pg8::SchedOut S; S.valid = ok_; S.pm = pm_; S.pn = pn_; S.ws = (const char*)ws;
            pg8::EpiOut E{(const bf16_t*)(ws + WS_S2), (const bf16_t*)(ws + WS_S5), (bf16_t*)(ws + WS_S3)};
            pg8::gemm_phase<pg8::EpiOut, pg8::SchedOut, false, true>(F.lds, F.tid, DM, S, E);
        }
        SEAM(pb + 4);
        if (IN(pb + 5)) {
            Frame F = make_frame(ldsb); KArgs a = kargs(); unsigned char* ws = a->ws;
            pg8::SchedPlain S; S.so.init(M, DM, F.G, F.bx); S.A0 = (const char*)(ws + WS_S3); S.B0 = (const char*)(ws + WS_WO); S.tstep = TS1;
            pg8::EpiRes E{(bf16_t*)(ws + WS_S0), a->out, (float*)(ws + WS_SSQ), false};
            pg8::gemm_phase<pg8::EpiRes, pg8::SchedPlain, false, true>(F.lds, F.tid, DM, S, E);
        }
        SEAM(pb + 5);
        if (IN(pb + 6)) {
            Frame F = make_frame(ldsb); KArgs a = kargs(); unsigned char* ws = a->ws;
            pg8::SchedPlain S; S.so.init(M, NGU, F.G, F.bx); S.A0 = (const char*)(ws + WS_S0); S.B0 = (const char*)(ws + WS_WGU); S.tstep = TS1;
            pg8::EpiP6 E{(const float*)(ws + WS_SSQ), (bf16_t*)(ws + WS_S1)};
            pg8::gemm_phase<pg8::EpiP6, pg8::SchedPlain, true, true>(F.lds, F.tid, DM, S, E);
        }
        if (PROBE_REPEAT == 6 && IN(pb + 6)) {
            Frame F = make_frame(ldsb); KArgs a = kargs(); unsigned char* ws = a->ws;
            pg8::SchedPlain S; S.so.init(M, NGU, F.G, F.bx); S.A0 = (const char*)(ws + WS_S0); S.B0 = (const char*)(ws + WS_WGU); S.tstep = TS1;
            pg8::EpiP6 E{(const float*)(ws + WS_SSQ), (bf16_t*)(ws + WS_S1)};
            pg8::gemm_phase<pg8::EpiP6, pg8::SchedPlain, true, true>(F.lds, F.tid, DM, S, E);
        }
        SEAM(pb + 6);
        if (IN(pb + 7)) {
            Frame F = make_frame(ldsb); KArgs a = kargs(); unsigned char* ws = a->ws;
            pg8::SchedPlain S; S.so.init(M, DM, F.G, F.bx); S.A0 = (const char*)(ws + WS_S1); S.B0 = (const char*)(ws + WS_WD); S.tstep = TSF;
            pg8::EpiRes E{(bf16_t*)(ws + WS_S0), a->out, (float*)(ws + WS_SSQ), false};
            pg8::gemm_phase<pg8::EpiRes, pg8::SchedPlain, false, true>(F.lds, F.tid, DFF, S, E);
        }
        SEAM(pb + 7);
    }
    if (IN(8 * DEPTH)) { Frame F = make_frame(ldsb); p8_final(F); }
#undef IN
#undef SEAM
}

extern "C" void kernel_launch(void* const* d_in, const int* in_sizes, int n_in, void* d_out, int out_size, void* d_ws, size_t ws_size, hipStream_t stream) {
    static int grid = 0;
    if (grid == 0) {
        if (n_in != 20 || in_sizes[0] != M * DM || out_size != M * DM || ws_size < WS_END) {
            fprintf(stderr, "kernel_launch: unexpected shapes: n_in %d in0 %d out %d ws %zu (need %zu)\n", n_in, n_in > 0 ? in_sizes[0] : -1, out_size, ws_size, (size_t)WS_END); grid = -1; return; }
        int dev = 0, cus = 0, per_cu = 0;
        if (hipGetDevice(&dev) != hipSuccess || hipDeviceGetAttribute(&cus, hipDeviceAttributeMultiprocessorCount, dev) != hipSuccess) { grid = -1; return; }
        if (hipFuncSetAttribute((const void*)fwd_kernel, hipFuncAttributeMaxDynamicSharedMemorySize, LDS_BYTES) != hipSuccess) { fprintf(stderr, "kernel_launch: hipFuncSetAttribute failed\n"); grid = -1; return; }
        if (hipOccupancyMaxActiveBlocksPerMultiprocessor(&per_cu, (const void*)fwd_kernel, NWAVES * 64, LDS_BYTES) != hipSuccess || per_cu < 1)
            fprintf(stderr, "kernel_launch: occupancy query reports %d workgroups per CU\n", per_cu);
        (void)hipGetLastError();
        grid = cus;
        if (grid != 256) fprintf(stderr, "kernel_launch: %d CUs (built for 256)\n", grid);
    }
    if (grid < 0) return;
    (void)hipMemsetAsync((char*)d_ws + WS_CTL, 0, CTL_ZERO_BYTES, stream);
    Args a{};
    for (int i = 0; i < 20; ++i) a.in[i] = (const float*)d_in[i];
    a.out = (float*)d_out; a.ws = (unsigned char*)d_ws;
#if MK_PER_PHASE
    for (int p = 0; p < N_PHASES; ++p) { a.ph_lo = p; a.ph_hi = p + 1; hipLaunchKernelGGL(fwd_kernel, dim3(grid), dim3(NWAVES * 64), LDS_BYTES, stream, a); }
#else
    a.ph_lo = 0; a.ph_hi = N_PHASES;
    hipLaunchKernelGGL(fwd_kernel, dim3(grid), dim3(NWAVES * 64), LDS_BYTES, stream, a);
#endif
}
```

```cpp
#include <hip/hip_runtime.h>
#include <cstdio>
#include <cstdint>

#ifndef PROBE_REPEAT
#define PROBE_REPEAT -1
#endif
#ifndef MK_PER_PHASE
#define MK_PER_PHASE 0
#endif

#define LAS __attribute__((address_space(3)))
#define GAS __attribute__((address_space(1)))
typedef unsigned short bf16_t;
typedef short bf16x8 __attribute__((ext_vector_type(8)));
typedef float f32x4 __attribute__((ext_vector_type(4)));
typedef float f32x2 __attribute__((ext_vector_type(2)));
typedef unsigned u32x4 __attribute__((ext_vector_type(4)));
typedef unsigned u32x2 __attribute__((ext_vector_type(2)));
typedef GAS unsigned gu32;

constexpr int BATCH = 2, SEQ = 8192, DM = 1024, M = BATCH * SEQ, NIN = 7168, DFF = 2816, NGU = 2 * DFF, NHEAD = 16, HD = 64, DEPTH = 2;
constexpr float RMS_EPS = 1e-6f;
constexpr int NWAVES = 8;
constexpr int N1A = 5120;
constexpr int ROW_GG = 5120;

constexpr size_t MiB = 1u << 20;
constexpr size_t WS_CTL = 0, CTL_ZERO_BYTES = 1 * MiB;
constexpr size_t WS_SSQ = 1 * MiB;
constexpr size_t WS_SUM = 2 * MiB;
constexpr size_t WS_LRU = 3 * MiB;
constexpr size_t WS_SUMG = 3 * MiB + 512 * 1024;
constexpr size_t WS_WIN = 4 * MiB, WS_WOA = 18 * MiB, WS_WOB = 20 * MiB, WS_WO = 22 * MiB, WS_WGU = 24 * MiB, WS_WD = 35 * MiB;
constexpr size_t WS_S0 = 48 * MiB, SLOT = 32 * MiB;
constexpr size_t WS_S1 = WS_S0 + SLOT, WS_S2 = WS_S1 + SLOT, WS_S3 = WS_S2 + SLOT, WS_S4 = WS_S3 + SLOT, WS_S5 = WS_S4 + SLOT, WS_END = WS_S5 + SLOT;
static_assert(WS_WD + (size_t)DM * DFF * 2 <= WS_S0 && WS_END <= 256 * MiB, "d_ws map");
constexpr int CW_BAR = 4096;

constexpr int RING_BYTES = 131072;
constexpr int LDSCTL_OFF = RING_BYTES, MISC_OFF = LDSCTL_OFF + 320;
constexpr int RS_OFF = LDSCTL_OFF + 1024;
constexpr int LDS_BYTES = 147456;

#define RLX_AGENT __ATOMIC_RELAXED, __HIP_MEMORY_SCOPE_AGENT
#define LDS_WAIT() asm volatile("s_waitcnt lgkmcnt(0)" ::: "memory")
#define VM_WAIT() asm volatile("s_waitcnt vmcnt(0)" ::: "memory")
__device__ __forceinline__ unsigned f2bf(float f) { unsigned u = __builtin_bit_cast(unsigned, f); return (u + 0x7fffu + ((u >> 16) & 1u)) >> 16; }
__device__ __forceinline__ unsigned cvt_pk_bf16(float lo, float hi) { unsigned r; asm volatile("v_cvt_pk_bf16_f32 %0, %1, %2" : "=v"(r) : "v"(lo), "v"(hi)); return r; }
__device__ __forceinline__ unsigned pk2(float lo, float hi) { unsigned r; asm("v_cvt_pk_bf16_f32 %0, %1, %2" : "=v"(r) : "v"(lo), "v"(hi)); return r; }
__device__ __forceinline__ float bflo(unsigned w) { return __builtin_bit_cast(float, w << 16); }
__device__ __forceinline__ float bfhi(unsigned w) { return __builtin_bit_cast(float, w & 0xffff0000u); }
__device__ __forceinline__ float fast_exp(float x) { return __builtin_amdgcn_exp2f(x * 1.4426950408889634f); }
__device__ __forceinline__ float fast_sigmoid(float x) { return __builtin_amdgcn_rcpf(1.0f + fast_exp(-x)); }
__device__ __forceinline__ float gelu_tanh(float x) {
    const float z = 1.5957691216057308f * (x + 0.044715f * x * x * x);
    return x * __builtin_amdgcn_rcpf(1.0f + fast_exp(-z));
}
template <int XM> __device__ __forceinline__ float add_xor(float v) { return v + __builtin_bit_cast(float, __builtin_amdgcn_ds_swizzle(__builtin_bit_cast(int, v), (XM << 10) | 0x1F)); }
__device__ __forceinline__ float add_xor32(float v, int lane) { return v + __builtin_bit_cast(float, __builtin_amdgcn_ds_bpermute((lane ^ 32) << 2, __builtin_bit_cast(int, v))); }
__device__ __forceinline__ float rstd_of(const float* ssq, int row) {
    const f32x4 s = *(const f32x4*)(ssq + (size_t)row * 4);
    return __builtin_amdgcn_rsqf(((s.x + s.y) + (s.z + s.w)) * (1.0f / DM) + RMS_EPS);
}

#define XB_TMO      128
#define XB_XCNT(j)  (256  + 64 * (j))
#define XB_XSUB(j)  (1280 + 64 * (j))
#define XB_XGEN(j)  (2304 + 64 * (j))
#define XB_TOP      3328
#define XB_TOPGEN   3392
#define XCD_BAR_WORDS 3456
#define XB_SPIN_CAP (1u << 22)
__device__ __forceinline__ unsigned xb_ld(unsigned* p)              { return __hip_atomic_load(p, __ATOMIC_RELAXED, __HIP_MEMORY_SCOPE_AGENT); }
__device__ __forceinline__ unsigned xb_add(unsigned* p, unsigned v) { return __hip_atomic_fetch_add(p, v, __ATOMIC_RELAXED, __HIP_MEMORY_SCOPE_AGENT); }
__device__ __forceinline__ unsigned xb_xcc_id() { return (unsigned)__builtin_amdgcn_s_getreg((3 << 11) | 20) & 0xFu; }
#define XB_SPIN(cond, bar) do { unsigned _sp = 0; while (cond) { __builtin_amdgcn_s_sleep(1); \
    if ((++_sp & 255u) == 0u) { if (xb_ld(&(bar)[XB_TMO])) break; if (_sp > XB_SPIN_CAP) { atomicAdd(&(bar)[XB_TMO], 1u); break; } } } } while (0)
struct XcdBarrier { unsigned* bar; unsigned x; volatile LAS unsigned* st; };
__device__ __forceinline__ XcdBarrier xcd_barrier_post(unsigned* bar, volatile LAS unsigned* st) {
    XcdBarrier b; b.bar = bar; b.x = xb_xcc_id(); b.st = st;
    if (threadIdx.x == 0) (void)xb_add(&bar[XB_XCNT(b.x)], 1u);
    return b;
}
__device__ __forceinline__ void xcd_barrier_complete(unsigned* bar, unsigned x, unsigned& nloc, unsigned& nx) {
    const unsigned G = gridDim.x * gridDim.y * gridDim.z;
    unsigned sum, cnt, mine, sp = 0u;
    for (;;) {
        sum = 0u; cnt = 0u; mine = 0u;
#pragma unroll
        for (unsigned j = 0; j < 16; ++j) { const unsigned c = xb_ld(&bar[XB_XCNT(j)]); sum += c; cnt += (c > 0u) ? 1u : 0u; mine = (j == x) ? c : mine; }
        if (sum == G) break;
        __builtin_amdgcn_s_sleep(1);
        if ((++sp & 255u) == 0u) { if (xb_ld(&bar[XB_TMO])) break; if (sp > XB_SPIN_CAP) { atomicAdd(&bar[XB_TMO], 1u); break; } }
    }
    nloc = mine > 0u ? mine : 1u; nx = cnt > 0u ? cnt : 1u;
}
__device__ __forceinline__ void xcd_barrier(const XcdBarrier& b) {
    asm volatile("s_waitcnt vmcnt(0)" ::: "memory");
    __syncthreads();
    if (threadIdx.x == 0) {
        unsigned* bar = b.bar;
        __builtin_amdgcn_s_waitcnt(0);
        unsigned nloc = b.st[0], nx = b.st[1];
        if (nloc == 0u) { xcd_barrier_complete(bar, b.x, nloc, nx); b.st[0] = nloc; b.st[1] = nx; }
        const unsigned old = xb_add(&bar[XB_XSUB(b.x)], 1u);
        const unsigned gen = old / nloc;
        if (old + 1u == (gen + 1u) * nloc) {
            __builtin_amdgcn_fence(__ATOMIC_RELEASE, "agent");
            asm volatile("s_waitcnt vmcnt(0)" ::: "memory");
            const unsigned og = xb_add(&bar[XB_TOP], 1u);
            const unsigned tg = og / nx;
            if (og + 1u == (tg + 1u) * nx) xb_add(&bar[XB_TOPGEN], 1u);
            else XB_SPIN(xb_ld(&bar[XB_TOPGEN]) == tg, bar);
            __builtin_amdgcn_fence(__ATOMIC_ACQUIRE, "agent");
            xb_add(&bar[XB_XGEN(b.x)], 1u);
            asm volatile("s_waitcnt vmcnt(0)" ::: "memory");
        } else {
            XB_SPIN(xb_ld(&bar[XB_XGEN(b.x)]) == gen, bar);
            __builtin_amdgcn_fence(__ATOMIC_ACQUIRE, "agent");
            asm volatile("s_waitcnt vmcnt(0)" ::: "memory");
        }
    }
    __syncthreads();
}

namespace pg8 {
constexpr int BM = 256, BK = 64, HALF = 128, HTB = HALF * BK * 2, NXCD = 8, WGM = 8;
__host__ __device__ __forceinline__ int lds_byte(int r, int c) { const int st = (r >> 4) * 2 + (c >> 5), rr = r & 15, cc = c & 31, ob = rr * 64 + cc * 2; return st * 1024 + (ob ^ (((ob >> 9) & 1) << 5)); }
__host__ __device__ __forceinline__ void stage_rc(int b, int& R, int& C) { const int st = b / 1024, sb = b % 1024, swz = sb ^ (((sb >> 9) & 1) << 5); R = (st >> 1) * 16 + swz / 64; C = (st & 1) * 32 + (swz % 64) / 2; }
__host__ __device__ __forceinline__ int perm32(int rho) { const int n = rho >> 4, i = rho & 15; return 8 * (i >> 2) + 4 * n + (i & 3); }

struct Unit { int pm, pn, kind; };

struct StaticOrder {
    int nM, nN, nwg, G, c;
    __device__ __forceinline__ void init(int M_, int N_, int G_, int c_) { nM = M_ / BM; nN = N_ / BM; nwg = nM * nN; G = G_; c = c_; }
    __device__ __forceinline__ bool next(int i, int& pm, int& pn) const {
        const long L = (long)i * G + c; if (L >= nwg) return false;
        int wgid = (int)L; { const int q = nwg / NXCD, r = nwg % NXCD, xcd = wgid % NXCD, off = wgid / NXCD; wgid = (xcd < r ? xcd * (q + 1) : r * (q + 1) + (xcd - r) * q) + off; }
        const int nig = WGM * nN, gid = wgid / nig, fm = gid * WGM, gsz = (nM - fm) < WGM ? (nM - fm) : WGM;
        pm = fm + ((wgid % nig) % gsz); pn = (wgid % nig) / gsz; return true;
    }
};
struct SchedPlain {
    StaticOrder so; const char* A0; const char* B0; size_t tstep;
    __device__ __forceinline__ bool next(int i, Unit& u) const { int pm_ = 0, pn_ = 0; const bool ok_ = so.next(i, pm_, pn_); u.pm = pm_; u.pn = pn_; u.kind = 0; return ok_; }
    __device__ __forceinline__ const char* a_ptr(const Unit& u) const { return A0 + (size_t)u.pm * tstep; }
    __device__ __forceinline__ const char* b_ptr(const Unit& u) const { return B0 + (size_t)u.pn * tstep; }
};
struct SchedGG {
    int pm, pn; bool valid; const char* ws;
    static constexpr size_t TS = (size_t)256 * DM * 2;
    __device__ __forceinline__ bool next(int i, Unit& u) const { if (!valid || i >= 2) return false; u.pm = pm; u.kind = 0; u.pn = 2 * pn + i; return true; }
    __device__ __forceinline__ const char* a_ptr(const Unit& u) const { return ws + WS_S0 + (size_t)u.pm * TS; }
    __device__ __forceinline__ const char* b_ptr(const Unit& u) const { return ws + WS_WIN + (size_t)ROW_GG * DM * 2 + (size_t)u.pn * TS; }
};
struct SchedOut {
    int pm, pn; bool valid; const char* ws;
    static constexpr size_t TS = (size_t)256 * DM * 2;
    __device__ __forceinline__ bool next(int i, Unit& u) const { if (!valid || i >= 2) return false; u.pm = pm; u.kind = i + 1; u.pn = pn; return true; }
    __device__ __forceinline__ const char* a_ptr(const Unit& u) const { return ws + WS_S1 + (size_t)(u.kind == 2) * (WS_S4 - WS_S1) + (size_t)u.pm * TS; }
    __device__ __forceinline__ const char* b_ptr(const Unit& u) const { return ws + WS_WOA + (size_t)(u.kind == 2) * (WS_WOB - WS_WOA) + (size_t)u.pn * TS; }
};

template <class Epi, class Sched, bool ALIGN_EPI, bool SP2>
__device__ __forceinline__ void gemm_phase(LAS unsigned char* lds, const int tid, const int K, const Sched& S, const Epi& E) {
    const int wid = __builtin_amdgcn_readfirstlane(tid >> 6), lane = tid & 63, wr = wid >> 2, wc = wid & 3, fr = lane & 15, fq = lane >> 4;
    const int nt = K / BK;
    unsigned voffA[2], voffB[2];
#pragma unroll
    for (int i = 0; i < 2; ++i) { int R, C; stage_rc(tid * 16 + i * 8192, R, C); const int Rb = Epi::PERM ? ((R & ~31) + perm32(R & 31)) : R;
        voffA[i] = (unsigned)(R * K + C) * 2u; voffB[i] = (unsigned)(Rb * K + C) * 2u; }
    const size_t kstep = (size_t)(BK * 2);
    const size_t hstep = (size_t)HALF * K * 2;
    const unsigned ldsw = (unsigned)wid * 1024u;
    const int aoff = lds_byte(wr * 64 + fr, fq * 8), boff = lds_byte(wc * 32 + fr, fq * 8);
#define PG8_SA(b, h) (((b) * 2 + (h)) * HTB)
#define PG8_SB(b, h) ((4 + (b) * 2 + (h)) * HTB)
#define PG8_STAGE(bufoff, gbase, voff) do { _Pragma("unroll") for (int _i = 0; _i < 2; ++_i) \
        __builtin_amdgcn_global_load_lds((const unsigned*)((const char*)(gbase) + (voff)[_i]), (LAS unsigned*)(lds + (bufoff) + ldsw + _i * 8192), 16, 0, 0); } while (0)
#define PG8_LDA(dst, b, h) do { _Pragma("unroll") for (int m = 0; m < 4; ++m) _Pragma("unroll") for (int k = 0; k < 2; ++k) dst[m][k] = *(const LAS bf16x8*)(lds + PG8_SA(b, h) + aoff + m * 2048 + k * 1024); } while (0)
#define PG8_LDB(dst, b, h) do { _Pragma("unroll") for (int n = 0; n < 2; ++n) _Pragma("unroll") for (int k = 0; k < 2; ++k) dst[n][k] = *(const LAS bf16x8*)(lds + PG8_SB(b, h) + boff + n * 2048 + k * 1024); } while (0)
#define PG8_MMA(ai, bj, At, Bt) do { __builtin_amdgcn_s_setprio(1); _Pragma("unroll") for (int m = 0; m < 4; ++m) _Pragma("unroll") for (int n = 0; n < 2; ++n) _Pragma("unroll") for (int k = 0; k < 2; ++k) \
        acc[ai][bj][m][n] = __builtin_amdgcn_mfma_f32_16x16x32_bf16(Bt[n][k], At[m][k], acc[ai][bj][m][n], 0, 0, 0); __builtin_amdgcn_s_setprio(0); } while (0)
#define PG8_WAIT_V(n) asm volatile("s_waitcnt vmcnt(" #n ")" ::: "memory")
#define PG8_WAIT_V8R do { if (relax == 16) PG8_WAIT_V(24); else if (relax == 8) PG8_WAIT_V(16); else PG8_WAIT_V(8); } while (0)
#define PG8_WAIT_L(n) asm volatile("s_waitcnt lgkmcnt(" #n ")" ::: "memory")
#define PG8_BAR __builtin_amdgcn_s_barrier()
#define PG8_SCHED __builtin_amdgcn_sched_barrier(0)
    Unit cur, nxt; int ui = 0, nst_prev = 0;
    if (!S.next(0, cur)) return;
    LAS float* const RS = (LAS float*)(lds + RS_OFF);
    if constexpr (Epi::NEEDS_RSTD) {
        if (tid < 256) {
#pragma unroll 1
            for (int i = 0; i < 6; ++i) { Unit uu; if (!S.next(i, uu)) break; RS[i * 256 + tid] = rstd_of(E.ssq, uu.pm * BM + tid); }
        }
    }
    f32x4 acc[2][2][4][2];
#pragma unroll
    for (int a = 0; a < 2; ++a)
#pragma unroll
        for (int b = 0; b < 2; ++b)
#pragma unroll
            for (int m = 0; m < 4; ++m)
#pragma unroll
                for (int n = 0; n < 2; ++n) acc[a][b][m][n] = (f32x4){0.f, 0.f, 0.f, 0.f};
    bf16x8 At[4][2], B0[2][2], B1[2][2];
    const char* cA = S.a_ptr(cur); const char* cB = S.b_ptr(cur);
    if constexpr (SP2) {
        PG8_STAGE(PG8_SB(0, 0), cB, voffB); PG8_STAGE(PG8_SB(0, 1), cB + hstep, voffB); PG8_STAGE(PG8_SA(0, 0), cA, voffA); PG8_STAGE(PG8_SA(0, 1), cA + hstep, voffA);
        if (wr == 1) PG8_BAR;
        PG8_WAIT_V(2); PG8_BAR;
        PG8_STAGE(PG8_SB(1, 0), cB + kstep, voffB); PG8_STAGE(PG8_SA(1, 0), cA + kstep, voffA); PG8_STAGE(PG8_SB(1, 1), cB + hstep + kstep, voffB);
        PG8_WAIT_V(6); PG8_BAR;
    } else {
        PG8_STAGE(PG8_SB(0, 0), cB, voffB); PG8_STAGE(PG8_SA(0, 0), cA, voffA); PG8_STAGE(PG8_SB(0, 1), cB + hstep, voffB); PG8_STAGE(PG8_SA(0, 1), cA + hstep, voffA);
        if (wr == 1) PG8_BAR;
        PG8_WAIT_V(4); PG8_BAR;
        PG8_STAGE(PG8_SB(1, 0), cB + kstep, voffB); PG8_STAGE(PG8_SA(1, 0), cA + kstep, voffA); PG8_STAGE(PG8_SB(1, 1), cB + hstep + kstep, voffB);
        PG8_WAIT_V(6); PG8_BAR;
    }
    for (;;) {
        const bool has_next = S.next(ui + 1, nxt);
        const char* nA = has_next ? S.a_ptr(nxt) : cA; const char* nB = has_next ? S.b_ptr(nxt) : cB;
        for (int t = 0; t < nt; t += 2) {
            const bool last = (t == nt - 2);
            const char* a1 = cA + (size_t)(t + 1) * kstep;
            const char* a2 = last ? nA : cA + (size_t)(t + 2) * kstep; const char* b2 = last ? nB : cB + (size_t)(t + 2) * kstep;
            const char* a3 = a2 + kstep; const char* b3 = b2 + kstep;
            if constexpr (SP2) {
            const int relax = (Epi::RELAX && t == 0 && ui > 0) ? nst_prev : 0;
            PG8_LDB(B0, 0, 0); PG8_LDB(B1, 0, 1); PG8_SCHED; PG8_LDA(At, 0, 0); PG8_STAGE(PG8_SA(1, 1), a1 + hstep, voffA);
            PG8_WAIT_V8R; PG8_WAIT_L(0); PG8_BAR; PG8_MMA(0, 0, At, B0); PG8_MMA(0, 1, At, B1); PG8_BAR; PG8_SCHED;
            PG8_LDA(At, 0, 1); PG8_STAGE(PG8_SB(0, 0), b2, voffB); PG8_STAGE(PG8_SB(0, 1), b2 + hstep, voffB); PG8_STAGE(PG8_SA(0, 0), a2, voffA);
            PG8_WAIT_V8R; PG8_WAIT_L(0); PG8_BAR; PG8_MMA(1, 0, At, B0); PG8_MMA(1, 1, At, B1); PG8_BAR; PG8_SCHED;
            PG8_LDB(B0, 1, 0); PG8_LDB(B1, 1, 1); PG8_SCHED; PG8_LDA(At, 1, 0); PG8_STAGE(PG8_SA(0, 1), a2 + hstep, voffA);
            PG8_WAIT_V(8); PG8_WAIT_L(0); PG8_BAR; PG8_MMA(0, 0, At, B0); PG8_MMA(0, 1, At, B1); PG8_BAR; PG8_SCHED;
            PG8_LDA(At, 1, 1); PG8_STAGE(PG8_SB(1, 0), b3, voffB); PG8_STAGE(PG8_SB(1, 1), b3 + hstep, voffB); PG8_STAGE(PG8_SA(1, 0), a3, voffA);
            PG8_WAIT_V(8); PG8_WAIT_L(0); PG8_BAR; PG8_MMA(1, 0, At, B0); PG8_MMA(1, 1, At, B1); PG8_BAR; PG8_SCHED;
            } else {
            PG8_LDB(B0, 0, 0); PG8_SCHED; PG8_LDA(At, 0, 0); PG8_STAGE(PG8_SA(1, 1), a1 + hstep, voffA);
            PG8_WAIT_L(8); PG8_BAR; PG8_WAIT_L(0); PG8_MMA(0, 0, At, B0); PG8_BAR; PG8_SCHED;
            PG8_LDB(B1, 0, 1); PG8_STAGE(PG8_SB(0, 0), b2, voffB);
            PG8_BAR; PG8_WAIT_L(0); PG8_MMA(0, 1, At, B1); PG8_BAR;
            PG8_LDA(At, 0, 1); PG8_STAGE(PG8_SA(0, 0), a2, voffA);
            PG8_BAR; PG8_WAIT_L(0); PG8_MMA(1, 0, At, B0); PG8_BAR; PG8_SCHED;
            PG8_STAGE(PG8_SB(0, 1), b2 + hstep, voffB);
            PG8_WAIT_V(6); PG8_BAR; PG8_MMA(1, 1, At, B1); PG8_BAR;
            PG8_LDB(B0, 1, 0); PG8_SCHED; PG8_LDA(At, 1, 0); PG8_STAGE(PG8_SA(0, 1), a2 + hstep, voffA);
            PG8_WAIT_L(8); PG8_BAR; PG8_WAIT_L(0); PG8_MMA(0, 0, At, B0); PG8_BAR; PG8_SCHED;
            PG8_LDB(B1, 1, 1); PG8_STAGE(PG8_SB(1, 0), b3, voffB);
            PG8_BAR; PG8_WAIT_L(0); PG8_MMA(0, 1, At, B1); PG8_BAR;
            PG8_LDA(At, 1, 1); PG8_STAGE(PG8_SA(1, 0), a3, voffA);
            PG8_BAR; PG8_WAIT_L(0); PG8_MMA(1, 0, At, B0); PG8_BAR; PG8_SCHED;
            PG8_STAGE(PG8_SB(1, 1), b3 + hstep, voffB);
            PG8_WAIT_V(6); PG8_BAR; PG8_MMA(1, 1, At, B1); PG8_BAR;
            }
        }
        if constexpr (ALIGN_EPI) { if (wr == 0) PG8_BAR; }
        if constexpr (!Epi::AFTER_DRAIN) { E(acc, cur, wr, wc, fr, fq, RS + ui * 256); if constexpr (Epi::RELAX) nst_prev = E.nstores(cur); }
        if (!has_next) break;
        if constexpr (Epi::KEEPS) {
            E.rescale(acc, cur, wr, wc, fr, fq);
        } else {
#pragma unroll
            for (int a = 0; a < 2; ++a)
#pragma unroll
                for (int b = 0; b < 2; ++b)
#pragma unroll
                    for (int m = 0; m < 4; ++m)
#pragma unroll
                        for (int n = 0; n < 2; ++n) acc[a][b][m][n] = (f32x4){0.f, 0.f, 0.f, 0.f};
        }
        cur = nxt; cA = nA; cB = nB; ++ui;
        if constexpr (ALIGN_EPI) { if (wr == 1) PG8_BAR; }
    }
    PG8_WAIT_V(0);
    if constexpr (!ALIGN_EPI) { if (wr == 0) PG8_BAR; }
    PG8_BAR;
    if constexpr (Epi::AFTER_DRAIN) { E.fused(acc, cur, wr, wc, fr, fq, lds, wid, lane); }
#undef PG8_SA
#undef PG8_SB
#undef PG8_STAGE
#undef PG8_LDA
#undef PG8_LDB
#undef PG8_MMA
#undef PG8_WAIT_V
#undef PG8_WAIT_V8R
#undef PG8_WAIT_L
#undef PG8_BAR
#undef PG8_SCHED
}

__device__ __forceinline__ void rstd8(const float* ssq, int row0, float (&rs)[2][4]) {
    f32x4 q[2][4];
#pragma unroll
    for (int ai = 0; ai < 2; ++ai)
#pragma unroll
        for (int m = 0; m < 4; ++m) q[ai][m] = *(const f32x4*)(ssq + (size_t)(row0 + ai * HALF + m * 16) * 4);
#pragma unroll
    for (int ai = 0; ai < 2; ++ai)
#pragma unroll
        for (int m = 0; m < 4; ++m) rs[ai][m] = __builtin_amdgcn_rsqf(((q[ai][m].x + q[ai][m].y) + (q[ai][m].z + q[ai][m].w)) * (1.0f / DM) + RMS_EPS);
}
__device__ __forceinline__ u32x4 pack8(const f32x4 a, const f32x4 b) { u32x4 w; w.x = cvt_pk_bf16(a[0], a[1]); w.y = cvt_pk_bf16(a[2], a[3]); w.z = cvt_pk_bf16(b[0], b[1]); w.w = cvt_pk_bf16(b[2], b[3]); return w; }

struct EpiP1a {
    static constexpr bool PERM = true, AFTER_DRAIN = false, KEEPS = false, NEEDS_RSTD = true, RELAX = false;
    const float* ssq; bf16_t *BA, *V, *XBp, *GG;
    __device__ __forceinline__ bool keep(const Unit&) const { return false; }
    __device__ __forceinline__ int nstores(const Unit& u) const { return (u.pn >= 4 && u.pn < 12) ? 8 : 16; }
    __device__ __forceinline__ void operator()(f32x4 (&acc)[2][2][4][2], const Unit& u, int wr, int wc, int fr, int fq, const LAS float* rsu) const {
        int row0 = u.pm * BM + wr * 64 + fr; asm volatile("" : "+v"(row0));
        const int pn = u.pn;
        const LAS float* rsl = rsu + wr * 64 + fr;
        if (pn >= 4 && pn < 12) {
            const int col = (pn - 4) * 128 + wc * 32 + 8 * fq;
#pragma unroll
            for (int ai = 0; ai < 2; ++ai)
#pragma unroll
                for (int m = 0; m < 4; ++m) { const int row = row0 + ai * HALF + m * 16; const float r = rsl[ai * HALF + m * 16], r2 = r * r;
                    const f32x4 v0 = acc[ai][0][m][0] * acc[ai][1][m][0] * r2, v1 = acc[ai][0][m][1] * acc[ai][1][m][1] * r2;
                    *(u32x4*)(V + (size_t)row * DM + col) = pack8(v0, v1); }
        } else {
            bf16_t* O; int colt; bool act = false;
            if (pn < 4) { O = BA; colt = pn * 256; } else if (pn < 16) { O = XBp; colt = (pn - 12) * 256; } else { O = GG; colt = (pn - 16) * 256; act = true; }
            const int col = colt + wc * 32 + 8 * fq;
#pragma unroll
            for (int ai = 0; ai < 2; ++ai)
#pragma unroll
                for (int m = 0; m < 4; ++m) { const int row = row0 + ai * HALF + m * 16; const float r = rsl[ai * HALF + m * 16];
#pragma unroll
                    for (int bj = 0; bj < 2; ++bj) { f32x4 v0 = acc[ai][bj][m][0] * r, v1 = acc[ai][bj][m][1] * r;
                        if (act) {
#pragma unroll
                            for (int i = 0; i < 4; ++i) { v0[i] = gelu_tanh(v0[i]); v1[i] = gelu_tanh(v1[i]); } }
                        *(u32x4*)(O + (size_t)row * DM + col + bj * HALF) = pack8(v0, v1); } }
        }
    }
};
struct EpiGG {
    static constexpr bool PERM = true, AFTER_DRAIN = false, KEEPS = false, NEEDS_RSTD = true, RELAX = false;
    const float* ssq; const float* gbias;
    bf16_t *RA, *SB;
    __device__ __forceinline__ bool keep(const Unit&) const { return false; }
    __device__ __forceinline__ int nstores(const Unit&) const { return 16; }
    __device__ __forceinline__ void operator()(f32x4 (&acc)[2][2][4][2], const Unit& u, int wr, int wc, int fr, int fq, const LAS float* rsu) const {
        int row0 = u.pm * BM + wr * 64 + fr; asm volatile("" : "+v"(row0));
        {
            const int col = u.pn * 128 + wc * 32 + 8 * fq;
#pragma unroll
            for (int ai = 0; ai < 2; ++ai) {
#pragma unroll
                for (int m = 0; m < 4; ++m) { const int row = row0 + ai * HALF + m * 16; const float r = rsu[ai * HALF + wr * 64 + m * 16 + fr];
                    unsigned wra[4], wsb[4];
#pragma unroll
                    for (int n = 0; n < 2; ++n) {
                        const f32x4 ba = *(const f32x4*)(gbias + col + 4 * n), bb = *(const f32x4*)(gbias + DM + col + 4 * n);
                        float ra[4], sb[4];
#pragma unroll
                        for (int i = 0; i < 4; ++i) {
                            float p = acc[ai][0][m][n][i] * r + ba[i], q = acc[ai][1][m][n][i] * r + bb[i];
                            p = fminf(fmaxf(p, -30.f), 30.f); q = fminf(fmaxf(q, -30.f), 30.f);
                            const float ep = 1.0f + fast_exp(-p), eq = 1.0f + fast_exp(-q);
                            ra[i] = eq * __builtin_amdgcn_rcpf(ep); sb[i] = __builtin_amdgcn_rcpf(eq); }
                        wra[2 * n] = cvt_pk_bf16(ra[0], ra[1]); wra[2 * n + 1] = cvt_pk_bf16(ra[2], ra[3]);
                        wsb[2 * n] = cvt_pk_bf16(sb[0], sb[1]); wsb[2 * n + 1] = cvt_pk_bf16(sb[2], sb[3]); }
                    *(u32x4*)(RA + (size_t)row * DM + col) = (u32x4){wra[0], wra[1], wra[2], wra[3]};
                    *(u32x4*)(SB + (size_t)row * DM + col) = (u32x4){wsb[0], wsb[1], wsb[2], wsb[3]}; }
                asm volatile("" ::: "memory"); }
        }
    }
};
struct EpiOut {
    static constexpr bool PERM = true, AFTER_DRAIN = false, KEEPS = true, NEEDS_RSTD = false, RELAX = false;
    const bf16_t *RA, *SB; bf16_t* MG;
    __device__ __forceinline__ bool keep(const Unit& u) const { return u.kind == 1; }
    __device__ __forceinline__ void operator()(f32x4 (&acc)[2][2][4][2], const Unit& u, int wr, int wc, int fr, int fq, const LAS float* rsu) const {
        int row0 = u.pm * BM + wr * 64 + fr; asm volatile("" : "+v"(row0));
        if (u.kind == 2) {
            const int col = u.pn * 256 + wc * 32 + 8 * fq;
#pragma unroll
            for (int ai = 0; ai < 2; ++ai)
#pragma unroll
                for (int mh = 0; mh < 2; ++mh) {
                    u32x4 g[2][2];
#pragma unroll
                    for (int m2 = 0; m2 < 2; ++m2)
#pragma unroll
                        for (int bj = 0; bj < 2; ++bj) g[m2][bj] = *(const u32x4*)(SB + (size_t)(row0 + ai * HALF + (2 * mh + m2) * 16) * DM + col + bj * HALF);
#pragma unroll
                    for (int m2 = 0; m2 < 2; ++m2) { const int m = 2 * mh + m2, row = row0 + ai * HALF + m * 16;
#pragma unroll
                        for (int bj = 0; bj < 2; ++bj) { const u32x4 gg = g[m2][bj];
                            const f32x4 g0 = {bflo(gg.x), bfhi(gg.x), bflo(gg.y), bfhi(gg.y)}, g1 = {bflo(gg.z), bfhi(gg.z), bflo(gg.w), bfhi(gg.w)};
                            *(u32x4*)(MG + (size_t)row * DM + col + bj * HALF) = pack8(acc[ai][bj][m][0] * g0, acc[ai][bj][m][1] * g1); } }
                    asm volatile("" ::: "memory"); }
        }
    }
    __device__ __forceinline__ void rescale(f32x4 (&acc)[2][2][4][2], const Unit& u, int wr, int wc, int fr, int fq) const {
        int row0 = u.pm * BM + wr * 64 + fr; asm volatile("" : "+v"(row0)); const int col = u.pn * 256 + wc * 32 + 8 * fq;
#pragma unroll
        for (int ai = 0; ai < 2; ++ai)
#pragma unroll
            for (int mh = 0; mh < 2; ++mh) {
                u32x4 g[2][2];
#pragma unroll
                for (int m2 = 0; m2 < 2; ++m2)
#pragma unroll
                    for (int bj = 0; bj < 2; ++bj) g[m2][bj] = *(const u32x4*)(RA + (size_t)(row0 + ai * HALF + (2 * mh + m2) * 16) * DM + col + bj * HALF);
#pragma unroll
                for (int m2 = 0; m2 < 2; ++m2) { const int m = 2 * mh + m2;
#pragma unroll
                    for (int bj = 0; bj < 2; ++bj) { const u32x4 gg = g[m2][bj];
                        const f32x4 g0 = {bflo(gg.x), bfhi(gg.x), bflo(gg.y), bfhi(gg.y)}, g1 = {bflo(gg.z), bfhi(gg.z), bflo(gg.w), bfhi(gg.w)};
                        acc[ai][bj][m][0] = acc[ai][bj][m][0] * g0; acc[ai][bj][m][1] = acc[ai][bj][m][1] * g1; } }
                asm volatile("" ::: "memory"); }
    }
};
struct EpiP6 {
    static constexpr bool PERM = true, AFTER_DRAIN = false, KEEPS = false, NEEDS_RSTD = true, RELAX = false;
    const float* ssq; bf16_t* H;
    __device__ __forceinline__ bool keep(const Unit&) const { return false; }
    __device__ __forceinline__ int nstores(const Unit&) const { return 8; }
    __device__ __forceinline__ void operator()(f32x4 (&acc)[2][2][4][2], const Unit& u, int wr, int wc, int fr, int fq, const LAS float* rsu) const {
        int row0 = u.pm * BM + wr * 64 + fr; asm volatile("" : "+v"(row0)); const int col = u.pn * 128 + wc * 32 + 8 * fq;
        const LAS float* rsl = rsu + wr * 64 + fr;
#pragma unroll
        for (int ai = 0; ai < 2; ++ai)
#pragma unroll
            for (int m = 0; m < 4; ++m) { const int row = row0 + ai * HALF + m * 16; const float r = rsl[ai * HALF + m * 16];
                f32x4 h[2];
#pragma unroll
                for (int n = 0; n < 2; ++n)
#pragma unroll
                    for (int i = 0; i < 4; ++i) { const float g = acc[ai][0][m][n][i] * r, uu = acc[ai][1][m][n][i] * r;
                        h[n][i] = g * uu * __builtin_amdgcn_rcpf(1.0f + fast_exp(-g)); }
                *(u32x4*)(H + (size_t)row * DFF + col) = pack8(h[0], h[1]); }
    }
};
struct EpiRes {
    static constexpr bool PERM = true, AFTER_DRAIN = true, KEEPS = false, NEEDS_RSTD = false, RELAX = false;
    bf16_t* XB; float* Xf; float* ssq; bool fin;
    __device__ __forceinline__ bool keep(const Unit&) const { return false; }
    __device__ __forceinline__ void fused(f32x4 (&acc)[2][2][4][2], const Unit& u, int wr, int wc, int fr, int fq, LAS unsigned char* lds, int wid, int lane) const {
        LAS float* P = (LAS float*)lds;
        int row0 = u.pm * BM + wr * 64 + fr; asm volatile("" : "+v"(row0));
        const int col = u.pn * BM + wc * 32 + 8 * fq;
#pragma unroll
        for (int ai = 0; ai < 2; ++ai)
#pragma unroll
            for (int mh = 0; mh < 2; ++mh) {
                u32x4 g[2][2];
#pragma unroll
                for (int m2 = 0; m2 < 2; ++m2)
#pragma unroll
                    for (int bj = 0; bj < 2; ++bj) g[m2][bj] = *(const u32x4*)(XB + (size_t)(row0 + ai * HALF + (2 * mh + m2) * 16) * DM + col + bj * HALF);
#pragma unroll
                for (int m2 = 0; m2 < 2; ++m2) { const int m = 2 * mh + m2; const size_t off = (size_t)(row0 + ai * HALF + m * 16) * DM + col;
                    float ss = 0.f;
#pragma unroll
                    for (int bj = 0; bj < 2; ++bj) { const u32x4 gg = g[m2][bj];
                        const f32x4 x0 = (f32x4){bflo(gg.x), bfhi(gg.x), bflo(gg.y), bfhi(gg.y)} + acc[ai][bj][m][0], x1 = (f32x4){bflo(gg.z), bfhi(gg.z), bflo(gg.w), bfhi(gg.w)} + acc[ai][bj][m][1];
                        ss += ((x0[0] * x0[0] + x0[1] * x0[1]) + (x0[2] * x0[2] + x0[3] * x0[3])) + ((x1[0] * x1[0] + x1[1] * x1[1]) + (x1[2] * x1[2] + x1[3] * x1[3]));
                        if (fin) { *(f32x4*)(Xf + off + bj * HALF) = x0; *(f32x4*)(Xf + off + bj * HALF + 4) = x1; }
                        else *(u32x4*)(XB + off + bj * HALF) = pack8(x0, x1); }
                    ss = add_xor<16>(ss); ss = add_xor32(ss, lane);
                    if (fq == 0) P[(ai * HALF + wr * 64 + m * 16 + fr) * 4 + wc] = ss; }
                asm volatile("" ::: "memory"); }
        asm volatile("s_waitcnt lgkmcnt(0)" ::: "memory"); __builtin_amdgcn_s_barrier(); asm volatile("" ::: "memory");
        const int t = wid * 64 + lane;
        if (t < 256) { const f32x4 p = *(const LAS f32x4*)(P + t * 4); ssq[(size_t)(u.pm * BM + t) * 4 + u.pn] = (p.x + p.y) + (p.z + p.w); }
        asm volatile("s_waitcnt lgkmcnt(0)" ::: "memory"); __builtin_amdgcn_s_barrier(); asm volatile("" ::: "memory");
    }
};
}

struct Frame {
    LAS unsigned char* lds;
    volatile LAS unsigned* MISC;
    int tid, lane, wave, vcu, G, bx;
};
__device__ __forceinline__ Frame make_frame(LAS unsigned char* lds, int wave_s) {
    Frame F; int lane, wv = wave_s, bx = blockIdx.x, G = gridDim.x;
    asm volatile("v_mbcnt_lo_u32_b32 %0, -1, 0\n\tv_mbcnt_hi_u32_b32 %0, -1, %0" : "=v"(lane));
    asm volatile("" : "+s"(wv), "+s"(bx), "+s"(G));
    F.lds = lds; F.MISC = (volatile LAS unsigned*)(lds + MISC_OFF);
    F.tid = wv * 64 + lane; F.lane = lane; F.wave = wv;
    F.G = G; F.bx = bx; F.vcu = (G % 8 == 0) ? (bx % 8) * (G / 8) + bx / 8 : bx;
    return F;
}
struct Args { const float* in[20]; float* out; unsigned char* ws; int ph_lo, ph_hi; };
#define CAS __attribute__((address_space(4)))
typedef const CAS Args* KArgs;
__device__ __forceinline__ KArgs kargs() { KArgs p = (KArgs)__builtin_amdgcn_kernarg_segment_ptr(); asm volatile("" : "+s"(p)); return p; }
enum { I_X = 0, I_LN1 = 1, I_WIN = 2, I_CAW = 3, I_CBW = 4, I_CBB = 5, I_LWA = 6, I_LBA = 7, I_LWX = 8, I_LBX = 9, I_LAM = 10, I_WOA = 11, I_WOB = 12, I_GB = 13, I_WO = 14, I_LN2 = 15, I_WG = 16, I_WU = 17, I_WD = 18, I_FG = 19 };

__device__ __forceinline__ float wave_sum(float v, int lane) {
    v = add_xor<1>(v); v = add_xor<2>(v); v = add_xor<4>(v); v = add_xor<8>(v); v = add_xor<16>(v); v = add_xor32(v, lane);
    return v;
}

__device__ __forceinline__ void tr_item(const float* W, int K, int N, bf16_t* WT, int drow, const float* gk, LAS float* scr, int k0, int n0, int lane) {
    const int ks = lane >> 3, nq = lane & 7;
    f32x4 v[8];
#pragma unroll
    for (int i = 0; i < 8; ++i) v[i] = *(const f32x4*)(W + (size_t)(k0 + 8 * i + ks) * N + n0 + 4 * nq);
#pragma unroll
    for (int i = 0; i < 8; ++i) { const int kk = 8 * i + ks; const float sc = gk ? gk[k0 + kk] : 1.0f; LAS float* d = scr + kk * 33 + 4 * nq;
        d[0] = v[i].x * sc; d[1] = v[i].y * sc; d[2] = v[i].z * sc; d[3] = v[i].w * sc; }
    LDS_WAIT(); asm volatile("" ::: "memory");
    const int c = lane & 7;
#pragma unroll
    for (int j = 0; j < 4; ++j) { const int n = (lane >> 3) + 8 * j; const LAS float* s = scr + (8 * c) * 33 + n;
        u32x4 o; o.x = pk2(s[0 * 33], s[1 * 33]); o.y = pk2(s[2 * 33], s[3 * 33]); o.z = pk2(s[4 * 33], s[5 * 33]); o.w = pk2(s[6 * 33], s[7 * 33]);
        *(GAS u32x4*)(WT + (size_t)(drow + n) * K + k0 + 8 * c) = o; }
    LDS_WAIT(); asm volatile("" ::: "memory");
}
__device__ __forceinline__ int win_row(int n0) {
    const int seg = n0 >> 10, o = n0 & 1023, j = o >> 7, i = o & 127;
    switch (seg) {
        case 0: return o;
        case 1: return 1024 + 256 * j + i;
        case 2: return 1024 + 256 * j + 128 + i;
        case 3: return 3072 + o;
        case 4: return 4096 + o;
        case 5: return ROW_GG + 256 * j + i;
        default: return ROW_GG + 256 * j + 128 + i;
    }
}
__device__ __forceinline__ void p0_weights(Frame& F, int l) {
    KArgs a = kargs();
    unsigned char* ws = a->ws;
    LAS float* scr = (LAS float*)(F.lds + F.wave * 16384);
    const int gw = F.vcu * NWAVES + F.wave, NGW = F.G * NWAVES;
    constexpr int I_IN = (DM / 64) * (NIN / 32), I_SQ = (DM / 64) * (DM / 32), I_FF = (DM / 64) * (DFF / 32), I_DN = (DFF / 64) * (DM / 32), I_LR = 16 * 2;
    constexpr int NITEMS = I_IN + 3 * I_SQ + 2 * I_FF + I_DN + 2 * I_LR;
    const float* ln1 = a->in[I_LN1] + (size_t)l * DM; const float* ln2 = a->in[I_LN2] + (size_t)l * DM;
    for (int it = gw; it < NITEMS; it += NGW) {
        int r = it;
        if (r < I_IN) { const int nblk = NIN / 32, kb = r / nblk, nb = r % nblk; tr_item(a->in[I_WIN] + (size_t)l * DM * NIN, DM, NIN, (bf16_t*)(ws + WS_WIN), win_row(nb * 32), ln1, scr, kb * 64, nb * 32, F.lane); continue; } r -= I_IN;
        if (r < I_SQ) { const int nblk = DM / 32, kb = r / nblk, nb = r % nblk; tr_item(a->in[I_WOA] + (size_t)l * DM * DM, DM, DM, (bf16_t*)(ws + WS_WOA), nb * 32, nullptr, scr, kb * 64, nb * 32, F.lane); continue; } r -= I_SQ;
        if (r < I_SQ) { const int nblk = DM / 32, kb = r / nblk, nb = r % nblk; tr_item(a->in[I_WOB] + (size_t)l * DM * DM, DM, DM, (bf16_t*)(ws + WS_WOB), nb * 32, nullptr, scr, kb * 64, nb * 32, F.lane); continue; } r -= I_SQ;
        if (r < I_SQ) { const int nblk = DM / 32, kb = r / nblk, nb = r % nblk; tr_item(a->in[I_WO] + (size_t)l * DM * DM, DM, DM, (bf16_t*)(ws + WS_WO), nb * 32, nullptr, scr, kb * 64, nb * 32, F.lane); continue; } r -= I_SQ;
        if (r < I_FF) { const int nblk = DFF / 32, kb = r / nblk, nb = r % nblk, n0 = nb * 32; tr_item(a->in[I_WG] + (size_t)l * DM * DFF, DM, DFF, (bf16_t*)(ws + WS_WGU), 256 * (n0 >> 7) + (n0 & 127), ln2, scr, kb * 64, n0, F.lane); continue; } r -= I_FF;
        if (r < I_FF) { const int nblk = DFF / 32, kb = r / nblk, nb = r % nblk, n0 = nb * 32; tr_item(a->in[I_WU] + (size_t)l * DM * DFF, DM, DFF, (bf16_t*)(ws + WS_WGU), 256 * (n0 >> 7) + 128 + (n0 & 127), ln2, scr, kb * 64, n0, F.lane); continue; } r -= I_FF;
        if (r < I_DN) { const int nblk = DM / 32, kb = r / nblk, nb = r % nblk; tr_item(a->in[I_WD] + (size_t)l * DFF * DM, DFF, DM, (bf16_t*)(ws + WS_WD), nb * 32, nullptr, scr, kb * 64, nb * 32, F.lane); continue; } r -= I_DN;
        if (r < I_LR) { const int h = r >> 1, nb = r & 1; tr_item(a->in[I_LWA] + ((size_t)l * NHEAD + h) * HD * HD, HD, HD, (bf16_t*)(ws + WS_LRU) + (size_t)h * HD * HD, nb * 32, nullptr, scr, 0, nb * 32, F.lane); continue; } r -= I_LR;
        { const int h = r >> 1, nb = r & 1; tr_item(a->in[I_LWX] + ((size_t)l * NHEAD + h) * HD * HD, HD, HD, (bf16_t*)(ws + WS_LRU) + (size_t)(NHEAD + h) * HD * HD, nb * 32, nullptr, scr, 0, nb * 32, F.lane); }
    }
}
__device__ __forceinline__ void p0_x(Frame& F) {
    KArgs a = kargs();
    const int gw = F.vcu * NWAVES + F.wave, NGW = F.G * NWAVES;
    const float* x = a->in[I_X]; bf16_t* XB = (bf16_t*)(a->ws + WS_S0); float* ssq = (float*)(a->ws + WS_SSQ);
    for (int m = gw; m < M; m += NGW) {
        const GAS f32x4* xr = (const GAS f32x4*)(x + (size_t)m * DM) + F.lane;
        f32x4 v[4]; float s = 0.f;
#pragma unroll
        for (int j = 0; j < 4; ++j) { v[j] = xr[64 * j]; s += (v[j].x * v[j].x + v[j].y * v[j].y) + (v[j].z * v[j].z + v[j].w * v[j].w); }
        s = wave_sum(s, F.lane);
        GAS u32x2* o8 = (GAS u32x2*)(XB + (size_t)m * DM) + F.lane;
#pragma unroll
        for (int j = 0; j < 4; ++j) { u32x2 w; w.x = pk2(v[j].x, v[j].y); w.y = pk2(v[j].z, v[j].w); o8[64 * j] = w; }
        if (F.lane == 0) *(f32x4*)(ssq + (size_t)m * 4) = (f32x4){s, 0.f, 0.f, 0.f};
    }
}
__device__ __forceinline__ void p8_final(Frame& F) {
    KArgs a = kargs();
    const int gw = F.vcu * NWAVES + F.wave, NGW = F.G * NWAVES;
    float* O = a->out; const bf16_t* XB = (const bf16_t*)(a->ws + WS_S0); const float* ssq = (const float*)(a->ws + WS_SSQ); const float* g = a->in[I_FG];
    f32x4 gv[4];
#pragma unroll
    for (int j = 0; j < 2; ++j) { gv[2 * j] = *(const f32x4*)(g + 512 * j + 8 * F.lane); gv[2 * j + 1] = *(const f32x4*)(g + 512 * j + 8 * F.lane + 4); }
    for (int m = gw; m < M; m += NGW) {
        const float r = rstd_of(ssq, m);
#pragma unroll
        for (int j = 0; j < 2; ++j) { const u32x4 w = *(const u32x4*)(XB + (size_t)m * DM + 512 * j + 8 * F.lane);
            const f32x4 x0 = {bflo(w.x), bfhi(w.x), bflo(w.y), bfhi(w.y)}, x1 = {bflo(w.z), bfhi(w.z), bflo(w.w), bfhi(w.w)};
            *(f32x4*)(O + (size_t)m * DM + 512 * j + 8 * F.lane) = x0 * r * gv[2 * j]; *(f32x4*)(O + (size_t)m * DM + 512 * j + 8 * F.lane + 4) = x1 * r * gv[2 * j + 1]; }
    }
}

__device__ __forceinline__ void unpack8(const u32x4 w, float (&f)[8]) { f[0] = bflo(w.x); f[1] = bfhi(w.x); f[2] = bflo(w.y); f[3] = bfhi(w.y); f[4] = bflo(w.z); f[5] = bfhi(w.z); f[6] = bflo(w.w); f[7] = bfhi(w.w); }
template <bool JUNK = false>
__device__ __forceinline__ void p2_mixer_a(Frame& F, int l) {
    KArgs a = kargs();
    bf16_t* BA = (bf16_t*)(a->ws + WS_S1); const bf16_t* V = (const bf16_t*)(a->ws + WS_S2);
    const float* cw = a->in[I_CAW] + (size_t)l * 3 * DM;
    constexpr int RB = 8, NTASK = (M / RB) * (DM / 8);
    for (int task = F.vcu * (NWAVES * 64) + F.tid; task < NTASK; task += F.G * NWAVES * 64) {
        const int cg = task & 127, rb = task >> 7, c0 = cg * 8, t0 = rb * RB;
        const bool first = (t0 % SEQ) == 0;
        u32x4 vr[RB + 2], br[RB];
        vr[0] = first ? (u32x4){0u, 0u, 0u, 0u} : *(const u32x4*)(V + (size_t)(t0 - 2) * DM + c0);
        vr[1] = first ? (u32x4){0u, 0u, 0u, 0u} : *(const u32x4*)(V + (size_t)(t0 - 1) * DM + c0);
#pragma unroll
        for (int r = 0; r < RB; ++r) { vr[r + 2] = *(const u32x4*)(V + (size_t)(t0 + r) * DM + c0); br[r] = *(const u32x4*)(BA + (size_t)(t0 + r) * DM + c0); }
        float w0[8], w1[8], w2[8];
#pragma unroll
        for (int h = 0; h < 2; ++h) { const f32x4 q0 = *(const f32x4*)(cw + c0 + 4 * h), q1 = *(const f32x4*)(cw + DM + c0 + 4 * h), q2 = *(const f32x4*)(cw + 2 * DM + c0 + 4 * h);
#pragma unroll
            for (int i = 0; i < 4; ++i) { w0[4 * h + i] = q0[i]; w1[4 * h + i] = q1[i]; w2[4 * h + i] = q2[i]; } }
        float vm2[8], vm1[8];
        unpack8(vr[0], vm2); unpack8(vr[1], vm1);
#pragma unroll
        for (int r = 0; r < RB; ++r) {
            float v[8], b[8], o[8];
            unpack8(vr[r + 2], v); unpack8(br[r], b);
#pragma unroll
            for (int i = 0; i < 8; ++i) { o[i] = b[i] * (w0[i] * vm2[i] + w1[i] * vm1[i] + w2[i] * v[i]); vm2[i] = vm1[i]; vm1[i] = v[i]; }
            u32x4 w; w.x = pk2(o[0], o[1]); w.y = pk2(o[2], o[3]); w.z = pk2(o[4], o[5]); w.w = pk2(o[6], o[7]);
            *(u32x4*)((JUNK ? (bf16_t*)(a->ws + WS_S5) : BA) + (size_t)(t0 + r) * DM + c0) = w;
        }
    }
}

constexpr int MX_WAVE_BYTES = 12288, MX_UB = 0, MX_SA = 2048, MX_SB = 6144, MX_GT = 10240, MX_WS = 8 * MX_WAVE_BYTES;
template <bool APPLY, bool JUNK = false>
__device__ __forceinline__ void mixer_b(Frame& F, int l) {
    KArgs a = kargs();
    const int lane = F.lane, w = F.wave;
    const bf16_t* XBp = (const bf16_t*)(a->ws + WS_S3); bf16_t* GG = (bf16_t*)(a->ws + WS_S4);
    f32x2* SUM = (f32x2*)(a->ws + WS_SUM); f32x2* SUMG = (f32x2*)(a->ws + WS_SUMG);
    const bf16_t* WaT = (const bf16_t*)(a->ws + WS_LRU); const bf16_t* WxT = WaT + (size_t)NHEAD * HD * HD;
    LAS unsigned char* wl = F.lds + w * MX_WAVE_BYTES;
    LAS float* SA = (LAS float*)(wl + MX_SA); LAS float* SBm = (LAS float*)(wl + MX_SB);
    LAS unsigned short* GT = (LAS unsigned short*)(wl + MX_GT);
    LAS f32x2* WSX = (LAS f32x2*)(F.lds + MX_WS);
    for (int item = F.bx; item < BATCH * NHEAD * 8; item += F.G) {
        const int b = item >> 7, hd = (item >> 3) & 15, g8 = item & 7, span = g8 * 8 + w, chb = hd * HD;
        const int t0 = b * SEQ + span * 128;
        f32x2 pg[7], ps[7];
        if (APPLY) {
#pragma unroll
            for (int j = 0; j < 7; ++j) { pg[j] = (j < g8) ? SUMG[((size_t)(b * 8 + j)) * DM + chb + lane] : (f32x2){1.f, 0.f};
                                          ps[j] = (j < w) ? SUM[((size_t)(b * 64 + g8 * 8 + j)) * DM + chb + lane] : (f32x2){1.f, 0.f}; }
        }
        const int g = lane & 7, tr = lane >> 3, ch0 = chb + 8 * g;
        u32x4 xr[5], gt[2];
#pragma unroll
        for (int k = 0; k < 5; ++k) { const int row = t0 + 2 * tr - 3 + k; xr[k] = (row >= b * SEQ) ? *(const u32x4*)(XBp + (size_t)row * DM + ch0) : (u32x4){0u, 0u, 0u, 0u}; }
        if (APPLY) {
#pragma unroll
            for (int e = 0; e < 2; ++e) gt[e] = *(const u32x4*)(GG + (size_t)(t0 + tr + 8 * e) * DM + ch0);
        }
        float cw[4][8], cb[8];
        { const float* cbw = a->in[I_CBW] + (size_t)l * 4 * DM + ch0; const float* cbb = a->in[I_CBB] + (size_t)l * DM + ch0;
#pragma unroll
          for (int h2 = 0; h2 < 2; ++h2) { const f32x4 bb = *(const f32x4*)(cbb + 4 * h2);
#pragma unroll
              for (int i2 = 0; i2 < 4; ++i2) cb[4 * h2 + i2] = bb[i2];
#pragma unroll
              for (int k = 0; k < 4; ++k) { const f32x4 wk = *(const f32x4*)(cbw + (size_t)k * DM + 4 * h2);
#pragma unroll
                  for (int i2 = 0; i2 < 4; ++i2) cw[k][4 * h2 + i2] = wk[i2]; } } }
        const int cc = lane & 15, kq = lane >> 4;
        bf16x8 bR[4][2], bI[4][2], idf[2];
        float gba[4], gbx[4], gkk[4];
#pragma unroll
        for (int n = 0; n < 4; ++n) { const int e = 16 * n + cc;
#pragma unroll
            for (int s2 = 0; s2 < 2; ++s2) { bR[n][s2] = *(const bf16x8*)(WaT + ((size_t)hd * HD + e) * HD + 32 * s2 + 8 * kq); bI[n][s2] = *(const bf16x8*)(WxT + ((size_t)hd * HD + e) * HD + 32 * s2 + 8 * kq); }
            gba[n] = a->in[I_LBA][(size_t)l * DM + chb + e]; gbx[n] = a->in[I_LBX][(size_t)l * DM + chb + e];
            gkk[n] = -8.0f * log1pf(__expf(-a->in[I_LAM][(size_t)l * DM + chb + e])) * 1.4426950408889634f; }
#pragma unroll
        for (int p2 = 0; p2 < 2; ++p2)
#pragma unroll
            for (int j = 0; j < 8; ++j) idf[p2][j] = (8 * kq + j == 16 * p2 + cc) ? (short)0x3f80 : (short)0;
        float Pw = 1.f, Hw = 0.f;
        if (APPLY) {
#pragma unroll
            for (int j = 0; j < 7; ++j) Hw = pg[j].x * Hw + pg[j].y;
#pragma unroll
            for (int j = 0; j < 7; ++j) Hw = ps[j].x * Hw + ps[j].y;
        }
#pragma unroll 1
        for (int s = 0; s < 8; ++s) {
            const int tb = t0 + 16 * s;
            {
                float u0[8], u1[8];
#pragma unroll
                for (int i2 = 0; i2 < 8; ++i2) { u0[i2] = cb[i2]; u1[i2] = cb[i2]; }
#pragma unroll
                for (int k = 0; k < 5; ++k) { float x[8]; unpack8(xr[k], x);
#pragma unroll
                    for (int i2 = 0; i2 < 8; ++i2) { if (k < 4) u0[i2] += cw[k][i2] * x[i2]; if (k >= 1) u1[i2] += cw[k - 1][i2] * x[i2]; } }
                const int tk0 = 2 * tr, tk1 = 2 * tr + 1;
                u32x4 p0, p1; p0.x = pk2(u0[0], u0[1]); p0.y = pk2(u0[2], u0[3]); p0.z = pk2(u0[4], u0[5]); p0.w = pk2(u0[6], u0[7]);
                p1.x = pk2(u1[0], u1[1]); p1.y = pk2(u1[2], u1[3]); p1.z = pk2(u1[4], u1[5]); p1.w = pk2(u1[6], u1[7]);
                *(LAS u32x4*)(wl + MX_UB + tk0 * 128 + ((g ^ (tk0 & 7)) * 16)) = p0;
                *(LAS u32x4*)(wl + MX_UB + tk1 * 128 + ((g ^ (tk1 & 7)) * 16)) = p1;
                if (APPLY) {
#pragma unroll
                    for (int e = 0; e < 2; ++e) *(LAS u32x4*)(wl + MX_GT + (tr + 8 * e) * 128 + g * 16) = gt[e];
                }
            }
            if (s < 7) {
#pragma unroll
                for (int k = 0; k < 5; ++k) xr[k] = *(const u32x4*)(XBp + (size_t)(tb + 16 + 2 * tr - 3 + k) * DM + ch0);
                if (APPLY) {
#pragma unroll
                    for (int e = 0; e < 2; ++e) gt[e] = *(const u32x4*)(GG + (size_t)(tb + 16 + tr + 8 * e) * DM + ch0);
                }
            }
            LDS_WAIT(); asm volatile("" ::: "memory");
            {
                bf16x8 Af[2];
#pragma unroll
                for (int s2 = 0; s2 < 2; ++s2) Af[s2] = *(const LAS bf16x8*)(wl + MX_UB + cc * 128 + (((4 * s2 + kq) ^ (cc & 7)) * 16));
#pragma unroll
                for (int n = 0; n < 4; ++n) {
                    f32x4 aR = {0.f, 0.f, 0.f, 0.f}, aI = {0.f, 0.f, 0.f, 0.f}, aU = {0.f, 0.f, 0.f, 0.f};
#pragma unroll
                    for (int s2 = 0; s2 < 2; ++s2) { aR = __builtin_amdgcn_mfma_f32_16x16x32_bf16(Af[s2], bR[n][s2], aR, 0, 0, 0); aI = __builtin_amdgcn_mfma_f32_16x16x32_bf16(Af[s2], bI[n][s2], aI, 0, 0, 0); }
                    aU = __builtin_amdgcn_mfma_f32_16x16x32_bf16(Af[n >> 1], idf[n & 1], aU, 0, 0, 0);
#pragma unroll
                    for (int r = 0; r < 4; ++r) {
                        const float rg = fast_sigmoid(aR[r] + gba[n]), ig = fast_sigmoid(aI[r] + gbx[n]);
                        const float av = __builtin_amdgcn_exp2f(rg * gkk[n]);
                        const float bv = __builtin_amdgcn_sqrtf(fmaxf(1.0f - av * av, 0.f)) * (ig * aU[r]);
                        const int tok = 4 * kq + r;
                        SA[tok * 64 + 16 * n + cc] = av; SBm[tok * 64 + 16 * n + cc] = bv;
                    }
                }
            }
            LDS_WAIT(); asm volatile("" ::: "memory");
            if (!APPLY) {
#pragma unroll
                for (int t = 0; t < 16; ++t) { const float av = SA[t * 64 + lane], bv = SBm[t * 64 + lane]; Hw = av * Hw + bv; Pw *= av; }
            } else {
#pragma unroll
                for (int t = 0; t < 16; ++t) { const float av = SA[t * 64 + lane], bv = SBm[t * 64 + lane]; Hw = av * Hw + bv;
                    const float gv = __builtin_bit_cast(float, (unsigned)GT[t * 64 + lane] << 16);
                    GT[t * 64 + lane] = (unsigned short)pk2(Hw * gv, 0.f); }
                LDS_WAIT(); asm volatile("" ::: "memory");
#pragma unroll
                for (int e = 0; e < 2; ++e) { const u32x4 o = *(const LAS u32x4*)(wl + MX_GT + (tr + 8 * e) * 128 + g * 16);
                    *(u32x4*)((JUNK ? (bf16_t*)(a->ws + WS_S5) : GG) + (size_t)(tb + tr + 8 * e) * DM + ch0) = o; }
            }
        }
        if (!APPLY) {
            SUM[((size_t)(b * 64 + span)) * DM + chb + lane] = (f32x2){Pw, Hw};
            WSX[w * 64 + lane] = (f32x2){Pw, Hw};
            LDS_WAIT(); __syncthreads();
            if (w == 0) { float Pu = 1.f, Hu = 0.f;
#pragma unroll
                for (int j = 0; j < 8; ++j) { const f32x2 sj = WSX[j * 64 + lane]; Hu = sj.x * Hu + sj.y; Pu *= sj.x; }
                SUMG[((size_t)(b * 8 + g8)) * DM + chb + lane] = (f32x2){Pu, Hu}; }
            LDS_WAIT(); __syncthreads();
        }
    }
}

constexpr int N_PHASES = 8 * DEPTH + 1;
#define IN(k) (lo <= (k) && (k) < hi)
#define SEAM(k) do { if (IN(k) && IN((k) + 1)) { XcdBarrier b_; b_.bar = (unsigned*)(kargs()->ws + WS_CTL) + CW_BAR; b_.x = xb_xcc_id(); b_.st = (volatile LAS unsigned*)(ldsb + MISC_OFF) + 8; xcd_barrier(b_); } } while (0)
template <int L>
__device__ __forceinline__ void layer_phases(const int lo, const int hi, LAS unsigned char* const ldsb, const int wave_s) {
    constexpr int l = L, pb = 8 * L;
    constexpr size_t TS1 = (size_t)256 * DM * 2, TSF = (size_t)256 * DFF * 2;
        if (IN(pb + 0)) { Frame F = make_frame(ldsb, wave_s); p0_weights(F, l); if (l == 0) p0_x(F); }
        if (PROBE_REPEAT == 0 && IN(pb + 0)) { Frame F = make_frame(ldsb, wave_s); p0_weights(F, l); if (l == 0) p0_x(F); }
        SEAM(pb + 0);
        if (IN(pb + 1)) {
            Frame F = make_frame(ldsb, wave_s); KArgs a = kargs(); unsigned char* ws = a->ws;
            pg8::SchedPlain S; S.so.init(M, N1A, F.G, F.bx); S.A0 = (const char*)(ws + WS_S0); S.B0 = (const char*)(ws + WS_WIN); S.tstep = TS1;
            pg8::EpiP1a E{(const float*)(ws + WS_SSQ), (bf16_t*)(ws + WS_S1), (bf16_t*)(ws + WS_S2), (bf16_t*)(ws + WS_S3), (bf16_t*)(ws + WS_S4)};
            pg8::gemm_phase<pg8::EpiP1a, pg8::SchedPlain, true, true>(F.lds, F.tid, DM, S, E);
        }
        if (PROBE_REPEAT == 1 && IN(pb + 1)) {
            Frame F = make_frame(ldsb, wave_s); KArgs a = kargs(); unsigned char* ws = a->ws;
            pg8::SchedPlain S; S.so.init(M, N1A, F.G, F.bx); S.A0 = (const char*)(ws + WS_S0); S.B0 = (const char*)(ws + WS_WIN); S.tstep = TS1;
            pg8::EpiP1a E{(const float*)(ws + WS_SSQ), (bf16_t*)(ws + WS_S1), (bf16_t*)(ws + WS_S2), (bf16_t*)(ws + WS_S3), (bf16_t*)(ws + WS_S4)};
            pg8::gemm_phase<pg8::EpiP1a, pg8::SchedPlain, true, true>(F.lds, F.tid, DM, S, E);
        }
        SEAM(pb + 1);
        if (IN(pb + 2)) { { Frame F = make_frame(ldsb, wave_s); p2_mixer_a(F, l); } { Frame F = make_frame(ldsb, wave_s); mixer_b<false>(F, l); } }
        if (PROBE_REPEAT == 2 && IN(pb + 2)) { __syncthreads(); Frame F = make_frame(ldsb, wave_s); mixer_b<false>(F, l); }
        SEAM(pb + 2);
        if (IN(pb + 3)) {
            { Frame F = make_frame(ldsb, wave_s); mixer_b<true>(F, l); }
            __syncthreads();
            Frame F = make_frame(ldsb, wave_s); KArgs a = kargs(); unsigned char* ws = a->ws;
            pg8::StaticOrder so; so.init(M, DM, F.G, F.bx);
            int pm_ = 0, pn_ = 0; const bool ok_ = so.next(0, pm_, pn_);
            pg8::SchedGG S; S.valid = ok_; S.pm = pm_; S.pn = pn_; S.ws = (const char*)ws;
            pg8::EpiGG E{(const float*)(ws + WS_SSQ), a->in[I_GB] + (size_t)l * 2 * DM, (bf16_t*)(ws + WS_S2), (bf16_t*)(ws + WS_S5)};
            pg8::gemm_phase<pg8::EpiGG, pg8::SchedGG, true, true>(F.lds, F.tid, DM, S, E);
        }
        if (PROBE_REPEAT == 3 && IN(pb + 3)) {
            __syncthreads();
            Frame F = make_frame(ldsb, wave_s); KArgs a = kargs(); unsigned char* ws = a->ws;
            pg8::StaticOrder so; so.init(M, DM, F.G, F.bx);
            int pm_ = 0, pn_ = 0; const bool ok_ = so.next(0, pm_, pn_);
            pg8::SchedGG S; S.valid = ok_; S.pm = pm_; S.pn = pn_; S.ws = (const char*)ws;
            pg8::EpiGG E{(const float*)(ws + WS_SSQ), a->in[I_GB] + (size_t)l * 2 * DM, (bf16_t*)(ws + WS_S2), (bf16_t*)(ws + WS_S5)};
            pg8::gemm_phase<pg8::EpiGG, pg8::SchedGG, true, true>(F.lds, F.tid, DM, S, E);
        }
        SEAM(pb + 3);
        if (IN(pb + 4)) {
            Frame F = make_frame(ldsb, wave_s); KArgs a = kargs(); unsigned char* ws = a->ws;
            pg8::StaticOrder so; so.init(M, DM, F.G, F.bx);
            int pm_ = 0, pn_ = 0; const bool ok_ = so.next(0, pm_, pn_);
            pg8::SchedOut S; S.valid = ok_; S.pm = pm_; S.pn = pn_; S.ws = (const char*)ws;
            pg8::EpiOut E{(const bf16_t*)(ws + WS_S2), (const bf16_t*)(ws + WS_S5), (bf16_t*)(ws + WS_S3)};
            pg8::gemm_phase<pg8::EpiOut, pg8::SchedOut, false, true>(F.lds, F.tid, DM, S, E);
        }
        if (PROBE_REPEAT == 4 && IN(pb + 4)) {
            Frame F = make_frame(ldsb, wave_s); KArgs a = kargs(); unsigned char* ws = a->ws;
            pg8::StaticOrder so; so.init(M, DM, F.G, F.bx);
            int pm_ = 0, pn_ = 0; const bool ok_ = so.next(0, pm_, pn_);
            pg8::SchedOut S; S.valid = ok_; S.pm = pm_; S.pn = pn_; S.ws = (const char*)ws;
            pg8::EpiOut E{(const bf16_t*)(ws + WS_S2), (const bf16_t*)(ws + WS_S5), (bf16_t*)(ws + WS_S3)};
            pg8::gemm_phase<pg8::EpiOut, pg8::SchedOut, false, true>(F.lds, F.tid, DM, S, E);
        }
        SEAM(pb + 4);
        if (IN(pb + 5)) {
            Frame F = make_frame(ldsb, wave_s); KArgs a = kargs(); unsigned char* ws = a->ws;
            pg8::SchedPlain S; S.so.init(M, DM, F.G, F.bx); S.A0 = (const char*)(ws + WS_S3); S.B0 = (const char*)(ws + WS_WO); S.tstep = TS1;
            pg8::EpiRes E{(bf16_t*)(ws + WS_S0), a->out, (float*)(ws + WS_SSQ), false};
            pg8::gemm_phase<pg8::EpiRes, pg8::SchedPlain, false, true>(F.lds, F.tid, DM, S, E);
        }
        SEAM(pb + 5);
        if (IN(pb + 6)) {
            Frame F = make_frame(ldsb, wave_s); KArgs a = kargs(); unsigned char* ws = a->ws;
            pg8::SchedPlain S; S.so.init(M, NGU, F.G, F.bx); S.A0 = (const char*)(ws + WS_S0); S.B0 = (const char*)(ws + WS_WGU); S.tstep = TS1;
            pg8::EpiP6 E{(const float*)(ws + WS_SSQ), (bf16_t*)(ws + WS_S1)};
            pg8::gemm_phase<pg8::EpiP6, pg8::SchedPlain, true, true>(F.lds, F.tid, DM, S, E);
        }
        if (PROBE_REPEAT == 6 && IN(pb + 6)) {
            Frame F = make_frame(ldsb, wave_s); KArgs a = kargs(); unsigned char* ws = a->ws;
            pg8::SchedPlain S; S.so.init(M, NGU, F.G, F.bx); S.A0 = (const char*)(ws + WS_S0); S.B0 = (const char*)(ws + WS_WGU); S.tstep = TS1;
            pg8::EpiP6 E{(const float*)(ws + WS_SSQ), (bf16_t*)(ws + WS_S1)};
            pg8::gemm_phase<pg8::EpiP6, pg8::SchedPlain, true, true>(F.lds, F.tid, DM, S, E);
        }
        SEAM(pb + 6);
        if (IN(pb + 7)) {
            Frame F = make_frame(ldsb, wave_s); KArgs a = kargs(); unsigned char* ws = a->ws;
            pg8::SchedPlain S; S.so.init(M, DM, F.G, F.bx); S.A0 = (const char*)(ws + WS_S1); S.B0 = (const char*)(ws + WS_WD); S.tstep = TSF;
            pg8::EpiRes E{(bf16_t*)(ws + WS_S0), a->out, (float*)(ws + WS_SSQ), false};
            pg8::gemm_phase<pg8::EpiRes, pg8::SchedPlain, false, true>(F.lds, F.tid, DFF, S, E);
        }
        SEAM(pb + 7);
}

__global__ void __launch_bounds__(NWAVES * 64, 2) fwd_kernel(Args args_unused) {
    extern __shared__ __attribute__((aligned(16))) unsigned char lds[];
    LAS unsigned char* const ldsb = (LAS unsigned char*)lds;
    const int wave_s = __builtin_amdgcn_readfirstlane(threadIdx.x >> 6);
    for (int u = threadIdx.x; u < (LDS_BYTES - LDSCTL_OFF) / 4; u += NWAVES * 64) ((LAS unsigned*)(ldsb + LDSCTL_OFF))[u] = 0u;
    __syncthreads();
    int lo, hi;
    { KArgs a = kargs(); lo = a->ph_lo; hi = a->ph_hi;
      if (hi - lo > 1) (void)xcd_barrier_post((unsigned*)(a->ws + WS_CTL) + CW_BAR, (volatile LAS unsigned*)(ldsb + MISC_OFF) + 8); }

    layer_phases<0>(lo, hi, ldsb, wave_s);
    layer_phases<1>(lo, hi, ldsb, wave_s);
    if (IN(8 * DEPTH)) { Frame F = make_frame(ldsb, wave_s); p8_final(F); }
#undef IN
#undef SEAM
}

extern "C" void kernel_launch(void* const* d_in, const int* in_sizes, int n_in, void* d_out, int out_size, void* d_ws, size_t ws_size, hipStream_t stream) {
    static int grid = 0;
    if (grid == 0) {
        if (n_in != 20 || in_sizes[0] != M * DM || out_size != M * DM || ws_size < WS_END) {
            fprintf(stderr, "kernel_launch: unexpected shapes: n_in %d in0 %d out %d ws %zu (need %zu)\n", n_in, n_in > 0 ? in_sizes[0] : -1, out_size, ws_size, (size_t)WS_END); grid = -1; return; }
        int dev = 0, cus = 0, per_cu = 0;
        if (hipGetDevice(&dev) != hipSuccess || hipDeviceGetAttribute(&cus, hipDeviceAttributeMultiprocessorCount, dev) != hipSuccess) { grid = -1; return; }
        if (hipFuncSetAttribute((const void*)fwd_kernel, hipFuncAttributeMaxDynamicSharedMemorySize, LDS_BYTES) != hipSuccess) { fprintf(stderr, "kernel_launch: hipFuncSetAttribute failed\n"); grid = -1; return; }
        if (hipOccupancyMaxActiveBlocksPerMultiprocessor(&per_cu, (const void*)fwd_kernel, NWAVES * 64, LDS_BYTES) != hipSuccess || per_cu < 1)
            fprintf(stderr, "kernel_launch: occupancy query reports %d workgroups per CU\n", per_cu);
        (void)hipGetLastError();
        grid = cus;
        if (grid != 256) fprintf(stderr, "kernel_launch: %d CUs (built for 256)\n", grid);
    }
    if (grid < 0) return;
    (void)hipMemsetAsync((char*)d_ws + WS_CTL, 0, CTL_ZERO_BYTES, stream);
    Args a{};
    for (int i = 0; i < 20; ++i) a.in[i] = (const float*)d_in[i];
    a.out = (float*)d_out; a.ws = (unsigned char*)d_ws;
#if MK_PER_PHASE
    for (int p = 0; p < N_PHASES; ++p) { a.ph_lo = p; a.ph_hi = p + 1; hipLaunchKernelGGL(fwd_kernel, dim3(grid), dim3(NWAVES * 64), LDS_BYTES, stream, a); }
#else
    a.ph_lo = 0; a.ph_hi = N_PHASES;
    hipLaunchKernelGGL(fwd_kernel, dim3(grid), dim3(NWAVES * 64), LDS_BYTES, stream, a);
#endif
}
```
